# Optimizing an MI355X kernel written in HIP

```python
import math
import jax
import jax.numpy as jnp
from jax import lax
import numpy as np

D_MODEL = 4096
BATCH = 1
SEQ = 16384
DEPTH = 4

GRID_W = 64
CTX_LEN = 256
N_MIXERS = 3
FFN_HIDDEN = ((8 * D_MODEL + 3 * 256 - 1) // (3 * 256)) * 256
ADA_RANK = 256
N_MOD = 6
EPS = 1e-6
MLA_HEADS = D_MODEL // 128
Q_RANK = D_MODEL // 4
KV_RANK = 512
NOPE_DIM = 128
ROPE_DIM = 64
V_DIM = 128
ROPE_BASE = 10000.0
Q_BLOCK = 128
HY_BANDS = 16
HY_EMB = 2 * HY_BANDS + 1
HY_FILTER_HIDDEN = 64
HY_DECAY_TARGET = 1e-2
HY_FAST_DECAY_PCT = 0.3
HY_SLOW_DECAY_PCT = 1.5

kernel_name = 'hybrid_interleaved_diffusion_trunk'


def rmsnorm(x, gain):
    xf = x.astype(jnp.float32)
    y = xf * lax.rsqrt(jnp.mean(xf * xf, axis=-1, keepdims=True) + EPS)
    return (y * gain.astype(jnp.float32)).astype(x.dtype)


def modulate(x, gain, shift, scale):
    return rmsnorm(x, gain) * (1 + scale) + shift


def adaln(s, w_down, w_up, bias):
    mod = (s @ w_down) @ w_up + bias
    return jnp.split(mod[:, None, :], N_MOD, axis=-1)


def conv3(x, w):
    xp = jnp.pad(x, ((0, 0), (1, 1), (0, 0)))
    return w[0] * xp[:, :-2] + w[1] * xp[:, 1:-1] + w[2] * xp[:, 2:]


def swiglu(h, w_gate_up, w_down):
    gate, up = jnp.split(h @ w_gate_up, 2, axis=-1)
    return (jax.nn.silu(gate) * up) @ w_down


def short_conv_mixer(h, w_in, w_conv, w_out):
    b_gate, c_gate, xv = jnp.split(h @ w_in, 3, axis=-1)
    return (b_gate * conv3(c_gate * xv, w_conv)) @ w_out


def grid_rope_tables(n):
    rows = n // GRID_W
    row = jnp.repeat(jnp.arange(rows, dtype=jnp.float32), GRID_W)
    col = jnp.tile(jnp.arange(GRID_W, dtype=jnp.float32), rows)
    axis_dim = ROPE_DIM // 2
    inv = ROPE_BASE ** (-jnp.arange(0, axis_dim, 2, dtype=jnp.float32) / axis_dim)
    ang_r = row[:, None] * inv
    ang_c = col[:, None] * inv
    return (jnp.cos(ang_r), jnp.sin(ang_r), jnp.cos(ang_c), jnp.sin(ang_c))


def rotate(x, cos, sin):
    x1, x2 = jnp.split(x, 2, axis=-1)
    return jnp.concatenate([x1 * cos - x2 * sin, x2 * cos + x1 * sin], axis=-1)


def axial_rope(x, tabs):
    cos_r, sin_r, cos_c, sin_c = tabs
    x_row, x_col = jnp.split(x.astype(jnp.float32), 2, axis=-1)
    return jnp.concatenate([rotate(x_row, cos_r, sin_r), rotate(x_col, cos_c, sin_c)], axis=-1).astype(x.dtype)


def mla_queries(cq, q_norm, w_uq):
    B, n, _ = cq.shape
    q = (rmsnorm(cq, q_norm) @ w_uq).reshape(B, n, MLA_HEADS, NOPE_DIM + ROPE_DIM)
    return q[..., :NOPE_DIM], q[..., NOPE_DIM:]


def mla_keys_values(ckv_kr, kv_norm, w_ukv):
    B, n, _ = ckv_kr.shape
    ckv, k_rope = ckv_kr[..., :KV_RANK], ckv_kr[..., KV_RANK:]
    kv = (rmsnorm(ckv, kv_norm) @ w_ukv).reshape(B, n, MLA_HEADS, NOPE_DIM + V_DIM)
    return kv[..., :NOPE_DIM], k_rope, kv[..., NOPE_DIM:]


def attend(q_nope, q_rope, k_nope, k_rope, v):
    scale = (NOPE_DIM + ROPE_DIM) ** -0.5
    s = jnp.einsum('bqhd,bkhd->bhqk', q_nope, k_nope) + jnp.einsum('bqhr,bkr->bhqk', q_rope, k_rope)
    p = jax.nn.softmax(s.astype(jnp.float32) * scale, axis=-1).astype(v.dtype)
    return jnp.einsum('bhqk,bkhd->bqhd', p, v)


def mla_mixer(h, hc, ctx_queries, rope_tabs, w_down, q_norm, kv_norm, w_uq, w_ukv, w_out):
    B, n, _ = h.shape
    d = h @ w_down
    q_nope, q_rope = mla_queries(d[..., :Q_RANK], q_norm, w_uq)
    k_nope, k_rope, v = mla_keys_values(d[..., Q_RANK:], kv_norm, w_ukv)
    q_rope = axial_rope(q_rope, tuple(t[:, None, :] for t in rope_tabs))
    k_rope = axial_rope(k_rope, rope_tabs)
    if ctx_queries:
        dc = hc @ w_down
        qn_c, qr_c = mla_queries(dc[..., :Q_RANK], q_norm, w_uq)
        kn_c, kr_c, v_c = mla_keys_values(dc[..., Q_RANK:], kv_norm, w_ukv)
    else:
        kn_c, kr_c, v_c = mla_keys_values(hc @ w_down[:, Q_RANK:], kv_norm, w_ukv)
    kn_all = jnp.concatenate([k_nope, kn_c], axis=1)
    kr_all = jnp.concatenate([k_rope, kr_c], axis=1)
    v_all = jnp.concatenate([v, v_c], axis=1)
    nb = n // Q_BLOCK
    to_blocks = lambda a: a.reshape(B, nb, Q_BLOCK, *a.shape[2:]).swapaxes(0, 1)
    o = lax.map(lambda qs: attend(qs[0], qs[1], kn_all, kr_all, v_all), (to_blocks(q_nope), to_blocks(q_rope)))
    o = o.swapaxes(0, 1).reshape(B, n, MLA_HEADS * V_DIM)
    y = o @ w_out
    yc = None
    if ctx_queries:
        oc = attend(qn_c, qr_c, kn_c, kr_c, v_c)
        yc = oc.reshape(B, oc.shape[1], MLA_HEADS * V_DIM) @ w_out
    return y, yc


def hyena_filter_spectrum(n, w1, b1, w2, b2, w3, b3, freq, w4):
    f32 = jnp.float32
    t = jnp.linspace(0.0, 1.0, n, dtype=f32)[:, None]
    w = (2.0 * math.pi / n) * jnp.arange(n, dtype=f32)[:, None]
    bands = jnp.linspace(1e-4, HY_BANDS - 1, HY_BANDS, dtype=f32)
    z = jnp.concatenate([t, jnp.cos(bands * w), -jnp.sin(bands * w)], axis=-1)
    fr = freq.astype(f32)
    hdn = jnp.sin(fr[0] * (z @ w1.astype(f32) + b1.astype(f32)))
    hdn = jnp.sin(fr[1] * (hdn @ w2.astype(f32) + b2.astype(f32)))
    hdn = jnp.sin(fr[2] * (hdn @ w3.astype(f32) + b3.astype(f32)))
    filt = hdn @ w4.astype(f32)
    d = filt.shape[-1] // 2
    deltas = jnp.abs(jnp.linspace(math.log(HY_DECAY_TARGET) / HY_SLOW_DECAY_PCT,
                                  math.log(HY_DECAY_TARGET) / HY_FAST_DECAY_PCT, d, dtype=f32))
    decay = jnp.exp(-t * deltas)
    h_fwd = filt[:, :d] * decay
    h_bwd = filt[:, d:] * decay
    g = jnp.concatenate([h_fwd, jnp.zeros((1, d), f32), h_bwd[:0:-1]], axis=0)
    return jnp.fft.rfft(g, axis=0)


def hyena_mixer(h, w_in, conv_w, conv_b, f_w1, f_b1, f_w2, f_b2, f_w3, f_b3, f_freq, f_w4, skip, w_out):
    n = h.shape[1]
    z = conv3(h @ w_in, conv_w) + conv_b
    x0, x1, v = jnp.split(z, 3, axis=-1)
    v = x1 * v
    spec = hyena_filter_spectrum(n, f_w1, f_b1, f_w2, f_b2, f_w3, f_b3, f_freq, f_w4)
    vf = jnp.fft.rfft(v.astype(jnp.float32), n=2 * n, axis=1)
    y = jnp.fft.irfft(vf * spec, n=2 * n, axis=1)[:, :n].astype(h.dtype) + v * skip
    return (x0 * y) @ w_out


def setup_inputs(seed: int = 0) -> dict:
    key = jax.random.key(seed)
    keys = iter(jax.random.split(key, 64))
    f32 = jnp.float32
    D = D_MODEL
    FH = HY_FILTER_HIDDEN

    def dense(shape, fan_in, scale=1.0):
        return jax.random.normal(next(keys), shape, f32) * (scale * fan_in ** -0.5)

    def near_one(shape):
        return 1.0 + 0.05 * jax.random.normal(next(keys), shape, f32)

    def small(shape, s=0.01):
        return s * jax.random.normal(next(keys), shape, f32)

    n_a, n_b, n_c = (len(range(m, DEPTH, N_MIXERS)) for m in range(N_MIXERS))
    return {
        'x': jax.random.normal(next(keys), (BATCH, SEQ, D), f32),
        'c': jax.random.normal(next(keys), (BATCH, D), f32),
        'ctx': jax.random.normal(next(keys), (BATCH, CTX_LEN, D), f32),
        'c_ctx': jax.random.normal(next(keys), (D,), f32),
        'ada_down': dense((DEPTH, D, ADA_RANK), D),
        'ada_up': dense((DEPTH, ADA_RANK, N_MOD * D), ADA_RANK, 0.5),
        'ada_bias': small((DEPTH, N_MOD * D)),
        'norm_gain': near_one((DEPTH, 4, D)),
        'ffn_w_gate_up': dense((DEPTH, D, 2 * FFN_HIDDEN), D),
        'ffn_w_down': dense((DEPTH, FFN_HIDDEN, D), FFN_HIDDEN),
        'sc_w_in': dense((n_a, D, 3 * D), D),
        'sc_conv': dense((n_a, 3, D), 3),
        'sc_w_out': dense((n_a, D, D), D),
        'mla_w_down': dense((n_b, D, Q_RANK + KV_RANK + ROPE_DIM), D),
        'mla_q_norm': near_one((n_b, Q_RANK)),
        'mla_kv_norm': near_one((n_b, KV_RANK)),
        'mla_w_uq': dense((n_b, Q_RANK, MLA_HEADS * (NOPE_DIM + ROPE_DIM)), Q_RANK),
        'mla_w_ukv': dense((n_b, KV_RANK, MLA_HEADS * (NOPE_DIM + V_DIM)), KV_RANK),
        'mla_w_out': dense((n_b, MLA_HEADS * V_DIM, D), MLA_HEADS * V_DIM),
        'hy_w_in': dense((n_c, D, 3 * D), D),
        'hy_conv': dense((n_c, 3, 3 * D), 3),
        'hy_conv_b': small((n_c, 3 * D)),
        'hy_f_w1': dense((n_c, HY_EMB, FH), HY_EMB),
        'hy_f_b1': small((n_c, FH), 0.1),
        'hy_f_w2': dense((n_c, FH, FH), FH),
        'hy_f_b2': small((n_c, FH), 0.1),
        'hy_f_w3': dense((n_c, FH, FH), FH),
        'hy_f_b3': small((n_c, FH), 0.1),
        'hy_f_freq': near_one((n_c, 3, FH)),
        'hy_f_w4': dense((n_c, FH, 2 * D), FH),
        'hy_skip': jax.random.normal(next(keys), (n_c, D), f32),
        'hy_w_out': dense((n_c, D, D), D),
    }


def reference(x, c, ctx, c_ctx, ada_down, ada_up, ada_bias, norm_gain, ffn_w_gate_up, ffn_w_down,
              sc_w_in, sc_conv, sc_w_out,
              mla_w_down, mla_q_norm, mla_kv_norm, mla_w_uq, mla_w_ukv, mla_w_out,
              hy_w_in, hy_conv, hy_conv_b, hy_f_w1, hy_f_b1, hy_f_w2, hy_f_b2, hy_f_w3, hy_f_b3,
              hy_f_freq, hy_f_w4, hy_skip, hy_w_out):
    n = x.shape[1]
    rope_tabs = grid_rope_tables(n)
    mla_layers = [i for i in range(DEPTH) if i % N_MIXERS == 1]
    last_ctx_read = mla_layers[-1] if mla_layers else -1
    s_lat = jax.nn.silu(c)
    s_ctx = jax.nn.silu(c_ctx)[None, :]
    for i in range(DEPTH):
        kind, j = i % N_MIXERS, i // N_MIXERS
        ctx_full = i < last_ctx_read
        ctx_keys = i == last_ctx_read
        g = norm_gain[i]
        mod = adaln(s_lat, ada_down[i], ada_up[i], ada_bias[i])
        h = modulate(x, g[0], mod[0], mod[1])
        if ctx_full or ctx_keys:
            mod_c = adaln(s_ctx, ada_down[i], ada_up[i], ada_bias[i])
            hc = modulate(ctx, g[0], mod_c[0], mod_c[1])
        yc = None
        if kind == 0:
            y = short_conv_mixer(h, sc_w_in[j], sc_conv[j], sc_w_out[j])
            if ctx_full:
                yc = short_conv_mixer(hc, sc_w_in[j], sc_conv[j], sc_w_out[j])
        elif kind == 1:
            y, yc = mla_mixer(h, hc, ctx_full, rope_tabs, mla_w_down[j], mla_q_norm[j], mla_kv_norm[j],
                              mla_w_uq[j], mla_w_ukv[j], mla_w_out[j])
        else:
            hp = (hy_w_in[j], hy_conv[j], hy_conv_b[j], hy_f_w1[j], hy_f_b1[j], hy_f_w2[j], hy_f_b2[j],
                  hy_f_w3[j], hy_f_b3[j], hy_f_freq[j], hy_f_w4[j], hy_skip[j], hy_w_out[j])
            y = hyena_mixer(h, *hp)
            if ctx_full:
                yc = hyena_mixer(hc, *hp)
        x = x + mod[2] * rmsnorm(y, g[1])
        x = x + mod[5] * rmsnorm(swiglu(modulate(x, g[2], mod[3], mod[4]), ffn_w_gate_up[i], ffn_w_down[i]), g[3])
        if ctx_full:
            ctx = ctx + mod_c[2] * rmsnorm(yc, g[1])
            ctx = ctx + mod_c[5] * rmsnorm(swiglu(modulate(ctx, g[2], mod_c[3], mod_c[4]), ffn_w_gate_up[i], ffn_w_down[i]), g[3])
    return x
```

```cpp
#include <hip/hip_runtime.h>
#include <cstdio>
#include <cstdint>
namespace pg8 {
#define PG8_LAS __attribute__((address_space(3)))
typedef unsigned short bf16_t;
typedef short bf16x8 __attribute__((ext_vector_type(8)));
typedef float f32x4 __attribute__((ext_vector_type(4)));
typedef unsigned u32x4 __attribute__((ext_vector_type(4)));
constexpr int BM = 256, BK = 64, HALF = 128, HTB = HALF * BK * 2  , STAGE_BYTES = 8 * HTB, NXCD = 8, WGM = 8;

__host__ __device__ __forceinline__ int lds_byte(int r, int c) { const int st = (r >> 4) * 2 + (c >> 5), rr = r & 15, cc = c & 31, ob = rr * 64 + cc * 2; return st * 1024 + (ob ^ (((ob >> 9) & 1) << 5)); }
__host__ __device__ __forceinline__ void stage_rc(int b, int& R, int& C) { const int st = b / 1024, sb = b % 1024, swz = sb ^ (((sb >> 9) & 1) << 5); R = (st >> 1) * 16 + swz / 64; C = (st & 1) * 32 + (swz % 64) / 2; }
__host__ __device__ __forceinline__ int perm32(int rho) { const int n = rho >> 4, i = rho & 15; return 8 * (i >> 2) + 4 * n + (i & 3); }

struct Unit { int pm, pn; };
struct Gemm { const bf16_t* A; const bf16_t* Bt; int M, N, K; int ld; };

struct StaticOrder {
    int nM, nN, nwg, G, c;
    __host__ __device__ void init(int M, int N, int G_, int c_) { nM = M / BM; nN = N / BM; nwg = nM * nN; G = G_; c = c_; }
    __host__ __device__ bool next(int i, Unit& u) const {
        const long L = (long)i * G + c; if (L >= nwg) return false;
        int wgid = (int)L; { const int q = nwg / NXCD, r = nwg % NXCD, xcd = wgid % NXCD, off = wgid / NXCD; wgid = (xcd < r ? xcd * (q + 1) : r * (q + 1) + (xcd - r) * q) + off; }
        const int nig = WGM * nN, gid = wgid / nig, fm = gid * WGM, gsz = (nM - fm) < WGM ? (nM - fm) : WGM;
        u.pm = fm + ((wgid % nig) % gsz); u.pn = (wgid % nig) / gsz; return true;
    }
    __device__ __forceinline__ void a_ready(const Unit&) const {}
    __device__ __forceinline__ void done(const Unit&) const {}
};

template <int RB, int CB> struct BlockOrder {
    static_assert(RB * CB == 32 && 8 % RB == 0 && 16 % CB == 0, "32 tiles per XCD and round");
    int c;
    __host__ __device__ void init(int c_) { c = c_; }
    __host__ __device__ bool next(int i, Unit& u) const {
        constexpr int NCG = 16 / CB, NRS = 8 / RB; if (i >= NCG * NRS) return false;
        const int x = c & 7, s = c >> 3, cg = i % NCG, rs = i / NCG;
        u.pm = 8 * x + rs * RB + (s % RB); u.pn = cg * CB + (s / RB); return true;
    }
    __device__ __forceinline__ void a_ready(const Unit&) const {}
    __device__ __forceinline__ void done(const Unit&) const {}
};
__device__ __forceinline__ unsigned cvt_pk_bf16(float lo, float hi) { unsigned r; asm volatile("v_cvt_pk_bf16_f32 %0, %1, %2" : "=v"(r) : "v"(lo), "v"(hi)); return r; }
typedef float f32x2 __attribute__((ext_vector_type(2)));
__device__ __forceinline__ f32x2 gelu_pk(f32x2 v) {
    const f32x2 av = __builtin_elementwise_abs(v), d = av * 0.2316418882f + 1.0f;
    f32x2 t; t.x = __builtin_amdgcn_rcpf(d.x); t.y = __builtin_amdgcn_rcpf(d.y);
    f32x2 q = t * 0.5307027145f + (-0.7265760135f); q = q * t + 0.7107068705f; q = q * t + (-0.142248368f); q = q * t + 0.127414796f; q = q * t;
    const f32x2 s = (v * v) * (-0.72134752044f);
    f32x2 e; e.x = __builtin_amdgcn_exp2f(s.x); e.y = __builtin_amdgcn_exp2f(s.y);
    const f32x2 m = v * (q * e), r = v - m;
    f32x2 o; o.x = v.x < 0.f ? m.x : r.x; o.y = v.y < 0.f ? m.y : r.y; return o;
}

template <int ACT  > struct EpiBf16 {
    static constexpr bool PERM = true, AFTER_DRAIN = false; static_assert(ACT == 0 || ACT == 1, "EpiBf16: ACT is 0 (none) or 1 (gelu_pk)");
    bf16_t* O; int ldc; const float* bias; int split_cols; size_t split_stride; float scale0;
    __device__ __forceinline__ void operator()(const f32x4 (&acc)[2][2][4][2], const Unit& u, int wr, int wc, int fr, int fq) const {
        const int row0 = u.pm * BM + wr * 64 + fr; int colt = u.pn * BM; bf16_t* base = O;
        float sc = 1.f; if (split_cols) { const int t = colt / split_cols; base += (size_t)t * split_stride; colt -= t * split_cols; if (t == 0) sc = scale0; }
        const int col0 = colt + wc * 32 + 8 * fq, bcol0 = u.pn * BM + wc * 32 + 8 * fq;
        f32x4 bv[2][2];
#pragma unroll
        for (int bj = 0; bj < 2; ++bj)
#pragma unroll
            for (int n = 0; n < 2; ++n) bv[bj][n] = bias ? *(const f32x4*)(bias + bcol0 + bj * HALF + 4 * n) : (f32x4){0.f, 0.f, 0.f, 0.f};
#pragma unroll
        for (int ai = 0; ai < 2; ++ai)
#pragma unroll
            for (int m = 0; m < 4; ++m) { bf16_t* rowp = base + (size_t)(row0 + ai * HALF + m * 16) * ldc + col0;
#pragma unroll
                for (int bj = 0; bj < 2; ++bj) { f32x4 v0 = acc[ai][bj][m][0] + bv[bj][0], v1 = acc[ai][bj][m][1] + bv[bj][1];
                    if (ACT == 1) { f32x2 a = gelu_pk((f32x2){v0[0], v0[1]}), b = gelu_pk((f32x2){v0[2], v0[3]}), c = gelu_pk((f32x2){v1[0], v1[1]}), d = gelu_pk((f32x2){v1[2], v1[3]});
                        v0 = (f32x4){a.x, a.y, b.x, b.y}; v1 = (f32x4){c.x, c.y, d.x, d.y}; }
                    v0 = v0 * sc; v1 = v1 * sc; u32x4 w; w.x = cvt_pk_bf16(v0[0], v0[1]); w.y = cvt_pk_bf16(v0[2], v0[3]); w.z = cvt_pk_bf16(v1[0], v1[1]); w.w = cvt_pk_bf16(v1[2], v1[3]);
                    *(u32x4*)(rowp + bj * HALF) = w; } }
    }
};
__device__ __forceinline__ float silu_fast(float g) { return g * __builtin_amdgcn_rcpf(1.0f + __builtin_amdgcn_exp2f(-1.4426950408889634f * g)); }
__device__ __forceinline__ u32x4 pack8(const f32x4 v0, const f32x4 v1) { u32x4 w; w.x = cvt_pk_bf16(v0[0], v0[1]); w.y = cvt_pk_bf16(v0[2], v0[3]); w.z = cvt_pk_bf16(v1[0], v1[1]); w.w = cvt_pk_bf16(v1[2], v1[3]); return w; }
struct EpiF32 {
    static constexpr bool PERM = false, AFTER_DRAIN = false;
    float* C; int ldc;
    __device__ __forceinline__ void operator()(const f32x4 (&acc)[2][2][4][2], const Unit& u, int wr, int wc, int fr, int fq) const {
        const int row0 = u.pm * BM + wr * 64 + fr, col0 = u.pn * BM + wc * 32 + 4 * fq;
#pragma unroll
        for (int ai = 0; ai < 2; ++ai)
#pragma unroll
            for (int m = 0; m < 4; ++m) { float* rowp = C + (size_t)(row0 + ai * HALF + m * 16) * ldc + col0;
#pragma unroll
                for (int bj = 0; bj < 2; ++bj)
#pragma unroll
                    for (int n = 0; n < 2; ++n) *(f32x4*)(rowp + bj * HALF + n * 16) = acc[ai][bj][m][n]; }
    }
};
struct EpiSwiglu {
    static constexpr bool PERM = true, AFTER_DRAIN = false;
    bf16_t* O; int ldc;
    __device__ __forceinline__ void operator()(const f32x4 (&acc)[2][2][4][2], const Unit& u, int wr, int wc, int fr, int fq) const {
        const int row0 = u.pm * BM + wr * 64 + fr, col0 = u.pn * HALF + wc * 32 + 8 * fq;
#pragma unroll
        for (int ai = 0; ai < 2; ++ai)
#pragma unroll
            for (int m = 0; m < 4; ++m) { bf16_t* rowp = O + (size_t)(row0 + ai * HALF + m * 16) * ldc + col0;
                f32x4 r0, r1;
#pragma unroll
                for (int e = 0; e < 4; ++e) { r0[e] = silu_fast(acc[ai][0][m][0][e]) * acc[ai][1][m][0][e]; r1[e] = silu_fast(acc[ai][0][m][1][e]) * acc[ai][1][m][1][e]; }
                __builtin_nontemporal_store(pack8(r0, r1), (u32x4*)rowp); }
    }
};
struct EpiScIn {
    static constexpr bool PERM = true, AFTER_DRAIN = false;
    bf16_t* P; bf16_t* Bq; int ldc;
    __device__ __forceinline__ void operator()(const f32x4 (&acc)[2][2][4][2], const Unit& u, int wr, int wc, int fr, int fq) const {
        const int row0 = u.pm * BM + wr * 64 + fr;
        if (u.pn < 32) {
            const int col0 = u.pn * HALF + wc * 32 + 8 * fq;
#pragma unroll
            for (int ai = 0; ai < 2; ++ai)
#pragma unroll
                for (int m = 0; m < 4; ++m) { bf16_t* rowp = P + (size_t)(row0 + ai * HALF + m * 16) * ldc + col0;
                    *(u32x4*)rowp = pack8(acc[ai][0][m][0] * acc[ai][1][m][0], acc[ai][0][m][1] * acc[ai][1][m][1]); }
        } else {
            const int col0 = (u.pn - 32) * BM + wc * 32 + 8 * fq;
#pragma unroll
            for (int ai = 0; ai < 2; ++ai)
#pragma unroll
                for (int m = 0; m < 4; ++m) { bf16_t* rowp = Bq + (size_t)(row0 + ai * HALF + m * 16) * ldc + col0;
#pragma unroll
                    for (int bj = 0; bj < 2; ++bj) *(u32x4*)(rowp + bj * HALF) = pack8(acc[ai][bj][m][0], acc[ai][bj][m][1]); }
        }
    }
};
template <class Epi, class Sched, bool ALIGN_EPI = false, bool SP2 = false>
__device__ __forceinline__ void gemm_phase(PG8_LAS unsigned char* lds, const Gemm g, const Sched& S, const Epi& E) {
    int tid_ = threadIdx.x; asm volatile("" : "+v"(tid_));
    const int tid = tid_, wid = __builtin_amdgcn_readfirstlane(tid >> 6), lane = tid & 63, wr = wid >> 2, wc = wid & 3, fr = lane & 15, fq = lane >> 4;
    const int nt = g.K / BK, K = g.ld ? g.ld : g.K;
    unsigned voffA[2], voffB[2];
#pragma unroll
    for (int i = 0; i < 2; ++i) { int R, C; stage_rc(tid * 16 + i * 8192, R, C); const int Rb = Epi::PERM ? ((R & ~31) + perm32(R & 31)) : R;
        voffA[i] = (unsigned)(R * K + C) * 2u; voffB[i] = (unsigned)(Rb * K + C) * 2u; }
    const size_t kstep = (size_t)(BK * 2);
    const size_t hstep = (size_t)HALF * K * 2;
    const size_t tstep = 2 * hstep;
    const unsigned ldsw = (unsigned)wid * 1024u;
    const int aoff = lds_byte(wr * 64 + fr, fq * 8), boff = lds_byte(wc * 32 + fr, fq * 8);
#define PG8_SA(b, h) (((b) * 2 + (h)) * HTB)
#define PG8_SB(b, h) ((4 + (b) * 2 + (h)) * HTB)
#define PG8_STAGE(bufoff, gbase, voff) do { _Pragma("unroll") for (int _i = 0; _i < 2; ++_i) \
        __builtin_amdgcn_global_load_lds((const unsigned*)((const char*)(gbase) + (voff)[_i]), (PG8_LAS unsigned*)(lds + (bufoff) + ldsw + _i * 8192), 16, 0, 0); } while (0)
#define PG8_LDA(dst, b, h) do { _Pragma("unroll") for (int m = 0; m < 4; ++m) _Pragma("unroll") for (int k = 0; k < 2; ++k) dst[m][k] = *(const PG8_LAS bf16x8*)(lds + PG8_SA(b, h) + aoff + m * 2048 + k * 1024); } while (0)
#define PG8_LDB(dst, b, h) do { _Pragma("unroll") for (int n = 0; n < 2; ++n) _Pragma("unroll") for (int k = 0; k < 2; ++k) dst[n][k] = *(const PG8_LAS bf16x8*)(lds + PG8_SB(b, h) + boff + n * 2048 + k * 1024); } while (0)
#define PG8_MMA(ai, bj, At, Bt) do { __builtin_amdgcn_s_setprio(1); _Pragma("unroll") for (int m = 0; m < 4; ++m) _Pragma("unroll") for (int n = 0; n < 2; ++n) _Pragma("unroll") for (int k = 0; k < 2; ++k) \
        acc[ai][bj][m][n] = __builtin_amdgcn_mfma_f32_16x16x32_bf16(Bt[n][k], At[m][k], acc[ai][bj][m][n], 0, 0, 0); __builtin_amdgcn_s_setprio(0); } while (0)
#define PG8_WAIT_V(n) asm volatile("s_waitcnt vmcnt(" #n ")" ::: "memory")
#define PG8_WAIT_L(n) asm volatile("s_waitcnt lgkmcnt(" #n ")" ::: "memory")
#define PG8_BAR __builtin_amdgcn_s_barrier()
#define PG8_SCHED __builtin_amdgcn_sched_barrier(0)
    Unit cur, nxt; int ui = 0;
    if (!S.next(0, cur)) return;
    f32x4 acc[2][2][4][2];
#pragma unroll
    for (int a = 0; a < 2; ++a)
#pragma unroll
        for (int b = 0; b < 2; ++b)
#pragma unroll
            for (int m = 0; m < 4; ++m)
#pragma unroll
                for (int n = 0; n < 2; ++n) acc[a][b][m][n] = (f32x4){0.f, 0.f, 0.f, 0.f};
    bf16x8 At[4][2], B0[2][2], B1[2][2];
    const char* cA = (const char*)g.A + (size_t)cur.pm * tstep; const char* cB = (const char*)g.Bt + (size_t)cur.pn * tstep;
    S.a_ready(cur);
    if constexpr (SP2) {
        PG8_STAGE(PG8_SB(0, 0), cB, voffB); PG8_STAGE(PG8_SB(0, 1), cB + hstep, voffB); PG8_STAGE(PG8_SA(0, 0), cA, voffA); PG8_STAGE(PG8_SA(0, 1), cA + hstep, voffA);
        if (wr == 1) PG8_BAR;
        PG8_WAIT_V(2); PG8_BAR;
        PG8_STAGE(PG8_SB(1, 0), cB + kstep, voffB); PG8_STAGE(PG8_SA(1, 0), cA + kstep, voffA); PG8_STAGE(PG8_SB(1, 1), cB + hstep + kstep, voffB);
        PG8_WAIT_V(6); PG8_BAR;
    } else {
        PG8_STAGE(PG8_SB(0, 0), cB, voffB); PG8_STAGE(PG8_SA(0, 0), cA, voffA); PG8_STAGE(PG8_SB(0, 1), cB + hstep, voffB); PG8_STAGE(PG8_SA(0, 1), cA + hstep, voffA);
        if (wr == 1) PG8_BAR;
        PG8_WAIT_V(4); PG8_BAR;
        PG8_STAGE(PG8_SB(1, 0), cB + kstep, voffB); PG8_STAGE(PG8_SA(1, 0), cA + kstep, voffA); PG8_STAGE(PG8_SB(1, 1), cB + hstep + kstep, voffB);
        PG8_WAIT_V(6); PG8_BAR;
    }
    for (;;) {
        const bool has_next = S.next(ui + 1, nxt);
        const char* nA = has_next ? (const char*)g.A + (size_t)nxt.pm * tstep : cA; const char* nB = has_next ? (const char*)g.Bt + (size_t)nxt.pn * tstep : cB;
        for (int t = 0; t < nt; t += 2) {
            const bool last = (t == nt - 2);
            const char* a1 = cA + (size_t)(t + 1) * kstep;
            const char* a2 = last ? nA : cA + (size_t)(t + 2) * kstep; const char* b2 = last ? nB : cB + (size_t)(t + 2) * kstep;
            const char* a3 = a2 + kstep; const char* b3 = b2 + kstep;
            if (last && has_next) S.a_ready(nxt);
            if constexpr (SP2) {
            PG8_LDB(B0, 0, 0); PG8_LDB(B1, 0, 1); PG8_SCHED; PG8_LDA(At, 0, 0); PG8_STAGE(PG8_SA(1, 1), a1 + hstep, voffA);
            PG8_WAIT_V(8); PG8_WAIT_L(0); PG8_BAR; PG8_MMA(0, 0, At, B0); PG8_MMA(0, 1, At, B1); PG8_BAR; PG8_SCHED;
            PG8_LDA(At, 0, 1); PG8_STAGE(PG8_SB(0, 0), b2, voffB); PG8_STAGE(PG8_SB(0, 1), b2 + hstep, voffB); PG8_STAGE(PG8_SA(0, 0), a2, voffA);
            PG8_WAIT_V(8); PG8_WAIT_L(0); PG8_BAR; PG8_MMA(1, 0, At, B0); PG8_MMA(1, 1, At, B1); PG8_BAR; PG8_SCHED;
            PG8_LDB(B0, 1, 0); PG8_LDB(B1, 1, 1); PG8_SCHED; PG8_LDA(At, 1, 0); PG8_STAGE(PG8_SA(0, 1), a2 + hstep, voffA);
            PG8_WAIT_V(8); PG8_WAIT_L(0); PG8_BAR; PG8_MMA(0, 0, At, B0); PG8_MMA(0, 1, At, B1); PG8_BAR; PG8_SCHED;
            PG8_LDA(At, 1, 1); PG8_STAGE(PG8_SB(1, 0), b3, voffB); PG8_STAGE(PG8_SB(1, 1), b3 + hstep, voffB); PG8_STAGE(PG8_SA(1, 0), a3, voffA);
            PG8_WAIT_V(8); PG8_WAIT_L(0); PG8_BAR; PG8_MMA(1, 0, At, B0); PG8_MMA(1, 1, At, B1); PG8_BAR; PG8_SCHED;
            } else {
            PG8_LDB(B0, 0, 0); PG8_SCHED; PG8_LDA(At, 0, 0); PG8_STAGE(PG8_SA(1, 1), a1 + hstep, voffA);
            PG8_WAIT_L(8); PG8_BAR; PG8_WAIT_L(0); PG8_MMA(0, 0, At, B0); PG8_BAR; PG8_SCHED;
            PG8_LDB(B1, 0, 1); PG8_STAGE(PG8_SB(0, 0), b2, voffB);
            PG8_BAR; PG8_WAIT_L(0); PG8_MMA(0, 1, At, B1); PG8_BAR;
            PG8_LDA(At, 0, 1); PG8_STAGE(PG8_SA(0, 0), a2, voffA);
            PG8_BAR; PG8_WAIT_L(0); PG8_MMA(1, 0, At, B0); PG8_BAR; PG8_SCHED;
            PG8_STAGE(PG8_SB(0, 1), b2 + hstep, voffB);
            PG8_WAIT_V(6); PG8_BAR; PG8_MMA(1, 1, At, B1); PG8_BAR;
            PG8_LDB(B0, 1, 0); PG8_SCHED; PG8_LDA(At, 1, 0); PG8_STAGE(PG8_SA(0, 1), a2 + hstep, voffA);
            PG8_WAIT_L(8); PG8_BAR; PG8_WAIT_L(0); PG8_MMA(0, 0, At, B0); PG8_BAR; PG8_SCHED;
            PG8_LDB(B1, 1, 1); PG8_STAGE(PG8_SB(1, 0), b3, voffB);
            PG8_BAR; PG8_WAIT_L(0); PG8_MMA(0, 1, At, B1); PG8_BAR;
            PG8_LDA(At, 1, 1); PG8_STAGE(PG8_SA(1, 0), a3, voffA);
            PG8_BAR; PG8_WAIT_L(0); PG8_MMA(1, 0, At, B0); PG8_BAR; PG8_SCHED;
            PG8_STAGE(PG8_SB(1, 1), b3 + hstep, voffB);
            PG8_WAIT_V(6); PG8_BAR; PG8_MMA(1, 1, At, B1); PG8_BAR;
            }
        }
        if constexpr (ALIGN_EPI) { if (wr == 0) PG8_BAR; }
        if constexpr (!Epi::AFTER_DRAIN) { E(acc, cur, wr, wc, fr, fq); S.done(cur); }
        if (!has_next) break;
#pragma unroll
        for (int a = 0; a < 2; ++a)
#pragma unroll
            for (int b = 0; b < 2; ++b)
#pragma unroll
                for (int m = 0; m < 4; ++m)
#pragma unroll
                    for (int n = 0; n < 2; ++n) acc[a][b][m][n] = (f32x4){0.f, 0.f, 0.f, 0.f};
        cur = nxt; cA = nA; cB = nB; ++ui;
        if constexpr (ALIGN_EPI) { if (wr == 1) PG8_BAR; }
    }
    PG8_WAIT_V(0);
    if constexpr (!ALIGN_EPI) { if (wr == 0) PG8_BAR; }
    PG8_BAR;
    if constexpr (Epi::AFTER_DRAIN) { E.fused(acc, cur, wr, wc, fr, fq, lds, wid, lane); S.done(cur); }
#undef PG8_SA
#undef PG8_SB
#undef PG8_STAGE
#undef PG8_LDA
#undef PG8_LDB
#undef PG8_MMA
#undef PG8_WAIT_V
#undef PG8_WAIT_L
#undef PG8_BAR
#undef PG8_SCHED
}
}

#ifndef PG8_SP2
#define PG8_SP2 true
#endif
#ifndef PG8_ALIGN
#define PG8_ALIGN true
#endif
#define GAS __attribute__((address_space(1)))
#define LAS __attribute__((address_space(3)))
typedef unsigned short bf16;
typedef unsigned v4u __attribute__((ext_vector_type(4)));
typedef unsigned v2u __attribute__((ext_vector_type(2)));
typedef float f32x4 __attribute__((ext_vector_type(4)));
typedef float f32x2 __attribute__((ext_vector_type(2)));
typedef GAS unsigned gu32;
#define RLX_AGENT __ATOMIC_RELAXED, __HIP_MEMORY_SCOPE_AGENT
#define LDS_WAIT() asm volatile("s_waitcnt lgkmcnt(0)" ::: "memory")
#define VM_WAIT() asm volatile("s_waitcnt vmcnt(0)" ::: "memory")
__device__ __forceinline__ unsigned pk2(float lo, float hi) { return pg8::cvt_pk_bf16(lo, hi); }
__device__ __forceinline__ float bflo(unsigned w) { return __uint_as_float(w << 16); }
__device__ __forceinline__ float bfhi(unsigned w) { return __uint_as_float(w & 0xffff0000u); }
__device__ __forceinline__ float bf1(unsigned short h) { return __uint_as_float((unsigned)h << 16); }

#define XB_TMO      128
#define XB_XCNT(j)  (256  + 64 * (j))
#define XB_XSUB(j)  (1280 + 64 * (j))
#define XB_XGEN(j)  (2304 + 64 * (j))
#define XB_TOP      3328
#define XB_TOPGEN   3392
#define XCD_BAR_WORDS 3456
#define XB_SPIN_CAP (1u << 18)

__device__ __forceinline__ unsigned xb_ld(unsigned* p)              { return __hip_atomic_load(p, __ATOMIC_RELAXED, __HIP_MEMORY_SCOPE_AGENT); }
__device__ __forceinline__ unsigned xb_add(unsigned* p, unsigned v) { return __hip_atomic_fetch_add(p, v, __ATOMIC_RELAXED, __HIP_MEMORY_SCOPE_AGENT); }
__device__ __forceinline__ unsigned xb_xcc_id() { return (unsigned)__builtin_amdgcn_s_getreg((3 << 11) | 20) & 0xFu; }
#define XB_SPIN(cond, bar) do { unsigned _sp = 0; while (cond) { __builtin_amdgcn_s_sleep(1); \
    if ((++_sp & 255u) == 0u) { if (xb_ld(&(bar)[XB_TMO])) break; if (_sp > XB_SPIN_CAP) { atomicAdd(&(bar)[XB_TMO], 1u); break; } } } } while (0)

struct XcdBarrier {
    unsigned* bar; unsigned x;
    volatile LAS unsigned* st;
};

__device__ __forceinline__ XcdBarrier xcd_barrier_post(unsigned* bar, volatile LAS unsigned* st) {
    XcdBarrier b; b.bar = bar; b.x = xb_xcc_id(); b.st = st;
    if (threadIdx.x == 0) (void)xb_add(&bar[XB_XCNT(b.x)], 1u);
    return b;
}
__device__ __forceinline__ void xcd_barrier_complete(unsigned* bar, unsigned x, unsigned& nloc, unsigned& nx) {
    const unsigned G = gridDim.x * gridDim.y * gridDim.z;
    unsigned sum, cnt, mine, sp = 0u;
    for (;;) {
        sum = 0u; cnt = 0u; mine = 0u;
#pragma unroll
        for (unsigned j = 0; j < 16; ++j) { const unsigned c = xb_ld(&bar[XB_XCNT(j)]); sum += c; cnt += (c > 0u) ? 1u : 0u; mine = (j == x) ? c : mine; }
        if (sum == G) break;
        __builtin_amdgcn_s_sleep(1);
        if ((++sp & 255u) == 0u) { if (xb_ld(&bar[XB_TMO])) break; if (sp > XB_SPIN_CAP) { atomicAdd(&bar[XB_TMO], 1u); break; } }
    }
    nloc = mine > 0u ? mine : 1u; nx = cnt > 0u ? cnt : 1u;
}

__device__ __forceinline__ void xcd_barrier(const XcdBarrier& b) {
    asm volatile("s_waitcnt vmcnt(0)" ::: "memory");
    __syncthreads();
    if (threadIdx.x == 0) {
        unsigned* bar = b.bar;
        __builtin_amdgcn_s_waitcnt(0);
        unsigned nloc = b.st[0], nx = b.st[1];
        if (nloc == 0u) { xcd_barrier_complete(bar, b.x, nloc, nx); b.st[0] = nloc; b.st[1] = nx; }
        const unsigned old = xb_add(&bar[XB_XSUB(b.x)], 1u);
        const unsigned gen = old / nloc;
        if (old + 1u == (gen + 1u) * nloc) {
            __builtin_amdgcn_fence(__ATOMIC_RELEASE, "agent");
            asm volatile("s_waitcnt vmcnt(0)" ::: "memory");
            const unsigned og = xb_add(&bar[XB_TOP], 1u);
            const unsigned tg = og / nx;
            if (og + 1u == (tg + 1u) * nx) xb_add(&bar[XB_TOPGEN], 1u);
            else XB_SPIN(xb_ld(&bar[XB_TOPGEN]) == tg, bar);
            __builtin_amdgcn_fence(__ATOMIC_ACQUIRE, "agent");
            xb_add(&bar[XB_XGEN(b.x)], 1u);
            asm volatile("s_waitcnt vmcnt(0)" ::: "memory");
        } else {
            XB_SPIN(xb_ld(&bar[XB_XGEN(b.x)]) == gen, bar);
            __builtin_amdgcn_fence(__ATOMIC_ACQUIRE, "agent");
            asm volatile("s_waitcnt vmcnt(0)" ::: "memory");
        }
    }
    __syncthreads();
}

constexpr int NWAVES = 8, NTHR = 512;
constexpr int DM = 4096, SEQ = 16384, CTXL = 256, MT = SEQ + CTXL, FF = 11008, NGU = 2 * FF, DEPTH = 4;
constexpr int ADA_R = 256, NMOD = 6, MODW = NMOD * DM;
constexpr int QR = 1024, KVR = 512, ROPE = 64, NOPE = 128, VD = 128, NH = 32;
constexpr int MDN = QR + KVR + ROPE, MDNP = 1792;
constexpr int QW = NH * (NOPE + ROPE), KVW = NH * (NOPE + VD);
constexpr int FHP = 256;
constexpr float EPS = 1e-6f;
#ifndef MK_MULTI
#define MK_MULTI 0
#endif
#ifndef MK_PH_END
#define MK_PH_END 37
#endif
constexpr int N_PHASES = 37;

constexpr size_t WS_CTL = 0, CTL_BYTES = 1u << 20;
constexpr size_t WS_MOD = WS_CTL + CTL_BYTES;
#ifndef FF_PAD
#define FF_PAD 64
#endif
constexpr int FFP = FF + FF_PAD;
constexpr size_t SZ_WGU = (size_t)NGU * DM * 2, SZ_WD = (size_t)DM * FFP * 2, SZ_W3 = (size_t)3 * DM * DM * 2, SZ_SQ = (size_t)DM * DM * 2;
constexpr size_t WS_WGU = WS_MOD + (size_t)DEPTH * 2 * MODW * 4;
constexpr size_t WS_WD = WS_WGU + 4 * SZ_WGU;
constexpr size_t WS_SCIN = WS_WD + 4 * SZ_WD;
constexpr size_t WS_SCOUT = WS_SCIN + 2 * SZ_W3;
constexpr size_t WS_MDOWN = WS_SCOUT + 2 * SZ_SQ;
constexpr size_t WS_MUQ = WS_MDOWN + (size_t)MDNP * DM * 2;
constexpr size_t WS_MUKV = WS_MUQ + (size_t)QW * QR * 2;
constexpr size_t WS_MOUT = WS_MUKV + (size_t)KVW * KVR * 2;
constexpr size_t WS_HYIN = WS_MOUT + SZ_SQ;
constexpr size_t WS_HYOUT = WS_HYIN + SZ_W3;
constexpr size_t WS_W4T = WS_HYOUT + SZ_SQ;
constexpr size_t WS_HD3 = WS_W4T + (size_t)8192 * FHP * 2;
constexpr size_t WS_XC = WS_HD3 + (size_t)SEQ * FHP * 2;
constexpr size_t WS_HB = WS_XC + (size_t)CTXL * DM * 4;
constexpr size_t WS_U = WS_HB + (size_t)MT * DM * 2;
constexpr size_t WS_Z = WS_U + (size_t)MT * 3 * DM * 2;
constexpr size_t WS_Y = WS_Z + (size_t)MT * DM * 2;
constexpr size_t WS_D = WS_Y + (size_t)MT * DM * 2;
constexpr size_t WS_CQN = WS_D + (size_t)MT * MDNP * 4;
constexpr size_t WS_CKVN = WS_CQN + (size_t)MT * QR * 2;
constexpr size_t WS_KR = WS_CKVN + (size_t)MT * KVR * 2;
constexpr size_t WS_Q = WS_KR + (size_t)MT * ROPE * 2;
constexpr size_t WS_KV = WS_Q + (size_t)SEQ * QW * 2;
constexpr size_t WS_GT = WS_KV + (size_t)MT * KVW * 2;
constexpr size_t WS_VVT = WS_GT + (size_t)8192 * SEQ * 2;
constexpr size_t WS_YT = WS_VVT + (size_t)DM * SEQ * 2;
constexpr size_t WS_PART = WS_YT + (size_t)DM * SEQ * 2;
constexpr size_t WS_XB = WS_PART + (size_t)DEPTH * 64 * 2 * 256 * 4;
constexpr size_t WS_END = WS_XB + (size_t)SEQ * DM * 2;
static_assert(WS_WGU % 256 == 0 && WS_END % 256 == 0, "ws map alignment");
constexpr int CW_TMO = 0, CW_CODE = 1, CW_BAR = 4096, CW_T = 16384;

constexpr int LDS_BYTES = 163840;
constexpr int LDSCTL_OFF = 159744, MISC_OFF = LDSCTL_OFF + 320;
static_assert(MISC_OFF + 128 <= LDS_BYTES, "LDS map");


struct Frame {
    LAS unsigned char* lds;
    volatile LAS unsigned* MISC;
    gu32* ctl;
    int tid, lane, wave;
    int G;
};
__device__ __forceinline__ Frame fresh(const Frame& F) { Frame P = F; int t = F.tid; asm volatile("" : "+v"(t)); P.tid = t; P.lane = t & 63; return P; }
__device__ __forceinline__ float wave_sum(float v) {
#pragma unroll
    for (int o = 1; o < 64; o <<= 1) v += __shfl_xor(v, o);
    return v;
}
__device__ __forceinline__ void unpack8(const v4u w, float (&f)[8]) {
    f[0] = bflo(w.x); f[1] = bfhi(w.x); f[2] = bflo(w.y); f[3] = bfhi(w.y); f[4] = bflo(w.z); f[5] = bfhi(w.z); f[6] = bflo(w.w); f[7] = bfhi(w.w);
}
__device__ __forceinline__ v4u pack8f(const float (&f)[8]) { v4u w; w.x = pk2(f[0], f[1]); w.y = pk2(f[2], f[3]); w.z = pk2(f[4], f[5]); w.w = pk2(f[6], f[7]); return w; }

__device__ __forceinline__ void conv_item(const float* W, int N, bf16* WT, int KD, int k0, int n0, int drow0, LAS float* scr, int lane) {
#pragma unroll 8
    for (int i = 0; i < 32; ++i) { const int kk = 2 * i + (lane >> 5); scr[kk * 33 + (lane & 31)] = W[(size_t)(k0 + kk) * N + n0 + (lane & 31)]; }
    LDS_WAIT(); asm volatile("" ::: "memory");
    const int c = lane & 7;
#pragma unroll
    for (int j = 0; j < 4; ++j) { const int n = (lane >> 3) + 8 * j; const LAS float* s = scr + (8 * c) * 33 + n;
        v4u o; o.x = pk2(s[0 * 33], s[1 * 33]); o.y = pk2(s[2 * 33], s[3 * 33]); o.z = pk2(s[4 * 33], s[5 * 33]); o.w = pk2(s[6 * 33], s[7 * 33]);
        *(GAS v4u*)(WT + (size_t)(drow0 + n) * KD + k0 + 8 * c) = o; }
    LDS_WAIT(); asm volatile("" ::: "memory");
}
__device__ __forceinline__ int map_pair(int n0, int half) { return n0 < half ? ((n0 >> 7) * 256 + (n0 & 127)) : ((((n0 - half) >> 7) * 256) + 128 + ((n0 - half) & 127)); }
__device__ __forceinline__ int map_scin(int n0) { return n0 < DM ? (2 * DM + n0) : map_pair(n0 - DM, DM); }

struct Args { const float* in[32]; float* out; unsigned char* ws; int ph_lo, ph_hi; };

__device__ __forceinline__ void p0_prologue(Frame& F, const Args& A) {
    unsigned char* ws = A.ws;
    LAS float* scr = (LAS float*)(F.lds + F.wave * 16384);
    const int gw = blockIdx.x * NWAVES + F.wave, NGW = F.G * NWAVES, lane = F.lane;
    constexpr int I_GU = (DM / 64) * (NGU / 32), I_D = (FF / 64) * (DM / 32), I_3 = (DM / 64) * (3 * DM / 32), I_SQ = (DM / 64) * (DM / 32);
    constexpr int I_MD = (DM / 64) * (MDN / 32), I_UQ = (QR / 64) * (QW / 32), I_UKV = (KVR / 64) * (KVW / 32), I_W4 = 8192 / 32;
    constexpr int NITEMS = 4 * I_GU + 4 * I_D + 2 * I_3 + 2 * I_SQ + I_MD + I_UQ + I_UKV + I_SQ + I_3 + I_SQ + I_W4;
    for (int it = gw; it < NITEMS; it += NGW) {
        int r = it;
        if (r < 4 * I_GU) { const int L = r / I_GU, rr = r % I_GU, nblk = NGU / 32, kb = rr / nblk, n0 = (rr % nblk) * 32;
            conv_item(A.in[8] + (size_t)L * DM * NGU, NGU, (bf16*)(ws + WS_WGU + L * SZ_WGU), DM, kb * 64, n0, map_pair(n0, FF), scr, lane); continue; } r -= 4 * I_GU;
        if (r < 4 * I_D) { const int L = r / I_D, rr = r % I_D, nblk = DM / 32, kb = rr / nblk, n0 = (rr % nblk) * 32;
            conv_item(A.in[9] + (size_t)L * FF * DM, DM, (bf16*)(ws + WS_WD + L * SZ_WD), FFP, kb * 64, n0, n0, scr, lane); continue; } r -= 4 * I_D;
        if (r < 2 * I_3) { const int L = r / I_3, rr = r % I_3, nblk = 3 * DM / 32, kb = rr / nblk, n0 = (rr % nblk) * 32;
            conv_item(A.in[10] + (size_t)L * DM * 3 * DM, 3 * DM, (bf16*)(ws + WS_SCIN + L * SZ_W3), DM, kb * 64, n0, map_scin(n0), scr, lane); continue; } r -= 2 * I_3;
        if (r < 2 * I_SQ) { const int L = r / I_SQ, rr = r % I_SQ, nblk = DM / 32, kb = rr / nblk, n0 = (rr % nblk) * 32;
            conv_item(A.in[12] + (size_t)L * DM * DM, DM, (bf16*)(ws + WS_SCOUT + L * SZ_SQ), DM, kb * 64, n0, n0, scr, lane); continue; } r -= 2 * I_SQ;
        if (r < I_MD) { const int nblk = MDN / 32, kb = r / nblk, n0 = (r % nblk) * 32;
            conv_item(A.in[13], MDN, (bf16*)(ws + WS_MDOWN), DM, kb * 64, n0, n0, scr, lane); continue; } r -= I_MD;
        if (r < I_UQ) { const int nblk = QW / 32, kb = r / nblk, n0 = (r % nblk) * 32;
            conv_item(A.in[16], QW, (bf16*)(ws + WS_MUQ), QR, kb * 64, n0, n0, scr, lane); continue; } r -= I_UQ;
        if (r < I_UKV) { const int nblk = KVW / 32, kb = r / nblk, n0 = (r % nblk) * 32;
            conv_item(A.in[17], KVW, (bf16*)(ws + WS_MUKV), KVR, kb * 64, n0, n0, scr, lane); continue; } r -= I_UKV;
        if (r < I_SQ) { const int nblk = DM / 32, kb = r / nblk, n0 = (r % nblk) * 32;
            conv_item(A.in[18], DM, (bf16*)(ws + WS_MOUT), DM, kb * 64, n0, n0, scr, lane); continue; } r -= I_SQ;
        if (r < I_3) { const int nblk = 3 * DM / 32, kb = r / nblk, n0 = (r % nblk) * 32;
            conv_item(A.in[19], 3 * DM, (bf16*)(ws + WS_HYIN), DM, kb * 64, n0, n0, scr, lane); continue; } r -= I_3;
        if (r < I_SQ) { const int nblk = DM / 32, kb = r / nblk, n0 = (r % nblk) * 32;
            conv_item(A.in[31], DM, (bf16*)(ws + WS_HYOUT), DM, kb * 64, n0, n0, scr, lane); continue; } r -= I_SQ;
        { const int n0 = r * 32; conv_item(A.in[29], 8192, (bf16*)(ws + WS_W4T), FHP, 0, n0, n0, scr, lane); }
    }
    const int gt = blockIdx.x * NTHR + F.tid, NGT = F.G * NTHR;
    { GAS v4u* z = (GAS v4u*)(ws + WS_MDOWN + (size_t)MDN * DM * 2); const int nz = (MDNP - MDN) * DM * 2 / 16;
      for (int i = gt; i < nz; i += NGT) z[i] = (v4u){0u, 0u, 0u, 0u}; }
    { const int nz = 8192 * 24;
      for (int i = gt; i < nz; i += NGT) { const int row = i / 24, ch = i % 24; *(GAS v4u*)(ws + WS_W4T + (size_t)row * FHP * 2 + 128 + ch * 16) = (v4u){0u, 0u, 0u, 0u}; } }
    { float* PART = (float*)(ws + WS_PART); const float* cl = A.in[1]; const float* cc = A.in[3];
      for (int it = blockIdx.x; it < 128; it += F.G) { const int L = it >> 5, kc = it & 31, j = F.tid & 255, kh = F.tid >> 8, k0 = kc * 128 + kh * 64;
          const float* wd = A.in[4] + (size_t)L * DM * ADA_R; float al = 0.f, ac = 0.f;
#pragma unroll 8
          for (int kk = 0; kk < 64; ++kk) { const int k = k0 + kk; const float w = wd[(size_t)k * ADA_R + j]; const float a = cl[k], b = cc[k];
              al += (a / (1.f + expf(-a))) * w; ac += (b / (1.f + expf(-b))) * w; }
          float* p = PART + ((size_t)(L * 64 + kc * 2 + kh) * 2) * 256 + j; p[0] = al; p[256] = ac; } }
    __syncthreads();
    { LAS float* W1 = (LAS float*)F.lds; LAS float* W2 = W1 + 33 * 64; LAS float* W3 = W2 + 4096;
      for (int i = F.tid; i < 33 * 64; i += NTHR) W1[i] = A.in[22][i];
      for (int i = F.tid; i < 4096; i += NTHR) { W2[i] = A.in[24][i]; W3[i] = A.in[26][i]; }
      __syncthreads();
      const float b1 = A.in[23][lane], b2 = A.in[25][lane], b3 = A.in[27][lane], f0 = A.in[28][lane], f1 = A.in[28][64 + lane], f2 = A.in[28][128 + lane];
      bf16* HD3 = (bf16*)(ws + WS_HD3);
      const float bstep = (15.0f - 1e-4f) / 15.0f;
      for (int p = gw; p < SEQ; p += NGW) {
          const float tl = (float)p * (1.0f / 16383.0f), w = (float)p * (6.283185307179586f / 16384.0f);
          float z = 0.f;
          if (lane == 0) z = tl; else if (lane <= 16) z = cosf((1e-4f + (float)(lane - 1) * bstep) * w); else if (lane <= 32) z = -sinf((1e-4f + (float)(lane - 17) * bstep) * w);
          float a = b1;
#pragma unroll
          for (int i = 0; i < 33; ++i) a += __uint_as_float(__builtin_amdgcn_readlane(__float_as_uint(z), i)) * W1[i * 64 + lane];
          const float h1 = sinf(f0 * a); a = b2;
#pragma unroll
          for (int i = 0; i < 64; ++i) a += __uint_as_float(__builtin_amdgcn_readlane(__float_as_uint(h1), i)) * W2[i * 64 + lane];
          const float h2 = sinf(f1 * a); a = b3;
#pragma unroll
          for (int i = 0; i < 64; ++i) a += __uint_as_float(__builtin_amdgcn_readlane(__float_as_uint(h2), i)) * W3[i * 64 + lane];
          const float h3 = sinf(f2 * a);
          bf16* o = HD3 + (size_t)p * FHP + lane; o[0] = (bf16)(pk2(h3, 0.f) & 0xffffu); o[64] = 0; o[128] = 0; o[192] = 0; }
    }
}
__device__ __forceinline__ void p1_adaln(Frame& F, const Args& A) {
    LAS float* Tl = (LAS float*)F.lds; const float* PART = (const float*)(A.ws + WS_PART); float* MOD = (float*)(A.ws + WS_MOD);
    for (int it = blockIdx.x; it < DEPTH * 2 * 48; it += F.G) { const int L = it / 96, rem = it % 96, r = rem / 48, col = (rem % 48) * 512 + F.tid;
        __syncthreads(); if (F.tid < 256) { float t = 0.f; for (int i = 0; i < 64; ++i) t += PART[((size_t)(L * 64 + i) * 2 + r) * 256 + F.tid]; Tl[F.tid] = t; } __syncthreads();
        const float* up = A.in[5] + (size_t)L * ADA_R * MODW + col; float a = A.in[6][L * MODW + col];
#pragma unroll 8
        for (int j = 0; j < ADA_R; ++j) a += Tl[j] * up[(size_t)j * MODW];
        MOD[(size_t)(L * 2 + r) * MODW + col] = a; }
}
template <bool HAS_Y, bool HAS_H, int XS, int XD>
__device__ __forceinline__ void row_phase(Frame& F, int row_lo, int row_hi, int bid, int nb, const void* xs_l, const void* xs_c, void* xd_l, void* xd_c, const bf16* Y,
                                          const float* gate_l, const float* gate_c, const float* gy, bf16* HB, const float* gh,
                                          const float* shift_l, const float* shift_c, const float* scale_l, const float* scale_c) {
    const int gw = bid * NWAVES + F.wave, NGW = nb * NWAVES;
    LAS float* const LV = (LAS float*)F.lds;
    __syncthreads();
    for (int i = F.tid; i < 2 * 1024; i += NTHR) { const int r = i >> 10, c4 = (i & 1023) * 4;
        if (r == 0 ? (row_lo < SEQ) : (row_hi > SEQ)) {
            if (HAS_Y) { const f32x4 g = *(const GAS f32x4*)((r ? gate_c : gate_l) + c4), gg = *(const GAS f32x4*)(gy + c4); *(LAS f32x4*)(LV + (0 + r) * DM + c4) = g * gg; }
            if (HAS_H) { const f32x4 g = *(const GAS f32x4*)(gh + c4), s1 = *(const GAS f32x4*)((r ? scale_c : scale_l) + c4), s0 = *(const GAS f32x4*)((r ? shift_c : shift_l) + c4);
                *(LAS f32x4*)(LV + (2 + r) * DM + c4) = g * (s1 + 1.0f); *(LAS f32x4*)(LV + (4 + r) * DM + c4) = s0; } } }
    __syncthreads();
#define ROW_FENCE(j) do { if (((j) & 3) == 3) asm volatile("" ::: "memory"); } while (0)
    for (int row = row_lo + gw; row < row_hi; row += NGW) {
        int lane_ = F.lane; asm volatile("" : "+v"(lane_)); const int lane = lane_;
        const bool isc = row >= SEQ;
        const bf16* yr = Y + (size_t)row * DM;
        float rn = 0.f;
        v2u yk[16], xk[16];
        const bf16* xsb0 = (const bf16*)xs_l + (size_t)row * DM;
        if (HAS_Y) { float ss = 0.f;
#pragma unroll
            for (int j = 0; j < 16; ++j) { const v2u w = *(const GAS v2u*)(yr + 256 * j + 4 * lane); yk[j] = w; if (XS == 1) xk[j] = *(const GAS v2u*)(xsb0 + 256 * j + 4 * lane);
                const float a = bflo(w.x), b = bfhi(w.x), c = bflo(w.y), d = bfhi(w.y); ss += (a * a + b * b) + (c * c + d * d); ROW_FENCE(j); }
            rn = rsqrtf(wave_sum(ss) * (1.0f / DM) + EPS); }
        f32x4 xv[16]; float ssx = 0.f;
        const float* xsf = (const float*)(isc ? xs_c : xs_l) + (isc ? (size_t)(row - SEQ) * DM : (size_t)row * DM); const bf16* xsb = (const bf16*)xs_l + (size_t)row * DM;
        const LAS float* lv = LV + (isc ? DM : 0) + 4 * lane;
        bf16* xdb = (bf16*)xd_l + (size_t)row * DM; float* xdf = (float*)(isc ? xd_c : xd_l) + (isc ? (size_t)(row - SEQ) * DM : (size_t)row * DM);
#pragma unroll
        for (int j = 0; j < 16; ++j) {
            f32x4 x;
            if (XS == 0) x = *(const GAS f32x4*)(xsf + 256 * j + 4 * lane);
            else { const v2u w = HAS_Y ? xk[j] : *(const GAS v2u*)(xsb + 256 * j + 4 * lane); x = (f32x4){bflo(w.x), bfhi(w.x), bflo(w.y), bfhi(w.y)}; }
            if (HAS_Y) { const v2u w = yk[j]; const f32x4 yv = (f32x4){bflo(w.x), bfhi(w.x), bflo(w.y), bfhi(w.y)};
                const f32x4 v1 = *(const LAS f32x4*)(lv + 256 * j);
                x = x + (yv * rn) * v1; }
            if (XD == 1) { v2u o; o.x = pk2(x.x, x.y); o.y = pk2(x.z, x.w); *(GAS v2u*)(xdb + 256 * j + 4 * lane) = o; }
            else if (XD == 2) *(GAS f32x4*)(xdf + 256 * j + 4 * lane) = x;
            ssx += (x.x * x.x + x.y * x.y) + (x.z * x.z + x.w * x.w); xv[j] = x; ROW_FENCE(j);
        }
        if (HAS_H) {
            const float rh = rsqrtf(wave_sum(ssx) * (1.0f / DM) + EPS);
            bf16* hr = HB + (size_t)row * DM;
#pragma unroll
            for (int j = 0; j < 16; ++j) { const f32x4 v2 = *(const LAS f32x4*)(lv + 2 * DM + 256 * j), v3 = *(const LAS f32x4*)(lv + 4 * DM + 256 * j);
                const f32x4 h = (xv[j] * rh) * v2 + v3; v2u o; o.x = pk2(h.x, h.y); o.y = pk2(h.z, h.w);
                *(GAS v2u*)(hr + 256 * j + 4 * lane) = o; ROW_FENCE(j); }
        }
    }
#undef ROW_FENCE
}
__device__ __forceinline__ void sc_conv_phase(Frame& F, int row_lo, int row_hi, int bid, int nb, const bf16* P, const bf16* Bq, const float* wc, bf16* Z) {
    const int gw = bid * NWAVES + F.wave, NGW = nb * NWAVES, lane = F.lane; const int items = ((row_hi - row_lo) / 32) * 8;
    for (int it = gw; it < items; it += NGW) { const int r0 = row_lo + (it >> 3) * 32, c0 = (it & 7) * 512 + lane * 8;
        const int seg_lo = r0 < SEQ ? 0 : SEQ, seg_hi = r0 < SEQ ? SEQ : MT;
        float w0[8], w1[8], w2[8];
        { const f32x4 a = *(const f32x4*)(wc + c0), b = *(const f32x4*)(wc + c0 + 4); w0[0] = a.x; w0[1] = a.y; w0[2] = a.z; w0[3] = a.w; w0[4] = b.x; w0[5] = b.y; w0[6] = b.z; w0[7] = b.w; }
        { const f32x4 a = *(const f32x4*)(wc + DM + c0), b = *(const f32x4*)(wc + DM + c0 + 4); w1[0] = a.x; w1[1] = a.y; w1[2] = a.z; w1[3] = a.w; w1[4] = b.x; w1[5] = b.y; w1[6] = b.z; w1[7] = b.w; }
        { const f32x4 a = *(const f32x4*)(wc + 2 * DM + c0), b = *(const f32x4*)(wc + 2 * DM + c0 + 4); w2[0] = a.x; w2[1] = a.y; w2[2] = a.z; w2[3] = a.w; w2[4] = b.x; w2[5] = b.y; w2[6] = b.z; w2[7] = b.w; }
        float pv[8], cu[8], nx[8], bq[8], o[8];
        if (r0 == seg_lo) {
#pragma unroll
            for (int e = 0; e < 8; ++e) pv[e] = 0.f;
        } else unpack8(*(const GAS v4u*)(P + (size_t)(r0 - 1) * DM + c0), pv);
        unpack8(*(const GAS v4u*)(P + (size_t)r0 * DM + c0), cu);
        for (int r = r0; r < r0 + 32; ++r) {
            if (r + 1 < seg_hi) unpack8(*(const GAS v4u*)(P + (size_t)(r + 1) * DM + c0), nx);
            else {
#pragma unroll
                for (int e = 0; e < 8; ++e) nx[e] = 0.f;
            }
            unpack8(*(const GAS v4u*)(Bq + (size_t)r * DM + c0), bq);
#pragma unroll
            for (int e = 0; e < 8; ++e) { o[e] = bq[e] * (w0[e] * pv[e] + w1[e] * cu[e] + w2[e] * nx[e]); pv[e] = cu[e]; cu[e] = nx[e]; }
            *(GAS v4u*)(Z + (size_t)r * DM + c0) = pack8f(o);
        }
    }
}
__device__ __forceinline__ void mla_row_phase(Frame& F, const float* D, const float* qn, const float* kvn, bf16* CQN, bf16* CKVN, bf16* KR) {
    const int gw = blockIdx.x * NWAVES + F.wave, NGW = F.G * NWAVES, lane = F.lane;
    for (int row = gw; row < MT; row += NGW) { const float* d = D + (size_t)row * MDNP;
        f32x4 q[4]; float ss = 0.f;
#pragma unroll
        for (int j = 0; j < 4; ++j) { q[j] = *(const GAS f32x4*)(d + 256 * j + 4 * lane); ss += (q[j].x * q[j].x + q[j].y * q[j].y) + (q[j].z * q[j].z + q[j].w * q[j].w); }
        const float rq = rsqrtf(wave_sum(ss) * (1.0f / QR) + EPS);
#pragma unroll
        for (int j = 0; j < 4; ++j) { const f32x4 g = *(const f32x4*)(qn + 256 * j + 4 * lane); const f32x4 h = (q[j] * rq) * g; v2u o; o.x = pk2(h.x, h.y); o.y = pk2(h.z, h.w);
            *(GAS v2u*)(CQN + (size_t)row * QR + 256 * j + 4 * lane) = o; }
        f32x4 k[2]; ss = 0.f;
#pragma unroll
        for (int j = 0; j < 2; ++j) { k[j] = *(const GAS f32x4*)(d + QR + 256 * j + 4 * lane); ss += (k[j].x * k[j].x + k[j].y * k[j].y) + (k[j].z * k[j].z + k[j].w * k[j].w); }
        const float rk = rsqrtf(wave_sum(ss) * (1.0f / KVR) + EPS);
#pragma unroll
        for (int j = 0; j < 2; ++j) { const f32x4 g = *(const f32x4*)(kvn + 256 * j + 4 * lane); const f32x4 h = (k[j] * rk) * g; v2u o; o.x = pk2(h.x, h.y); o.y = pk2(h.z, h.w);
            *(GAS v2u*)(CKVN + (size_t)row * KVR + 256 * j + 4 * lane) = o; }
        const float v = *(const GAS float*)(d + QR + KVR + lane); const float pt = __shfl_xor(v, 16); float out = v;
        if (row < SEQ) { const int i = lane & 15; const float pos = (float)((lane < 32) ? (row >> 6) : (row & 63));
            const float ang = pos * exp2f(-(float)i * 0.83048202372184059f); const float cs = cosf(ang), sn = sinf(ang);
            out = (lane & 16) ? (v * cs + pt * sn) : (v * cs - pt * sn); }
        KR[(size_t)row * ROPE + lane] = (bf16)(pk2(out, 0.f) & 0xffffu);
    }
}

namespace att {
using bf16x8 = __attribute__((ext_vector_type(8))) short;
using s16x4  = __attribute__((ext_vector_type(4))) short;
using f32x16 = __attribute__((ext_vector_type(16))) float;
using u32x4  = __attribute__((ext_vector_type(4))) unsigned;
constexpr int NW = 8, QBLK = 32, KVBLK = 64;
constexpr float SCALE_DEF = 0.07216878364870322f, SCALE = SCALE_DEF;
constexpr float THR = 8.f;
#ifndef ATT_AUG
#define ATT_AUG 1
#endif
constexpr bool ATT_AUG_ON = (ATT_AUG != 0);
constexpr float QC = SCALE_DEF * 1.4426950408889634f;
#ifndef ATT_SDEPTH
#define ATT_SDEPTH 1
#endif
constexpr int SDEPTH = ATT_SDEPTH;
constexpr int LDQ = 6144, LDK = 8192, LDR = 64, LDO = 4096;
constexpr int SHM_V = KVBLK * 128 * 2, SHM_K = KVBLK * 128 * 2, SHM_R = KVBLK * 64 * 2;
#ifndef ATT_NBUF
#define ATT_NBUF 3
#endif
constexpr int NBUF = ATT_NBUF;
static_assert(NBUF == 2 || (NBUF == 3 && SDEPTH == 1), "3 buffers use the single staging slot");
constexpr int OFF_V = 0, OFF_K = NBUF * SHM_V, OFF_R = OFF_K + NBUF * SHM_K, OFF_WS = OFF_R + NBUF * SHM_R, OFF_QR = OFF_WS + NW * 64 * 4, LDS_NEED = OFF_QR + NW * 4096;
#define KSWZ(row, colB) ((row) * 256 + ((colB) ^ (((row) & 15) << 4)))
#define RSWZ(row, colB) ((row) * 128 + ((colB) ^ ((((row) >> 1) & 7) << 4)))
#define SBAR() __builtin_amdgcn_sched_barrier(0)
__device__ __forceinline__ int crow(int r, int hi) { return (r & 3) + 8 * (r >> 2) + 4 * hi; }
__device__ __forceinline__ unsigned cvtpk(float lo, float hi) { unsigned r; asm volatile("v_cvt_pk_bf16_f32 %0, %1, %2" : "=v"(r) : "v"(lo), "v"(hi)); return r; }
__device__ __forceinline__ bf16x8 ld8(const unsigned short* p) { return *reinterpret_cast<const bf16x8*>(p); }

__device__ __forceinline__ void partialSM(f32x16& p0, f32x16& p1, float& m_reg, float& mn, float& alpha) {
  constexpr float C = SCALE * 1.4426950408889634f;
  float pmax = p0[0]; for (int r = 1; r < 16; ++r) pmax = fmaxf(pmax, p0[r]); for (int r = 0; r < 16; ++r) pmax = fmaxf(pmax, p1[r]);
  { auto rr = __builtin_amdgcn_permlane32_swap(__float_as_uint(pmax), __float_as_uint(pmax), false, false);
    pmax = fmaxf(__uint_as_float(rr[0]), __uint_as_float(rr[1])); }
  if (__builtin_expect(__all(pmax - m_reg <= THR / SCALE), 1)) { mn = m_reg; alpha = 1.f; }
  else { mn = fmaxf(m_reg, pmax); alpha = __builtin_amdgcn_exp2f((m_reg - mn) * C); m_reg = mn; }
  float mnC = -mn * C;
  for (int r = 0; r < 16; ++r) p0[r] = fmaf(p0[r], C, mnC); for (int r = 0; r < 16; ++r) p1[r] = fmaf(p1[r], C, mnC);
  for (int r = 0; r < 16; ++r) p0[r] = __builtin_amdgcn_exp2f(p0[r]);
}
__device__ __forceinline__ void finishSM(f32x16& p0, f32x16& p1, float alpha, float& l_reg, bf16x8& pa0, bf16x8& pa1, bf16x8& pa2, bf16x8& pa3) {
  for (int r = 0; r < 16; ++r) p1[r] = __builtin_amdgcn_exp2f(p1[r]);
  float ps = 0; for (int r = 0; r < 16; ++r) ps += p0[r]; for (int r = 0; r < 16; ++r) ps += p1[r];
  { auto rr = __builtin_amdgcn_permlane32_swap(__float_as_uint(ps), __float_as_uint(ps), false, false);
    ps = __uint_as_float(rr[0]) + __uint_as_float(rr[1]); }
  l_reg = l_reg * alpha + ps;
#define PK4(P, BASE, OUT) do { unsigned a0 = cvtpk(P[BASE + 0], P[BASE + 1]), a1 = cvtpk(P[BASE + 2], P[BASE + 3]);   \
    unsigned b0 = cvtpk(P[BASE + 4], P[BASE + 5]), b1 = cvtpk(P[BASE + 6], P[BASE + 7]);                              \
    auto r0 = __builtin_amdgcn_permlane32_swap(a0, b0, false, false); auto r1 = __builtin_amdgcn_permlane32_swap(a1, b1, false, false); \
    u32x4 w = {r0[0], r1[0], r0[1], r1[1]}; OUT = *reinterpret_cast<bf16x8*>(&w); } while (0)
  PK4(p0, 0, pa0); PK4(p0, 8, pa1); PK4(p1, 0, pa2); PK4(p1, 8, pa3);
#undef PK4
}
__device__ __forceinline__ void qkt(f32x16& p0, f32x16& p1, const char* Ks, const char* Rs, const bf16x8* qr, const char* Qf, int r32, int hi) {
  p0 = f32x16{}; p1 = f32x16{};
#pragma unroll
  for (int d0 = 0; d0 < 8; ++d0) { int cb = (d0 * 16 + hi * 8) * 2;
    bf16x8 b0 = *reinterpret_cast<const bf16x8*>(Ks + KSWZ(r32, cb));
    bf16x8 b1 = *reinterpret_cast<const bf16x8*>(Ks + KSWZ(32 + r32, cb));
    p0 = __builtin_amdgcn_mfma_f32_32x32x16_bf16(b0, qr[d0], p0, 0, 0, 0);
    p1 = __builtin_amdgcn_mfma_f32_32x32x16_bf16(b1, qr[d0], p1, 0, 0, 0); }
#pragma unroll
  for (int d0 = 0; d0 < 4; ++d0) { int cb = (d0 * 16 + hi * 8) * 2;
    bf16x8 b0 = *reinterpret_cast<const bf16x8*>(Rs + RSWZ(r32, cb));
    bf16x8 b1 = *reinterpret_cast<const bf16x8*>(Rs + RSWZ(32 + r32, cb));
    bf16x8 qf = *reinterpret_cast<const bf16x8*>(Qf + d0 * 1024);
    p0 = __builtin_amdgcn_mfma_f32_32x32x16_bf16(b0, qf, p0, 0, 0, 0);
    p1 = __builtin_amdgcn_mfma_f32_32x32x16_bf16(b1, qf, p1, 0, 0, 0); }
}
template <int D0> __device__ __forceinline__ void kld_pp(bf16x8& a0, bf16x8& a1, bf16x8& qf, const char* Ks, const char* Rs, const char* Qf, int r32, int hi) {
  if constexpr (D0 < 8) { const int cb = (D0 * 16 + hi * 8) * 2; a0 = *reinterpret_cast<const bf16x8*>(Ks + KSWZ(r32, cb)); a1 = *reinterpret_cast<const bf16x8*>(Ks + KSWZ(32 + r32, cb)); }
  else { const int cb = ((D0 - 8) * 16 + hi * 8) * 2; a0 = *reinterpret_cast<const bf16x8*>(Rs + RSWZ(r32, cb)); a1 = *reinterpret_cast<const bf16x8*>(Rs + RSWZ(32 + r32, cb));
         qf = *reinterpret_cast<const bf16x8*>(Qf + (D0 - 8) * 1024); }
}
__device__ __forceinline__ void qkt_pp(f32x16& p0, f32x16& p1, const char* Ks, const char* Rs, const bf16x8* qr, const char* Qf, int r32, int hi) {
  p0 = f32x16{}; p1 = f32x16{};
  bf16x8 xa0, xa1, xq, ya0, ya1, yq, za0, za1, zq;
  kld_pp<0>(xa0, xa1, xq, Ks, Rs, Qf, r32, hi); kld_pp<1>(ya0, ya1, yq, Ks, Rs, Qf, r32, hi);
  __builtin_amdgcn_sched_group_barrier(0x100, 4, 0);
#define QK_STEP(D0, A0, A1, Q, NA0, NA1, NQ) do { if constexpr ((D0) + 2 < 12) kld_pp<(D0) + 2>(NA0, NA1, NQ, Ks, Rs, Qf, r32, hi); \
    { const bf16x8 bq_ = (D0) < 8 ? qr[(D0) < 8 ? (D0) : 0] : Q; p0 = __builtin_amdgcn_mfma_f32_32x32x16_bf16(A0, bq_, p0, 0, 0, 0); p1 = __builtin_amdgcn_mfma_f32_32x32x16_bf16(A1, bq_, p1, 0, 0, 0); } \
    if constexpr ((D0) + 2 < 8) __builtin_amdgcn_sched_group_barrier(0x100, 2, 0); else if constexpr ((D0) + 2 < 12) __builtin_amdgcn_sched_group_barrier(0x100, 3, 0); \
    __builtin_amdgcn_sched_group_barrier(0x8, 2, 0); } while (0)
  QK_STEP(0, xa0, xa1, xq, za0, za1, zq); QK_STEP(1, ya0, ya1, yq, xa0, xa1, xq); QK_STEP(2, za0, za1, zq, ya0, ya1, yq);
  QK_STEP(3, xa0, xa1, xq, za0, za1, zq); QK_STEP(4, ya0, ya1, yq, xa0, xa1, xq); QK_STEP(5, za0, za1, zq, ya0, ya1, yq);
  QK_STEP(6, xa0, xa1, xq, za0, za1, zq); QK_STEP(7, ya0, ya1, yq, xa0, xa1, xq); QK_STEP(8, za0, za1, zq, ya0, ya1, yq);
  QK_STEP(9, xa0, xa1, xq, za0, za1, zq); QK_STEP(10, ya0, ya1, yq, xa0, xa1, xq); QK_STEP(11, za0, za1, zq, ya0, ya1, yq);
#undef QK_STEP
}
template <int D0> __device__ __forceinline__ void kld_pr(bf16x8& a0, bf16x8& a1, const char* Ks, const char* Rs, int r32, int hi) {
  if constexpr (D0 < 8) { const int cb = (D0 * 16 + hi * 8) * 2; a0 = *reinterpret_cast<const bf16x8*>(Ks + KSWZ(r32, cb)); a1 = *reinterpret_cast<const bf16x8*>(Ks + KSWZ(32 + r32, cb)); }
  else { const int cb = ((D0 - 8) * 16 + hi * 8) * 2; a0 = *reinterpret_cast<const bf16x8*>(Rs + RSWZ(r32, cb)); a1 = *reinterpret_cast<const bf16x8*>(Rs + RSWZ(32 + r32, cb)); }
}
__device__ __forceinline__ void qkt_pr(f32x16& p0, f32x16& p1, const char* Ks, const char* Rs, const bf16x8* qr, int r32, int hi) {
  p0 = f32x16{}; p1 = f32x16{};
  bf16x8 xa0, xa1, ya0, ya1, za0, za1;
  kld_pr<0>(xa0, xa1, Ks, Rs, r32, hi); kld_pr<1>(ya0, ya1, Ks, Rs, r32, hi);
  __builtin_amdgcn_sched_group_barrier(0x100, 4, 0);
#define QK_STEP(D0, A0, A1, NA0, NA1) do { if constexpr ((D0) + 2 < 12) kld_pr<(D0) + 2>(NA0, NA1, Ks, Rs, r32, hi); \
    p0 = __builtin_amdgcn_mfma_f32_32x32x16_bf16(A0, qr[D0], p0, 0, 0, 0); p1 = __builtin_amdgcn_mfma_f32_32x32x16_bf16(A1, qr[D0], p1, 0, 0, 0); \
    if constexpr ((D0) + 2 < 12) __builtin_amdgcn_sched_group_barrier(0x100, 2, 0); \
    __builtin_amdgcn_sched_group_barrier(0x8, 2, 0); } while (0)
  QK_STEP(0, xa0, xa1, za0, za1); QK_STEP(1, ya0, ya1, xa0, xa1); QK_STEP(2, za0, za1, ya0, ya1);
  QK_STEP(3, xa0, xa1, za0, za1); QK_STEP(4, ya0, ya1, xa0, xa1); QK_STEP(5, za0, za1, ya0, ya1);
  QK_STEP(6, xa0, xa1, za0, za1); QK_STEP(7, ya0, ya1, xa0, xa1); QK_STEP(8, za0, za1, ya0, ya1);
  QK_STEP(9, xa0, xa1, za0, za1); QK_STEP(10, ya0, ya1, xa0, xa1); QK_STEP(11, za0, za1, ya0, ya1);
#undef QK_STEP
}
__device__ __forceinline__ void qkt_aug(f32x16& p0, f32x16& p1, const char* Ks, const char* Rs, const bf16x8* qr, bf16x8 kone, bf16x8 qx, int r32, int hi) {
  p0 = __builtin_amdgcn_mfma_f32_32x32x16_bf16(kone, qx, f32x16{}, 0, 0, 0); p1 = __builtin_amdgcn_mfma_f32_32x32x16_bf16(kone, qx, f32x16{}, 0, 0, 0);
  bf16x8 xa0, xa1, ya0, ya1, za0, za1;
  kld_pr<0>(xa0, xa1, Ks, Rs, r32, hi); kld_pr<1>(ya0, ya1, Ks, Rs, r32, hi);
  __builtin_amdgcn_sched_group_barrier(0x100, 4, 0);
#define QK_STEP(D0, A0, A1, NA0, NA1) do { if constexpr ((D0) + 2 < 12) kld_pr<(D0) + 2>(NA0, NA1, Ks, Rs, r32, hi); \
    p0 = __builtin_amdgcn_mfma_f32_32x32x16_bf16(A0, qr[D0], p0, 0, 0, 0); p1 = __builtin_amdgcn_mfma_f32_32x32x16_bf16(A1, qr[D0], p1, 0, 0, 0); \
    if constexpr ((D0) + 2 < 12) __builtin_amdgcn_sched_group_barrier(0x100, 2, 0); \
    __builtin_amdgcn_sched_group_barrier(0x8, 2, 0); } while (0)
  QK_STEP(0, xa0, xa1, za0, za1); QK_STEP(1, ya0, ya1, xa0, xa1); QK_STEP(2, za0, za1, ya0, ya1);
  QK_STEP(3, xa0, xa1, za0, za1); QK_STEP(4, ya0, ya1, xa0, xa1); QK_STEP(5, za0, za1, ya0, ya1);
  QK_STEP(6, xa0, xa1, za0, za1); QK_STEP(7, ya0, ya1, xa0, xa1); QK_STEP(8, za0, za1, ya0, ya1);
  QK_STEP(9, xa0, xa1, za0, za1); QK_STEP(10, ya0, ya1, xa0, xa1); QK_STEP(11, za0, za1, ya0, ya1);
#undef QK_STEP
}
__device__ __forceinline__ void partialSM_aug(f32x16& p0, f32x16& p1, float& mq, float& alpha, bf16x8& qx, int hi, bool first) {
  constexpr float THR2 = THR * 1.4426950408889634f;
  float pmax = p0[0]; for (int r = 1; r < 16; ++r) pmax = fmaxf(pmax, p0[r]); for (int r = 0; r < 16; ++r) pmax = fmaxf(pmax, p1[r]);
  { auto rr = __builtin_amdgcn_permlane32_swap(__float_as_uint(pmax), __float_as_uint(pmax), false, false);
    pmax = fmaxf(__uint_as_float(rr[0]), __uint_as_float(rr[1])); }
  if (__builtin_expect(!first && __all(pmax <= THR2), 1)) { alpha = 1.f; }
  else { const float d = first ? pmax : fmaxf(pmax, 0.f);
    const float mnew = __uint_as_float(cvtpk(mq + d, 0.f) << 16); const float dr = mnew - mq; alpha = first ? 1.f : __builtin_amdgcn_exp2f(-dr); mq = mnew;
    for (int r = 0; r < 16; ++r) { p0[r] -= dr; p1[r] -= dr; }
    qx[0] = (hi == 0) ? (short)(cvtpk(-mq, 0.f) & 0xffffu) : (short)0; }
  for (int r = 0; r < 16; ++r) p0[r] = __builtin_amdgcn_exp2f(p0[r]);
}
__device__ __forceinline__ int v_st(int k, int c) { const int kk = (k & ~0xC) | ((k & 4) << 1) | ((k & 8) >> 1); return ((kk >> 3) * 4 + (c >> 5)) * 512 + ((kk & 7) * 32 + (c & 31)) * 2; }
__device__ __forceinline__ int v_rd_base(int lane) { return ((lane & 3) << 3) | (((lane >> 2) & 3) << 6) | (((lane >> 4) & 1) << 5) | (((lane >> 5) & 1) << 8); }
constexpr int v_rd_off(int d0, int ks, int half) { return d0 * 512 + ks * 4096 + half * 2048; }
template <int OFF> __device__ __forceinline__ s16x4 tr_read(int vb) {
  s16x4 r; asm volatile("ds_read_b64_tr_b16 %0, %1 offset:%2" : "=&v"(r) : "v"(vb), "i"(OFF) : "memory"); return r;
}
template <int D0> __device__ __forceinline__ void pv_one(f32x16& od, int vb, bf16x8 pa0, bf16x8 pa1, bf16x8 pa2, bf16x8 pa3) {
  const s16x4 l0 = tr_read<v_rd_off(D0, 0, 0)>(vb), h0 = tr_read<v_rd_off(D0, 0, 1)>(vb), l1 = tr_read<v_rd_off(D0, 1, 0)>(vb), h1 = tr_read<v_rd_off(D0, 1, 1)>(vb);
  const s16x4 l2 = tr_read<v_rd_off(D0, 2, 0)>(vb), h2 = tr_read<v_rd_off(D0, 2, 1)>(vb), l3 = tr_read<v_rd_off(D0, 3, 0)>(vb), h3 = tr_read<v_rd_off(D0, 3, 1)>(vb);
  asm volatile("s_waitcnt lgkmcnt(0)" ::: "memory"); SBAR();
#define PK(L, H) (bf16x8){L[0], L[1], L[2], L[3], H[0], H[1], H[2], H[3]}
  od = __builtin_amdgcn_mfma_f32_32x32x16_bf16(pa0, PK(l0, h0), od, 0, 0, 0);
  od = __builtin_amdgcn_mfma_f32_32x32x16_bf16(pa1, PK(l1, h1), od, 0, 0, 0);
  od = __builtin_amdgcn_mfma_f32_32x32x16_bf16(pa2, PK(l2, h2), od, 0, 0, 0);
  od = __builtin_amdgcn_mfma_f32_32x32x16_bf16(pa3, PK(l3, h3), od, 0, 0, 0);
#undef PK
}
__device__ __forceinline__ void pv_d0(f32x16* o, int vb, bf16x8 pa0, bf16x8 pa1, bf16x8 pa2, bf16x8 pa3) {
  pv_one<0>(o[0], vb, pa0, pa1, pa2, pa3); pv_one<1>(o[1], vb, pa0, pa1, pa2, pa3); pv_one<2>(o[2], vb, pa0, pa1, pa2, pa3); pv_one<3>(o[3], vb, pa0, pa1, pa2, pa3);
}
__device__ __forceinline__ float bfv(short s) { return __uint_as_float(((unsigned)(unsigned short)s) << 16); }
__device__ __forceinline__ void attn_unit(const unsigned short* Qb, const unsigned short* Kn, const unsigned short* Vh, const unsigned short* Kr, unsigned short* Ob, int t0, int seq, char* lds) {
  int tid_ = threadIdx.x; asm volatile("" : "+v"(tid_));
  const int tid = tid_, wid = tid >> 6, lane = tid & 63, r32 = lane & 31, hi = lane >> 5;
  char* V_lds = lds + OFF_V; char* K_lds = lds + OFF_K; char* R_lds = lds + OFF_R;
  float* ws = (float*)(lds + OFF_WS) + wid * 64; float* li_l = ws; float* al_l = ws + 32;
  float m_reg = -1e30f, l_reg = 0; f32x16 o[4] = {}; bf16x8 qr[12];
  { const unsigned oq = (unsigned)((wid * QBLK + r32) * LDQ + hi * 8);
#pragma unroll
    for (int d0 = 0; d0 < 8; ++d0) { qr[d0] = ld8(Qb + (oq + d0 * 16));
      if constexpr (ATT_AUG_ON) { u32x4 w_;
#pragma unroll
        for (int e = 0; e < 4; ++e) w_[e] = cvtpk(bfv(qr[d0][2 * e]) * QC, bfv(qr[d0][2 * e + 1]) * QC);
        qr[d0] = *reinterpret_cast<bf16x8*>(&w_); } } }
  {
    const int row = tid >> 1, ax = tid & 1, t = t0 + row; const float pos = (float)(ax ? (t & 63) : (t >> 6));
    const unsigned oqp = (unsigned)(row * LDQ + 128 + 32 * ax);
    const bf16x8 xa0 = ld8(Qb + oqp), xa1 = ld8(Qb + (oqp + 8)), xb0 = ld8(Qb + (oqp + 16)), xb1 = ld8(Qb + (oqp + 24));
    unsigned oa[8], ob[8];
#pragma unroll
    for (int jj = 0; jj < 8; ++jj) { float r1[2], r2[2];
#pragma unroll
      for (int e = 0; e < 2; ++e) { const int i = 2 * jj + e; const float ang = pos * exp2f(-(float)i * 0.83048202372184059f); const float cs = __cosf(ang), sn = __sinf(ang);
        const float a = bfv(i < 8 ? xa0[i & 7] : xa1[i & 7]), b = bfv(i < 8 ? xb0[i & 7] : xb1[i & 7]); r1[e] = a * cs - b * sn; r2[e] = b * cs + a * sn; }
      if constexpr (ATT_AUG_ON) { r1[0] *= QC; r1[1] *= QC; r2[0] *= QC; r2[1] *= QC; }
      oa[jj] = cvtpk(r1[0], r1[1]); ob[jj] = cvtpk(r2[0], r2[1]); }
    char* qd = lds + OFF_QR + (row >> 5) * 4096 + (row & 31) * 16;
    *(u32x4*)(qd + (2 * ax) * 1024)           = (u32x4){oa[0], oa[1], oa[2], oa[3]};
    *(u32x4*)(qd + (2 * ax) * 1024 + 512)     = (u32x4){oa[4], oa[5], oa[6], oa[7]};
    *(u32x4*)(qd + (2 * ax + 1) * 1024)       = (u32x4){ob[0], ob[1], ob[2], ob[3]};
    *(u32x4*)(qd + (2 * ax + 1) * 1024 + 512) = (u32x4){ob[4], ob[5], ob[6], ob[7]}; }
  const char* Qf = lds + OFF_QR + wid * 4096 + lane * 16;
  const int sr = tid >> 4, sc = (tid & 15) * 8, vst0 = v_st(sr, sc), vst1 = v_st(32 + sr, sc);
  const int rr = tid >> 3, rc = (tid & 7) * 8;
  const int vb0 = (int)(uintptr_t)V_lds + v_rd_base(lane);
  struct { bf16x8 vs0, vs1, ks0, ks1, rs; } sr_[SDEPTH];
  unsigned okv0 = (unsigned)(sr * LDK + sc), okv1 = (unsigned)((32 + sr) * LDK + sc), okr = (unsigned)(rr * LDR + rc);
  asm volatile("" : "+v"(okv0), "+v"(okv1), "+v"(okr));
#define SLOAD(i, k0) do { const unsigned short* vt_ = Vh + (size_t)(k0) * LDK; const unsigned short* kt_ = Kn + (size_t)(k0) * LDK; const unsigned short* rt_ = Kr + (size_t)(k0) * LDR; \
    sr_[i].vs0 = ld8(vt_ + okv0); sr_[i].vs1 = ld8(vt_ + okv1); sr_[i].ks0 = ld8(kt_ + okv0); sr_[i].ks1 = ld8(kt_ + okv1); sr_[i].rs = ld8(rt_ + okr); } while (0)
#ifndef ATT_PF
#define ATT_PF 0
#endif
  unsigned opf; { const int t_ = tid < 320 ? tid : tid - 320; const unsigned nx = tid < 320 ? 0u : 64u;
    opf = (t_ < 128) ? (unsigned)((nx + (t_ >> 1)) * LDK + (t_ & 1) * 64) : (t_ < 256 && tid < 320) ? (unsigned)(((t_ - 128) >> 1) * LDK + (t_ & 1) * 64) : (tid < 320) ? (unsigned)((t_ - 256) * LDR) : (unsigned)((nx + ((t_ - 128) >> 1)) * LDK + (t_ & 1) * 64); }
  asm volatile("" : "+v"(opf));
  const int pfsel = __builtin_amdgcn_readfirstlane(tid < 128 ? 0 : (tid < 256 ? 1 : (tid < 320 ? 2 : (tid < 448 ? 0 : 1))));
  unsigned pf_ = 0u;
#define PFETCH(k0) do { if (ATT_PF > 0) { asm volatile("" :: "v"(pf_)); const int kc_ = (k0) < seq - 128 ? (k0) : seq - 128; const unsigned short* pb_ = (pfsel == 0) ? Kn + (size_t)kc_ * LDK : (pfsel == 1) ? Vh + (size_t)kc_ * LDK : Kr + (size_t)kc_ * LDR; \
    pf_ = *(const __attribute__((address_space(1))) unsigned*)(pb_ + opf); } } while (0)
#define SWRITE(b, i) do { *(bf16x8*)(V_lds + (b) * SHM_V + vst0) = sr_[i].vs0;          \
    *(bf16x8*)(V_lds + (b) * SHM_V + vst1) = sr_[i].vs1; int kc = sc * 2;               \
    *(bf16x8*)(K_lds + (b) * SHM_K + KSWZ(sr, kc)) = sr_[i].ks0;                       \
    *(bf16x8*)(K_lds + (b) * SHM_K + KSWZ(32 + sr, kc)) = sr_[i].ks1;                  \
    *(bf16x8*)(R_lds + (b) * SHM_R + RSWZ(rr, rc * 2)) = sr_[i].rs; } while (0)
#define SWAIT() do { if constexpr (SDEPTH == 2) asm volatile("s_waitcnt vmcnt(5)" ::: "memory"); else if (ATT_PF == 0) asm volatile("s_waitcnt vmcnt(0)" ::: "memory"); } while (0)
#define RESC(a) do { if (__any((a) < 1.f)) { if (hi == 0) al_l[r32] = (a); asm volatile("s_waitcnt lgkmcnt(0)" ::: "memory"); \
    for (int d = 0; d < 4; ++d) for (int r = 0; r < 16; ++r) o[d][r] *= al_l[crow(r, hi)]; } } while (0)
#ifndef ATT_PP
#define ATT_PP 1
#endif
  if constexpr (ATT_PP != 0 && NBUF == 3) {
  const int half = __builtin_amdgcn_readfirstlane(wid >> 2);
  f32x16 p0, p1; float mn, al; bf16x8 pa0, pa1, pa2, pa3; const int NT = seq / KVBLK;
#ifndef ATT_DMA
#define ATT_DMA 1
#endif
  const int widu = __builtin_amdgcn_readfirstlane(wid);
  unsigned dk0, dk1, dv0, dv1, dr0;
  { { const int row = 4 * (2 * widu) + (lane >> 4), ch = (lane & 15) ^ (row & 15); dk0 = (unsigned)(row * LDK + ch * 8); }
    { const int row = 4 * (2 * widu + 1) + (lane >> 4), ch = (lane & 15) ^ (row & 15); dk1 = (unsigned)(row * LDK + ch * 8); }
    { const int sub = 2 * (2 * widu) + (lane >> 5), idx = lane & 31, kk = (sub >> 2) * 8 + (idx >> 2), k = (kk & ~0xC) | ((kk & 4) << 1) | ((kk & 8) >> 1), c = (sub & 3) * 32 + (idx & 3) * 8; dv0 = (unsigned)(k * LDK + c); }
    { const int sub = 2 * (2 * widu + 1) + (lane >> 5), idx = lane & 31, kk = (sub >> 2) * 8 + (idx >> 2), k = (kk & ~0xC) | ((kk & 4) << 1) | ((kk & 8) >> 1), c = (sub & 3) * 32 + (idx & 3) * 8; dv1 = (unsigned)(k * LDK + c); }
    { const int row = 8 * widu + (lane >> 3), ch = (lane & 7) ^ ((row >> 1) & 7); dr0 = (unsigned)(row * LDR + ch * 8); } }
  asm volatile("" : "+v"(dk0), "+v"(dk1), "+v"(dv0), "+v"(dv1), "+v"(dr0));
#define GLDS16(gp, lp) __builtin_amdgcn_global_load_lds((const unsigned*)(gp), (__attribute__((address_space(3))) unsigned*)(lp), 16, 0, 0)
#define DMA_TILE(b, k0) do { const unsigned short* vt_ = Vh + (size_t)(k0) * LDK; const unsigned short* kt_ = Kn + (size_t)(k0) * LDK; const unsigned short* rt_ = Kr + (size_t)(k0) * LDR; \
    GLDS16(kt_ + dk0, K_lds + (b) * SHM_K + (2 * widu) * 1024); GLDS16(kt_ + dk1, K_lds + (b) * SHM_K + (2 * widu + 1) * 1024); \
    GLDS16(vt_ + dv0, V_lds + (b) * SHM_V + (2 * widu) * 1024); GLDS16(vt_ + dv1, V_lds + (b) * SHM_V + (2 * widu + 1) * 1024); \
    GLDS16(rt_ + dr0, R_lds + (b) * SHM_R + widu * 1024); } while (0)
#define DMA_WAIT() asm volatile("s_waitcnt vmcnt(0)" ::: "memory")
  if constexpr (ATT_DMA != 0) { DMA_TILE(0, 0); DMA_WAIT(); __syncthreads(); }
  else { SLOAD(0, 0); asm volatile("s_waitcnt vmcnt(0)" ::: "memory"); SWRITE(0, 0); SLOAD(0, KVBLK); __syncthreads(); }
#ifndef ATT_QREG
#define ATT_QREG 1
#endif
  if constexpr (ATT_QREG != 0) {
#pragma unroll
    for (int d = 0; d < 4; ++d) qr[8 + d] = *reinterpret_cast<const bf16x8*>(Qf + d * 1024); }
  float mq = 0.f; bf16x8 qx = (bf16x8){0, 0, 0, 0, 0, 0, 0, 0}; const bf16x8 kone = (bf16x8){(short)(hi == 0 ? 0x3F80 : 0), 0, 0, 0, 0, 0, 0, 0};
#define QKT_PP(P0, P1, KS, RS) do { if constexpr (ATT_AUG_ON && ATT_QREG != 0) qkt_aug(P0, P1, KS, RS, qr, kone, qx, r32, hi); else if constexpr (ATT_QREG != 0) qkt_pr(P0, P1, KS, RS, qr, r32, hi); else qkt_pp(P0, P1, KS, RS, qr, Qf, r32, hi); } while (0)
#define PSM_PP(P0, P1) do { if constexpr (ATT_AUG_ON && ATT_QREG != 0) partialSM_aug(P0, P1, mq, al, qx, hi, j == 0); else partialSM(P0, P1, m_reg, mn, al); } while (0)
  if (half == 0) {
    int bc = 0, bp = 2, bn = 1;
    for (int j = 0; j < NT; ++j) {
      if constexpr (ATT_DMA != 0) { if (j + 1 < NT) DMA_TILE(bn, (j + 1) * KVBLK); }
      SBAR(); if (j > 0) pv_d0(o, vb0 + bp * (int)SHM_V, pa0, pa1, pa2, pa3);
      QKT_PP(p0, p1, K_lds + bc * SHM_K, R_lds + bc * SHM_R); SBAR();
      if constexpr (ATT_DMA != 0) DMA_WAIT(); else { if (j + 1 < NT) { asm volatile("s_waitcnt vmcnt(0)" ::: "memory"); SWRITE(bn, 0); } }
      __syncthreads();
      if constexpr (ATT_DMA == 0) { if (j + 2 < NT) SLOAD(0, (j + 2) * KVBLK); }
      SBAR(); PSM_PP(p0, p1); finishSM(p0, p1, al, l_reg, pa0, pa1, pa2, pa3); RESC(al); SBAR();
      __syncthreads();
      { const int t_ = bp; bp = bc; bc = bn; bn = t_; }
    }
    SBAR(); pv_d0(o, vb0 + bp * (int)SHM_V, pa0, pa1, pa2, pa3);
    __syncthreads();
  } else {
    if constexpr (ATT_DMA != 0) { DMA_TILE(1, KVBLK); DMA_WAIT(); } else { asm volatile("s_waitcnt vmcnt(0)" ::: "memory"); SWRITE(1, 0); }
    __syncthreads();
    int bc = 0, bp = 2, bn = 1, bnn = 2;
    for (int j = 0; j < NT; ++j) {
      if constexpr (ATT_DMA == 0) SLOAD(0, (j + 2 < NT ? j + 2 : NT - 1) * KVBLK);
      SBAR(); if (j > 0) pv_d0(o, vb0 + bp * (int)SHM_V, pa0, pa1, pa2, pa3);
      QKT_PP(p0, p1, K_lds + bc * SHM_K, R_lds + bc * SHM_R); SBAR();
      __syncthreads();
      if constexpr (ATT_DMA != 0) { if (j + 2 < NT) DMA_TILE(bnn, (j + 2) * KVBLK); }
      SBAR(); PSM_PP(p0, p1); finishSM(p0, p1, al, l_reg, pa0, pa1, pa2, pa3); RESC(al); SBAR();
      if constexpr (ATT_DMA != 0) DMA_WAIT(); else { if (j + 2 < NT) { asm volatile("s_waitcnt vmcnt(0)" ::: "memory"); SWRITE(bnn, 0); } }
      __syncthreads();
      { bp = bc; bc = bn; bn = bnn; bnn = bp; }
    }
    SBAR(); pv_d0(o, vb0 + bp * (int)SHM_V, pa0, pa1, pa2, pa3);
  }
  } else {
  f32x16 pA0, pA1, pB0, pB1; float mnA, mnB, alA, alB; bf16x8 pa0, pa1, pa2, pa3; const int NT = seq / KVBLK;
#ifdef ATT_PRIO
  if (__builtin_amdgcn_readfirstlane(tid) >= 256) __builtin_amdgcn_s_setprio(1);
#endif
  constexpr int SE = 0, SO = SDEPTH - 1;
  SLOAD(SE, 0); asm volatile("s_waitcnt vmcnt(0)" ::: "memory"); SWRITE(0, SE); __syncthreads();
  qkt(pA0, pA1, K_lds, R_lds, qr, Qf, r32, hi); partialSM(pA0, pA1, m_reg, mnA, alA);
  SLOAD(SO, KVBLK); if constexpr (SDEPTH == 2) { if (2 < NT) SLOAD(SE, 2 * KVBLK); }
  SWAIT(); SWRITE(1, SO); __syncthreads();
  if constexpr (NBUF == 2) {
  for (int j = 1; j + 1 < NT; j += 2) {
    SBAR(); qkt(pB0, pB1, K_lds + SHM_K, R_lds + SHM_R, qr, Qf, r32, hi);
    finishSM(pA0, pA1, alA, l_reg, pa0, pa1, pa2, pa3); SBAR();
    SLOAD(SO, (j + SDEPTH) * KVBLK); PFETCH((j + SDEPTH + ATT_PF) * KVBLK); SBAR();
    pv_d0(o, vb0, pa0, pa1, pa2, pa3); partialSM(pB0, pB1, m_reg, mnB, alB);
    __syncthreads(); SWAIT(); SWRITE(0, SE);
    RESC(alB); __syncthreads();
    SBAR(); qkt(pA0, pA1, K_lds, R_lds, qr, Qf, r32, hi);
    finishSM(pB0, pB1, alB, l_reg, pa0, pa1, pa2, pa3); SBAR();
    if (SDEPTH == 1 || j + 3 < NT) SLOAD(SE, (j + 1 + SDEPTH) * KVBLK); PFETCH((j + 1 + SDEPTH + ATT_PF) * KVBLK); SBAR();
    pv_d0(o, vb0 + (int)SHM_V, pa0, pa1, pa2, pa3); partialSM(pA0, pA1, m_reg, mnA, alA);
    __syncthreads(); SWAIT(); SWRITE(1, SO);
    RESC(alA); __syncthreads();
  }
  SBAR(); qkt(pB0, pB1, K_lds + SHM_K, R_lds + SHM_R, qr, Qf, r32, hi);
  finishSM(pA0, pA1, alA, l_reg, pa0, pa1, pa2, pa3); SBAR();
  pv_d0(o, vb0, pa0, pa1, pa2, pa3); partialSM(pB0, pB1, m_reg, mnB, alB);
  __syncthreads(); RESC(alB);
  finishSM(pB0, pB1, alB, l_reg, pa0, pa1, pa2, pa3); SBAR();
  pv_d0(o, vb0 + (int)SHM_V, pa0, pa1, pa2, pa3);
  } else {
  int bp = 0, bc = 1, bn = 2;
  for (int j = 1; j + 1 < NT; j += 2) {
    SBAR(); qkt(pB0, pB1, K_lds + bc * SHM_K, R_lds + bc * SHM_R, qr, Qf, r32, hi);
    finishSM(pA0, pA1, alA, l_reg, pa0, pa1, pa2, pa3); SBAR();
    SLOAD(0, (j + 1) * KVBLK); SBAR();
    pv_d0(o, vb0 + bp * (int)SHM_V, pa0, pa1, pa2, pa3); partialSM(pB0, pB1, m_reg, mnB, alB);
    SWAIT(); SWRITE(bn, 0);
    RESC(alB); __syncthreads();
    { const int t_ = bp; bp = bc; bc = bn; bn = t_; }
    SBAR(); qkt(pA0, pA1, K_lds + bc * SHM_K, R_lds + bc * SHM_R, qr, Qf, r32, hi);
    finishSM(pB0, pB1, alB, l_reg, pa0, pa1, pa2, pa3); SBAR();
    SLOAD(0, (j + 2) * KVBLK); SBAR();
    pv_d0(o, vb0 + bp * (int)SHM_V, pa0, pa1, pa2, pa3); partialSM(pA0, pA1, m_reg, mnA, alA);
    SWAIT(); SWRITE(bn, 0);
    RESC(alA); __syncthreads();
    { const int t_ = bp; bp = bc; bc = bn; bn = t_; }
  }
  SBAR(); qkt(pB0, pB1, K_lds + bc * SHM_K, R_lds + bc * SHM_R, qr, Qf, r32, hi);
  finishSM(pA0, pA1, alA, l_reg, pa0, pa1, pa2, pa3); SBAR();
  pv_d0(o, vb0 + bp * (int)SHM_V, pa0, pa1, pa2, pa3); partialSM(pB0, pB1, m_reg, mnB, alB);
  __syncthreads(); RESC(alB);
  finishSM(pB0, pB1, alB, l_reg, pa0, pa1, pa2, pa3); SBAR();
  pv_d0(o, vb0 + bc * (int)SHM_V, pa0, pa1, pa2, pa3);
  }
  }
  asm volatile("" :: "v"(pf_));
#ifdef ATT_PRIO
  __builtin_amdgcn_s_setprio(0);
#endif
  if (hi == 0) li_l[r32] = l_reg; asm volatile("s_waitcnt lgkmcnt(0)" ::: "memory");
  float rli[16];
#pragma unroll
  for (int r = 0; r < 16; ++r) rli[r] = __builtin_amdgcn_rcpf(li_l[crow(r, hi)]);
#pragma unroll
  for (int r = 0; r < 16; ++r) { const unsigned oo = (unsigned)((wid * QBLK + crow(r, hi)) * LDO + r32);
#pragma unroll
    for (int d0 = 0; d0 < 4; ++d0) Ob[oo + d0 * 32] = (unsigned short)(cvtpk(o[d0][r] * rli[r], 0.f) & 0xffffu); }
#undef SLOAD
#undef PFETCH
#undef GLDS16
#undef QKT_PP
#undef PSM_PP
#undef DMA_TILE
#undef DMA_WAIT
#undef SWRITE
#undef SWAIT
#undef RESC
}
}

__device__ __forceinline__ void hy_h2_phase(Frame& F, const bf16* U, const float* cw, const float* cb, bf16* VVT) {
    const int gw = blockIdx.x * NWAVES + F.wave, NGW = F.G * NWAVES, lane = F.lane;
    LAS unsigned char* S = F.lds + F.wave * 16896;
    const int chunk = lane & 7, rsub = lane >> 3;
    constexpr int NTILE = (SEQ / 64) * (DM / 64);
    v4u R[2][9];
#define H2_LOAD(IT) do { const int t0_ = ((IT) >> 6) * 64, c0_ = ((IT) & 63) * 64; \
        _Pragma("unroll") for (int part = 0; part < 2; ++part) _Pragma("unroll") for (int i = 0; i < 9; ++i) { const int rr = rsub + 8 * i; const int t = t0_ - 1 + rr; v4u v = (v4u){0u, 0u, 0u, 0u}; \
            if (rr < 66 && t >= 0 && t < SEQ) v = *(const GAS v4u*)(U + (size_t)t * (3 * DM) + (part + 1) * DM + c0_ + chunk * 8); R[part][i] = v; } } while (0)
    if (gw < NTILE) H2_LOAD(gw);
    for (int it = gw; it < NTILE; it += NGW) { const int t0 = (it >> 6) * 64, c0 = (it & 63) * 64;
#pragma unroll
        for (int part = 0; part < 2; ++part)
#pragma unroll
            for (int i = 0; i < 9; ++i) { const int rr = rsub + 8 * i; if (rr < 66) *(LAS v4u*)(S + part * 8448 + rr * 128 + chunk * 16) = R[part][i]; }
        { const int itn = (it + NGW < NTILE) ? it + NGW : it; H2_LOAD(itn); }
        LDS_WAIT(); asm volatile("" ::: "memory");
        const int c1 = DM + c0 + lane, c2 = 2 * DM + c0 + lane;
        const float a0 = cw[c1], a1 = cw[3 * DM + c1], a2 = cw[6 * DM + c1], ab = cb[c1], b0 = cw[c2], b1 = cw[3 * DM + c2], b2 = cw[6 * DM + c2], bb = cb[c2];
        const LAS unsigned short* S1 = (const LAS unsigned short*)S + lane; const LAS unsigned short* S2 = (const LAS unsigned short*)(S + 8448) + lane;
        float p1 = bf1(S1[0]), q1 = bf1(S1[64]), p2 = bf1(S2[0]), q2 = bf1(S2[64]);
        unsigned ow[32];
#pragma unroll
        for (int t = 0; t < 64; t += 2) { float vv[2];
#pragma unroll
            for (int e = 0; e < 2; ++e) { const float n1 = bf1(S1[(t + e + 2) * 64]), n2 = bf1(S2[(t + e + 2) * 64]);
                vv[e] = (a0 * p1 + a1 * q1 + a2 * n1 + ab) * (b0 * p2 + b1 * q2 + b2 * n2 + bb); p1 = q1; q1 = n1; p2 = q2; q2 = n2; }
            ow[t >> 1] = pk2(vv[0], vv[1]); }
        GAS v4u* dst = (GAS v4u*)(VVT + (size_t)(c0 + lane) * SEQ + t0);
#pragma unroll
        for (int i = 0; i < 8; ++i) dst[i] = (v4u){ow[4 * i], ow[4 * i + 1], ow[4 * i + 2], ow[4 * i + 3]};
        LDS_WAIT(); asm volatile("" ::: "memory");
    }
}
#undef H2_LOAD
__device__ __forceinline__ void hy_h4_phase(Frame& F, const bf16* U, const float* cw, const float* cb, const bf16* YT, bf16* Aout) {
    const int gw = blockIdx.x * NWAVES + F.wave, NGW = F.G * NWAVES, lane = F.lane;
    LAS unsigned char* S = F.lds + F.wave * 17408;
    LAS unsigned char* Tt = S + 8448;
    const int chunk = lane & 7, rsub = lane >> 3;
    constexpr int NTILE = (SEQ / 64) * (DM / 64);
    v4u RX[9], RY[8];
#define H4_LOAD(IT) do { const int t0_ = ((IT) >> 6) * 64, c0_ = ((IT) & 63) * 64; \
        _Pragma("unroll") for (int i = 0; i < 9; ++i) { const int rr = rsub + 8 * i; const int t = t0_ - 1 + rr; v4u v = (v4u){0u, 0u, 0u, 0u}; \
            if (rr < 66 && t >= 0 && t < SEQ) v = *(const GAS v4u*)(U + (size_t)t * (3 * DM) + c0_ + chunk * 8); RX[i] = v; } \
        _Pragma("unroll") for (int i = 0; i < 8; ++i) { const int cr = rsub + 8 * i; RY[i] = *(const GAS v4u*)(YT + (size_t)(c0_ + cr) * SEQ + t0_ + chunk * 8); } } while (0)
    if (gw < NTILE) H4_LOAD(gw);
    for (int it = gw; it < NTILE; it += NGW) { const int t0 = (it >> 6) * 64, c0 = (it & 63) * 64;
#pragma unroll
        for (int i = 0; i < 9; ++i) { const int rr = rsub + 8 * i; if (rr < 66) *(LAS v4u*)(S + rr * 128 + chunk * 16) = RX[i]; }
#pragma unroll
        for (int i = 0; i < 8; ++i) { const int cr = rsub + 8 * i; const v4u v = RY[i];
            *(LAS v2u*)(Tt + cr * 136 + chunk * 16) = (v2u){v.x, v.y}; *(LAS v2u*)(Tt + cr * 136 + chunk * 16 + 8) = (v2u){v.z, v.w}; }
        { const int itn = (it + NGW < NTILE) ? it + NGW : it; H4_LOAD(itn); }
        LDS_WAIT(); asm volatile("" ::: "memory");
        const int c1 = c0 + lane; const float a0 = cw[c1], a1 = cw[3 * DM + c1], a2 = cw[6 * DM + c1], ab = cb[c1];
        const LAS unsigned short* S0 = (const LAS unsigned short*)S + lane; const LAS unsigned short* Ty = (const LAS unsigned short*)(Tt + lane * 136);
        float p = bf1(S0[0]), q = bf1(S0[64]);
        bf16* dst = Aout + (size_t)t0 * DM + c1;
#pragma unroll 8
        for (int t = 0; t < 64; ++t) { const float n = bf1(S0[(t + 2) * 64]); const float r = (a0 * p + a1 * q + a2 * n + ab) * bf1(Ty[t]); p = q; q = n;
            dst[(size_t)t * DM] = (bf16)(pk2(r, 0.f) & 0xffffu); }
        LDS_WAIT(); asm volatile("" ::: "memory");
    }
}
#undef H4_LOAD
namespace fftc {
constexpr int LOGN = 14, N = 1 << LOGN;
__device__ __forceinline__ int PA(int i) { return i + ((i >> 6) << 2); }
__device__ __forceinline__ int opq(int t) { asm volatile("" : "+v"(t)); return t; }
__device__ __forceinline__ f32x2 cmulc(f32x2 a, f32x2 b) { return (f32x2){a.x * b.x - a.y * b.y, a.x * b.y + a.y * b.x}; }
__device__ __forceinline__ f32x2 cmul(f32x2 a, f32x2 b) { f32x2 t, r;
    asm("v_pk_mul_f32 %0, %1, %2 op_sel_hi:[0,1]" : "=v"(t) : "v"(a), "v"(b));
    asm("v_pk_fma_f32 %0, %1, %2, %3 op_sel:[1,1,0] op_sel_hi:[1,0,1] neg_lo:[1,0,0]" : "=v"(r) : "v"(a), "v"(b), "v"(t));
    return r; }
__device__ __forceinline__ f32x2 cmadd(f32x2 a, f32x2 b, f32x2 c) { f32x2 t, r;
    asm("v_pk_fma_f32 %0, %1, %2, %3 op_sel_hi:[0,1,1]" : "=v"(t) : "v"(a), "v"(b), "v"(c));
    asm("v_pk_fma_f32 %0, %1, %2, %3 op_sel:[1,1,0] op_sel_hi:[1,0,1] neg_lo:[1,0,0]" : "=v"(r) : "v"(a), "v"(b), "v"(t));
    return r; }
__device__ __forceinline__ f32x2 cmul_n(f32x2 a, f32x2 b) { f32x2 t, r;
    asm("v_pk_mul_f32 %0, %1, %2 op_sel_hi:[0,1]" : "=v"(t) : "v"(a), "v"(b));
    asm("v_pk_fma_f32 %0, %1, %2, %3 op_sel:[1,1,0] op_sel_hi:[1,0,1] neg_lo:[1,0,0]\n\ts_nop 1" : "=v"(r) : "v"(a), "v"(b), "v"(t));
    return r; }
template <int CTRL> __device__ __forceinline__ f32x2 quadx(f32x2 v) {
    return (f32x2){__int_as_float(__builtin_amdgcn_update_dpp(0, __float_as_int(v.x), CTRL, 0xF, 0xF, true)), __int_as_float(__builtin_amdgcn_update_dpp(0, __float_as_int(v.y), CTRL, 0xF, 0xF, true))}; }
__device__ __forceinline__ f32x2 cis(float ang) { f32x2 w = (f32x2){__cosf(ang), __sinf(ang)}; asm volatile("s_nop 1" : "+v"(w)); return w; }
__device__ __forceinline__ constexpr float c8(int k) { return k == 0 ? 1.0f : k == 1 ? 0.92387953251128674f : k == 2 ? 0.70710678118654752f : k == 3 ? 0.38268343236508977f : k == 4 ? 0.0f : k == 5 ? -0.38268343236508977f : k == 6 ? -0.70710678118654752f : -0.92387953251128674f; }
__device__ __forceinline__ constexpr float s8(int k) { return k == 0 ? 0.0f : k == 1 ? 0.38268343236508977f : k == 2 ? 0.70710678118654752f : k == 3 ? 0.92387953251128674f : k == 4 ? 1.0f : k == 5 ? 0.92387953251128674f : k == 6 ? 0.70710678118654752f : 0.38268343236508977f; }
template <int NR, int HL, bool INV, bool DPPNEXT = false> __device__ __forceinline__ void bfly_stage(f32x2 (&v)[NR], const f32x2 bq) {
#pragma unroll
    for (int mu = 0; mu < HL; ++mu) {
        constexpr int KS = 8 / HL; const float cr = c8(mu * KS), ci = INV ? s8(mu * KS) : -s8(mu * KS);
        const f32x2 tw = (mu == 0) ? bq : cmulc(bq, (f32x2){cr, ci});
#pragma unroll
        for (int blk = 0; blk < NR; blk += 2 * HL) {
            if (!INV) { const f32x2 a = v[blk + mu], b = v[blk + mu + HL]; v[blk + mu] = a + b; v[blk + mu + HL] = DPPNEXT ? cmul_n(a - b, tw) : cmul(a - b, tw); }
            else { const f32x2 a = v[blk + mu], b = cmul(v[blk + mu + HL], tw); v[blk + mu] = a + b; v[blk + mu + HL] = a - b; }
        }
    }
}
template <int LOGH, int R, bool TAIL = false> __device__ __forceinline__ void dif_pass(LAS f32x2* X, int tid_) {
    constexpr int H = 1 << LOGH, S = H >> (R - 1), LOGS = LOGH - (R - 1), NR = 1 << R, NG = N >> R;
    const int tid = opq(tid_);
#pragma unroll 1
    for (int g = tid; g < NG; g += NTHR) {
        const int j = g & (S - 1), base = ((g >> LOGS) << (LOGH + 1)) + j;
        constexpr int PS = S + ((S >> 6) << 2); static_assert(S % 64 == 0 || NR * S <= 64, "padded stride");
        const int p0 = PA(base);
        f32x2 v[NR];
#pragma unroll
        for (int m = 0; m < NR; ++m) v[m] = X[p0 + PS * m];
        const float ang = -3.14159265358979323846f * (float)j * (1.0f / (float)((NR / 2) * S));
        const f32x2 bw = cis(ang);
        if constexpr (R == 4) { const f32x2 b4 = cmul(bw, bw), b2 = cmul(b4, b4), b1 = cmul(b2, b2);
            bfly_stage<NR, 8, false>(v, bw); bfly_stage<NR, 4, false>(v, b4); bfly_stage<NR, 2, false>(v, b2); bfly_stage<NR, 1, false, TAIL>(v, b1); }
        else { const f32x2 b1 = cmul(bw, bw); bfly_stage<NR, 2, false>(v, bw); bfly_stage<NR, 1, false>(v, b1); }
        if constexpr (TAIL) {
            static_assert(S == 4 && R == 4, "quad tail");
            const int q = tid & 3; const float s2 = (q & 2) ? -1.f : 1.f, s1 = (q & 1) ? -1.f : 1.f; const bool q3 = q == 3;
#pragma unroll
            for (int m = 0; m < NR; ++m) { const f32x2 xp = quadx<0x4E>(v[m]); f32x2 r = xp + v[m] * s2;
                r = q3 ? (f32x2){r.y, -r.x} : r;
                const f32x2 rp = quadx<0xB1>(r); v[m] = rp + r * s1; }
        }
#pragma unroll
        for (int m = 0; m < NR; ++m) X[p0 + PS * m] = v[m];
    }
}
template <int LOGH0, int R, bool HEAD = false> __device__ __forceinline__ void dit_pass(LAS f32x2* X, int tid_) {
    constexpr int S = 1 << LOGH0, NR = 1 << R, NG = N >> R;
    const int tid = opq(tid_);
#pragma unroll 1
    for (int g = tid; g < NG; g += NTHR) {
        const int j = g & (S - 1), base = ((g >> LOGH0) << (LOGH0 + R)) + j;
        constexpr int PS = S + ((S >> 6) << 2); static_assert(S % 64 == 0 || NR * S <= 64, "padded stride");
        const int p0 = PA(base);
        f32x2 v[NR];
#pragma unroll
        for (int m = 0; m < NR; ++m) v[m] = X[p0 + PS * m];
        if constexpr (HEAD) {
            static_assert(S == 4 && R == 4, "quad head");
            const int q = tid & 3; const float s2 = (q & 2) ? -1.f : 1.f, s1 = (q & 1) ? -1.f : 1.f; const bool q3 = q == 3;
#pragma unroll
            for (int m = 0; m < NR; ++m) { const f32x2 xp = quadx<0xB1>(v[m]); f32x2 r = xp + v[m] * s1;
                r = q3 ? (f32x2){-r.y, r.x} : r;
                const f32x2 rp = quadx<0x4E>(r); v[m] = rp + r * s2; }
        }
        const float ang = 3.14159265358979323846f * (float)j * (1.0f / (float)((NR / 2) * S));
        const f32x2 bw = cis(ang);
        if constexpr (R == 4) { const f32x2 b4 = cmul(bw, bw), b2 = cmul(b4, b4), b1 = cmul(b2, b2);
            bfly_stage<NR, 1, true>(v, b1); bfly_stage<NR, 2, true>(v, b2); bfly_stage<NR, 4, true>(v, b4); bfly_stage<NR, 8, true>(v, bw); }
        else { const f32x2 b1 = cmul(bw, bw); bfly_stage<NR, 1, true>(v, b1); bfly_stage<NR, 2, true>(v, bw); }
#pragma unroll
        for (int m = 0; m < NR; ++m) X[p0 + PS * m] = v[m];
    }
}
__device__ __forceinline__ void fwd(LAS f32x2* X, int tid) {
    dif_pass<13, 4>(X, tid); __syncthreads(); dif_pass<9, 4>(X, tid); __syncthreads(); dif_pass<5, 4, true>(X, tid); __syncthreads();
}
__device__ __forceinline__ void inv(LAS f32x2* X, int tid) {
    dit_pass<2, 4, true>(X, tid); __syncthreads(); dit_pass<6, 4>(X, tid); __syncthreads(); dit_pass<10, 4>(X, tid); __syncthreads();
}
__device__ __forceinline__ int brev14(int k) { return (int)(__brev((unsigned)k) >> 18); }
}
__device__ __forceinline__ void hy_fft_phase(Frame& F, const bf16* GT, const bf16* VVT, const float* skip, bf16* YT, float d0, float dstep, float tscale) {
    using namespace fftc;
    LAS f32x2* X = (LAS f32x2*)F.lds; const int tid0 = F.tid;
    v4u G[8]; unsigned short GE[4]; v4u V[4];
#define FFT_LOAD_G(cc) do { const int t_ = opq(tid0); const bf16* gf_ = GT + (size_t)(cc) * SEQ; const bf16* gb_ = GT + (size_t)(DM + (cc)) * SEQ; \
        _Pragma("unroll") for (int jj = 0; jj < 4; ++jj) { const int m = 4 * (t_ + NTHR * jj); G[jj] = *(const GAS v4u*)(gf_ + 2 * m); } \
        _Pragma("unroll") for (int jj = 4; jj < 8; ++jj) { const int m = 4 * (t_ + NTHR * jj), mp = N - m; G[jj] = *(const GAS v4u*)(gb_ + 2 * mp - 8); GE[jj - 4] = (2 * mp < N) ? *(const GAS bf16*)(gb_ + 2 * mp) : (unsigned short)0; } } while (0)
    if ((int)blockIdx.x < DM) FFT_LOAD_G(blockIdx.x);
    for (int c = blockIdx.x; c < DM; c += F.G) {
        const bf16* vr = VVT + (size_t)c * SEQ;
        int tid = opq(tid0);
        const float dlc = -(d0 + (float)c * dstep) * tscale, rst = __builtin_amdgcn_exp2f(dlc);
#pragma unroll
        for (int jj = 0; jj < 4; ++jj) { const int m = 4 * (tid + NTHR * jj); float f[8]; unpack8(G[jj], f); float dk = __builtin_amdgcn_exp2f(dlc * (float)(2 * m));
#pragma unroll
            for (int e = 0; e < 8; ++e) { f[e] *= dk; dk *= rst; }
#pragma unroll
            for (int e = 0; e < 4; ++e) X[PA(m + e)] = (f32x2){f[2 * e], f[2 * e + 1]}; }
#pragma unroll
        for (int jj = 4; jj < 8; ++jj) { const int m = 4 * (tid + NTHR * jj), mp = N - m; float f[8]; unpack8(G[jj], f); float e0 = bf1(GE[jj - 4]);
            float dk = __builtin_amdgcn_exp2f(dlc * (float)(2 * mp - 8));
#pragma unroll
            for (int e = 0; e < 8; ++e) { f[e] *= dk; dk *= rst; }
            e0 *= dk;
            X[PA(m)] = (f32x2){e0, f[7]}; X[PA(m + 1)] = (f32x2){f[6], f[5]}; X[PA(m + 2)] = (f32x2){f[4], f[3]}; X[PA(m + 3)] = (f32x2){f[2], f[1]}; }
        tid = opq(tid0);
#pragma unroll
        for (int jj = 0; jj < 4; ++jj) { const int m = 4 * (tid + NTHR * jj); V[jj] = *(const GAS v4u*)(vr + 2 * m); }
        __syncthreads();
        fwd(X, tid);
        tid = opq(tid0);
#define KMAP(t_, jj_) ((((t_) & 31) << 8) | (((t_) >> 5) << 4) | (jj_))
        f32x2 zg[16][2];
#pragma unroll
        for (int jj = 0; jj < 16; ++jj) { const int k = KMAP(tid, jj); zg[jj][0] = X[PA(brev14(k))]; zg[jj][1] = X[PA(brev14((N - k) & (N - 1)))]; }
        const f32x2 zgh = X[PA(1)];
        __syncthreads();
        tid = opq(tid0);
#pragma unroll
        for (int jj = 0; jj < 8; ++jj) { const int m = 4 * (tid + NTHR * jj);
            if (jj < 4) { float f[8]; unpack8(V[jj], f);
#pragma unroll
                for (int e = 0; e < 4; ++e) X[PA(m + e)] = (f32x2){f[2 * e], f[2 * e + 1]}; }
            else {
#pragma unroll
                for (int e = 0; e < 4; ++e) X[PA(m + e)] = (f32x2){0.f, 0.f}; } }
        if (c + F.G < DM) FFT_LOAD_G(c + F.G);
        __syncthreads();
        fwd(X, tid);
        tid = opq(tid0);
        constexpr float SC = 1.0f / (float)N;
#pragma unroll
        for (int jj = 0; jj < 16; ++jj) { const int k = KMAP(tid, jj), p = PA(brev14(k)), p2 = PA(brev14((N - k) & (N - 1)));
            const f32x2 a = X[p], b = X[p2], ga = zg[jj][0], gc = zg[jj][1];
            const f32x2 Ev = (f32x2){0.5f * (a.x + b.x), 0.5f * (a.y - b.y)}, Ov = (f32x2){0.5f * (a.y + b.y), 0.5f * (b.x - a.x)};
            const f32x2 Eg = (f32x2){0.5f * (ga.x + gc.x), 0.5f * (ga.y - gc.y)}, Og = (f32x2){0.5f * (ga.y + gc.y), 0.5f * (gc.x - ga.x)};
            const float ang = -6.283185307179586f * (float)k / (float)N; const f32x2 wk = cis(ang);
            f32x2 Pe = cmadd(Ev, Eg, cmul(wk, cmul(Ov, Og))), Po = cmadd(Ev, Og, cmul(Ov, Eg)); Pe = Pe * SC; Po = Po * SC;
            X[p] = (f32x2){Pe.x - Po.y, Pe.y + Po.x};
            if (k != 0) X[p2] = (f32x2){Pe.x + Po.y, Po.x - Pe.y}; }
        if (tid == 0) { const f32x2 a = X[PA(1)];
            const float Ev = a.x, Ov = a.y, Eg = zgh.x, Og = zgh.y; X[PA(1)] = (f32x2){(Ev * Eg - Ov * Og) * SC, (Ev * Og + Ov * Eg) * SC}; }
        __syncthreads();
        inv(X, tid);
        tid = opq(tid0);
        const float sk = skip[c];
#pragma unroll
        for (int jj = 0; jj < 4; ++jj) { const int m = 4 * (tid + NTHR * jj); float f[8], o[8]; unpack8(*(const GAS v4u*)(vr + 2 * m), f);
#pragma unroll
            for (int e = 0; e < 4; ++e) { const f32x2 q = X[PA(m + e)]; o[2 * e] = q.x + f[2 * e] * sk; o[2 * e + 1] = q.y + f[2 * e + 1] * sk; }
            *(GAS v4u*)(YT + (size_t)c * SEQ + 2 * m) = pack8f(o); }
        __syncthreads();
    }
#undef FFT_LOAD_G
#undef KMAP
}

#define GEMM_CALL(EPI, Aptr, Bptr, Mv, Nv, Kv, ...) do { pg8::Gemm g_{(const pg8::bf16_t*)(Aptr), (const pg8::bf16_t*)(Bptr), (Mv), (Nv), (Kv)}; pg8::StaticOrder S_; S_.init((Mv), (Nv), F.G, (int)blockIdx.x); \
    EPI E_{__VA_ARGS__}; pg8::gemm_phase<EPI, pg8::StaticOrder, PG8_ALIGN, PG8_SP2>(F.lds, g_, S_, E_); } while (0)

#ifndef DOWN_RB
#define DOWN_RB 2
#endif
#define GEMM_DOWN(Aptr, Bptr, ...) do { if (F.G == 256) { pg8::Gemm g_{(const pg8::bf16_t*)(Aptr), (const pg8::bf16_t*)(Bptr), SEQ, DM, FF, FFP}; pg8::BlockOrder<DOWN_RB, 32 / DOWN_RB> S_; S_.init((int)blockIdx.x); \
        pg8::EpiBf16<0> E_{__VA_ARGS__}; pg8::gemm_phase<pg8::EpiBf16<0>, pg8::BlockOrder<DOWN_RB, 32 / DOWN_RB>, PG8_ALIGN, PG8_SP2>(F.lds, g_, S_, E_); } \
    else { pg8::Gemm g_{(const pg8::bf16_t*)(Aptr), (const pg8::bf16_t*)(Bptr), SEQ, DM, FF, FFP}; pg8::StaticOrder S_; S_.init(SEQ, DM, F.G, (int)blockIdx.x); pg8::EpiBf16<0> E_{__VA_ARGS__}; pg8::gemm_phase<pg8::EpiBf16<0>, pg8::StaticOrder, PG8_ALIGN, PG8_SP2>(F.lds, g_, S_, E_); } } while (0)
#ifndef REP_P0
#define REP_P0 1
#endif
#ifndef REP_ATT
#define REP_ATT 1
#endif
#ifndef REP_GU
#define REP_GU 1
#endif
#ifndef REP_FFT
#define REP_FFT 1
#endif
#ifndef REP_DN
#define REP_DN 1
#endif
#ifndef REP_ROW
#define REP_ROW 1
#endif
#ifndef REP_SCIN
#define REP_SCIN 1
#endif
#ifndef REP_MISC
#define REP_MISC 1
#endif
#define GEMM_CALL_SUB(EPI, Aptr, Bptr, Mv, Nv, Kv, Gs, cs, ...) do { pg8::Gemm g_{(const pg8::bf16_t*)(Aptr), (const pg8::bf16_t*)(Bptr), (Mv), (Nv), (Kv)}; pg8::StaticOrder S_; S_.init((Mv), (Nv), (Gs), (cs)); \
    EPI E_{__VA_ARGS__}; pg8::gemm_phase<EPI, pg8::StaticOrder, PG8_ALIGN, PG8_SP2>(F.lds, g_, S_, E_); } while (0)
static_assert(att::LDS_NEED <= LDSCTL_OFF && 8 * 17408 <= LDSCTL_OFF && pg8::STAGE_BYTES <= LDSCTL_OFF, "phase LDS regions stay below the control words");
__global__ void __launch_bounds__(NTHR, 2) mega_fwd(Args args) {
    extern __shared__ __attribute__((aligned(16))) unsigned char lds[];
    Frame F;
    F.lds = (LAS unsigned char*)lds;
    F.MISC = (volatile LAS unsigned*)(F.lds + MISC_OFF);
    F.tid = threadIdx.x; F.lane = F.tid & 63; F.wave = __builtin_amdgcn_readfirstlane(F.tid >> 6);
    F.G = gridDim.x;
    unsigned char* ws = args.ws;
    F.ctl = (gu32*)(ws + WS_CTL);
    for (int u = F.tid; u < (LDS_BYTES - LDSCTL_OFF) / 4; u += NTHR) ((LAS unsigned*)(F.lds + LDSCTL_OFF))[u] = 0u;
    __syncthreads();
    const int lo = args.ph_lo, hi = args.ph_hi;
    XcdBarrier bar; bar.bar = (unsigned*)(F.ctl + CW_BAR); bar.x = 0; bar.st = nullptr;
    if (hi - lo > 1) bar = xcd_barrier_post((unsigned*)(F.ctl + CW_BAR), F.MISC + 8);
#ifndef MK_MASK
#define MK_MASK 0xFFFFFFFFFFFFFFFFull
#endif
#define IN(k) ((((MK_MASK) >> (k)) & 1ull) != 0ull && lo <= (k) && (k) < hi)
#define SEAM(k) do { if (IN(k) && IN((k) + 1)) xcd_barrier(bar); } while (0)

    float* const MOD = (float*)(ws + WS_MOD);
#define MODV(L, r, i) (MOD + ((size_t)((L) * 2 + (r)) * NMOD + (i)) * DM)
#define GAIN(L, i) (args.in[7] + ((size_t)(L) * 4 + (i)) * DM)
    bf16* const HB = (bf16*)(ws + WS_HB); bf16* const U = (bf16*)(ws + WS_U); bf16* const Z = (bf16*)(ws + WS_Z); bf16* const Y = (bf16*)(ws + WS_Y);
    float* const XC = (float*)(ws + WS_XC); float* const XL = args.out;
#ifndef XRES_BF16
#define XRES_BF16 1
#endif
    constexpr int RXS = XRES_BF16 ? 1 : 0, RXD = XRES_BF16 ? 1 : 2;
    void* const XRL = XRES_BF16 ? (void*)(ws + WS_XB) : (void*)XL;
    bf16* const Pb = U; bf16* const Bqb = U + (size_t)MT * DM;

    if (IN(0)) { for (int rep_ = 0; rep_ < REP_P0; ++rep_) { Frame Fp = fresh(F); p0_prologue(Fp, args); __syncthreads(); } } SEAM(0);
    if (IN(1)) { Frame Fp = fresh(F); p1_adaln(Fp, args); } SEAM(1);
    if (IN(2)) { Frame Fp = fresh(F); row_phase<false, true, 0, 0>(Fp, 0, MT, (int)blockIdx.x, F.G, args.in[0], args.in[2], nullptr, nullptr, nullptr, nullptr, nullptr, nullptr, HB, GAIN(0, 0), MODV(0, 0, 0), MODV(0, 1, 0), MODV(0, 0, 1), MODV(0, 1, 1)); } SEAM(2);

    const int gsi = F.G >= 96 ? 48 : F.G / 2, gso = F.G >= 32 ? 16 : F.G / 2;
    if (IN(3)) { GEMM_CALL(pg8::EpiScIn, HB, ws + WS_SCIN, SEQ, 3 * DM, DM, Pb, Bqb, DM); } SEAM(3);
    if (IN(4)) { if ((int)blockIdx.x < gsi) { GEMM_CALL_SUB(pg8::EpiScIn, HB + (size_t)SEQ * DM, ws + WS_SCIN, CTXL, 3 * DM, DM, gsi, (int)blockIdx.x, Pb + (size_t)SEQ * DM, Bqb + (size_t)SEQ * DM, DM); }
                 else { Frame Fp = fresh(F); sc_conv_phase(Fp, 0, SEQ, (int)blockIdx.x - gsi, F.G - gsi, Pb, Bqb, args.in[11], Z); } } SEAM(4);
    if (IN(5)) { { Frame Fp = fresh(F); sc_conv_phase(Fp, SEQ, MT, (int)blockIdx.x, F.G, Pb, Bqb, args.in[11], Z); }
                 GEMM_CALL(pg8::EpiBf16<0>, Z, ws + WS_SCOUT, SEQ, DM, DM, Y, DM, nullptr, 0, 0, 1.f); } SEAM(5);
    if (IN(6)) { if ((int)blockIdx.x < gso) { GEMM_CALL_SUB(pg8::EpiBf16<0>, Z + (size_t)SEQ * DM, ws + WS_SCOUT, CTXL, DM, DM, gso, (int)blockIdx.x, Y + (size_t)SEQ * DM, DM, nullptr, 0, 0, 1.f); }
                 else { Frame Fp = fresh(F); row_phase<true, true, 0, RXD>(Fp, 0, SEQ, (int)blockIdx.x - gso, F.G - gso, args.in[0], args.in[2], XRL, XC, Y, MODV(0, 0, 2), MODV(0, 1, 2), GAIN(0, 1), HB, GAIN(0, 2), MODV(0, 0, 3), MODV(0, 1, 3), MODV(0, 0, 4), MODV(0, 1, 4)); } } SEAM(6);
    if (IN(7)) { Frame Fp = fresh(F); row_phase<true, true, 0, 2>(Fp, SEQ, MT, (int)blockIdx.x, F.G, args.in[0], args.in[2], XL, XC, Y, MODV(0, 0, 2), MODV(0, 1, 2), GAIN(0, 1), HB, GAIN(0, 2), MODV(0, 0, 3), MODV(0, 1, 3), MODV(0, 0, 4), MODV(0, 1, 4)); } SEAM(7);
    if (IN(8)) { GEMM_CALL(pg8::EpiSwiglu, HB, ws + WS_WGU, MT, NGU, DM, U, FFP); } SEAM(8);
    if (IN(9)) { GEMM_DOWN(U, ws + WS_WD, Y, DM, nullptr, 0, 0, 1.f); } SEAM(9);
    if (IN(10)) { if ((int)blockIdx.x < gso) { { pg8::Gemm g_{(const pg8::bf16_t*)(U + (size_t)SEQ * FFP), (const pg8::bf16_t*)(ws + WS_WD), CTXL, DM, FF, FFP}; pg8::StaticOrder S_; S_.init(CTXL, DM, gso, (int)blockIdx.x); pg8::EpiBf16<0> E_{Y + (size_t)SEQ * DM, DM, nullptr, 0, 0, 1.f}; pg8::gemm_phase<pg8::EpiBf16<0>, pg8::StaticOrder, PG8_ALIGN, PG8_SP2>(F.lds, g_, S_, E_); } }
                  else { Frame Fp = fresh(F); row_phase<true, true, RXS, RXD>(Fp, 0, SEQ, (int)blockIdx.x - gso, F.G - gso, XRL, XC, XRL, XC, Y, MODV(0, 0, 5), MODV(0, 1, 5), GAIN(0, 3), HB, GAIN(1, 0), MODV(1, 0, 0), MODV(1, 1, 0), MODV(1, 0, 1), MODV(1, 1, 1)); } } SEAM(10);
    if (IN(11)) { Frame Fp = fresh(F); row_phase<true, true, 0, 2>(Fp, SEQ, MT, (int)blockIdx.x, F.G, XL, XC, XL, XC, Y, MODV(0, 0, 5), MODV(0, 1, 5), GAIN(0, 3), HB, GAIN(1, 0), MODV(1, 0, 0), MODV(1, 1, 0), MODV(1, 0, 1), MODV(1, 1, 1)); } SEAM(11);

    float* const Dd = (float*)(ws + WS_D); bf16* const CQN = (bf16*)(ws + WS_CQN); bf16* const CKVN = (bf16*)(ws + WS_CKVN); bf16* const KR = (bf16*)(ws + WS_KR);
    bf16* const Qb = (bf16*)(ws + WS_Q); bf16* const KVb = (bf16*)(ws + WS_KV);
    if (IN(12)) { GEMM_CALL(pg8::EpiF32, HB, ws + WS_MDOWN, MT, MDNP, DM, Dd, MDNP); } SEAM(12);
    if (IN(13)) { Frame Fp = fresh(F); mla_row_phase(Fp, Dd, args.in[14], args.in[15], CQN, CKVN, KR); } SEAM(13);
    if (IN(14)) { GEMM_CALL(pg8::EpiBf16<0>, CQN, ws + WS_MUQ, SEQ, QW, QR, Qb, QW, nullptr, 0, 0, 1.f);
                  GEMM_CALL(pg8::EpiBf16<0>, CKVN, ws + WS_MUKV, MT, KVW, KVR, KVb, KVW, nullptr, 0, 0, 1.f); } SEAM(14);
    if (IN(15)) for (int rep_ = 0; rep_ < REP_ATT; ++rep_) {
        const int c = blockIdx.x;
        for (int i = 0;; ++i) { int head, qb;
            if (F.G == 256) { if (i >= 8) break; head = i * 4 + ((c & 7) >> 1); qb = (c & 1) * 32 + (c >> 3); }
            else { const int u = i * F.G + c; if (u >= NH * (SEQ / 256)) break; head = u >> 6; qb = u & 63; }
            att::attn_unit(Qb + (size_t)qb * 256 * QW + head * (NOPE + ROPE), KVb + head * (NOPE + VD), KVb + head * (NOPE + VD) + NOPE, KR, Z + (size_t)qb * 256 * DM + head * VD, qb * 256, MT, (char*)lds);
            __syncthreads(); }
    } SEAM(15);
    if (IN(16)) { GEMM_CALL(pg8::EpiBf16<0>, Z, ws + WS_MOUT, SEQ, DM, DM, Y, DM, nullptr, 0, 0, 1.f); } SEAM(16);
    if (IN(17)) { Frame Fp = fresh(F); row_phase<true, true, RXS, RXD>(Fp, 0, SEQ, (int)blockIdx.x, F.G, XRL, XC, XRL, XC, Y, MODV(1, 0, 2), MODV(1, 1, 2), GAIN(1, 1), HB, GAIN(1, 2), MODV(1, 0, 3), MODV(1, 1, 3), MODV(1, 0, 4), MODV(1, 1, 4)); } SEAM(17);
    if (IN(17)) { for (int rep_ = 1; rep_ < REP_ROW; ++rep_) { Frame Fp = fresh(F); row_phase<true, true, 0, 2>(Fp, 0, SEQ, (int)blockIdx.x, F.G, XL, XC, (float*)(ws + WS_KV), XC, Y, MODV(1, 0, 2), MODV(1, 1, 2), GAIN(1, 1), (bf16*)(ws + WS_Q), GAIN(1, 2), MODV(1, 0, 3), MODV(1, 1, 3), MODV(1, 0, 4), MODV(1, 1, 4)); } }
#ifdef REP_BAR
    if (IN(17) && IN(18)) { for (int rep_ = 0; rep_ < REP_BAR; ++rep_) xcd_barrier(bar); }
#endif
    if (IN(18)) { for (int rep_ = 0; rep_ < REP_GU; ++rep_) { GEMM_CALL(pg8::EpiSwiglu, HB, ws + WS_WGU + SZ_WGU, SEQ, NGU, DM, U, FFP); } } SEAM(18);
    if (IN(19)) { for (int rep_ = 0; rep_ < REP_DN; ++rep_) { GEMM_DOWN(U, ws + WS_WD + SZ_WD, Y, DM, nullptr, 0, 0, 1.f); } } SEAM(19);
    if (IN(20)) { Frame Fp = fresh(F); row_phase<true, true, RXS, RXD>(Fp, 0, SEQ, (int)blockIdx.x, F.G, XRL, XC, XRL, XC, Y, MODV(1, 0, 5), MODV(1, 1, 5), GAIN(1, 3), HB, GAIN(2, 0), MODV(2, 0, 0), MODV(2, 1, 0), MODV(2, 0, 1), MODV(2, 1, 1)); } SEAM(20);

    bf16* const GT = (bf16*)(ws + WS_GT); bf16* const VVT = (bf16*)(ws + WS_VVT); bf16* const YT = (bf16*)(ws + WS_YT);
    if (IN(21)) { GEMM_CALL(pg8::EpiBf16<0>, HB, ws + WS_HYIN, SEQ, 3 * DM, DM, U, 3 * DM, nullptr, 0, 0, 1.f);
                  GEMM_CALL(pg8::EpiBf16<0>, ws + WS_W4T, ws + WS_HD3, 8192, SEQ, FHP, GT, SEQ, nullptr, 0, 0, 1.f); } SEAM(21);
    if (IN(22)) { for (int rep_ = 0; rep_ < REP_MISC; ++rep_) { Frame Fp = fresh(F); hy_h2_phase(Fp, U, args.in[20], args.in[21], VVT); } } SEAM(22);
    if (IN(23)) { for (int rep_ = 0; rep_ < REP_FFT; ++rep_) { Frame Fp = fresh(F); hy_fft_phase(Fp, GT, VVT, args.in[30], YT, 3.0701134573253945f, (15.350567286626972f - 3.0701134573253945f) / 4095.0f, 1.4426950408889634f / 16383.0f); } } SEAM(23);
    if (IN(24)) { for (int rep_ = 0; rep_ < REP_MISC; ++rep_) { Frame Fp = fresh(F); hy_h4_phase(Fp, U, args.in[20], args.in[21], YT, Z); } } SEAM(24);
    if (IN(25)) { GEMM_CALL(pg8::EpiBf16<0>, Z, ws + WS_HYOUT, SEQ, DM, DM, Y, DM, nullptr, 0, 0, 1.f); } SEAM(25);
    if (IN(26)) { Frame Fp = fresh(F); row_phase<true, true, RXS, RXD>(Fp, 0, SEQ, (int)blockIdx.x, F.G, XRL, XC, XRL, XC, Y, MODV(2, 0, 2), MODV(2, 1, 2), GAIN(2, 1), HB, GAIN(2, 2), MODV(2, 0, 3), MODV(2, 1, 3), MODV(2, 0, 4), MODV(2, 1, 4)); } SEAM(26);
    if (IN(27)) { GEMM_CALL(pg8::EpiSwiglu, HB, ws + WS_WGU + 2 * SZ_WGU, SEQ, NGU, DM, U, FFP); } SEAM(27);
    if (IN(28)) { GEMM_DOWN(U, ws + WS_WD + 2 * SZ_WD, Y, DM, nullptr, 0, 0, 1.f); } SEAM(28);
    if (IN(29)) { Frame Fp = fresh(F); row_phase<true, true, RXS, RXD>(Fp, 0, SEQ, (int)blockIdx.x, F.G, XRL, XC, XRL, XC, Y, MODV(2, 0, 5), MODV(2, 1, 5), GAIN(2, 3), HB, GAIN(3, 0), MODV(3, 0, 0), MODV(3, 1, 0), MODV(3, 0, 1), MODV(3, 1, 1)); } SEAM(29);

    if (IN(30)) { for (int rep_ = 0; rep_ < REP_SCIN; ++rep_) { GEMM_CALL(pg8::EpiScIn, HB, ws + WS_SCIN + SZ_W3, SEQ, 3 * DM, DM, Pb, Bqb, DM); } } SEAM(30);
    if (IN(31)) { for (int rep_ = 0; rep_ < REP_MISC; ++rep_) { Frame Fp = fresh(F); sc_conv_phase(Fp, 0, SEQ, (int)blockIdx.x, F.G, Pb, Bqb, args.in[11] + 3 * DM, Z); } } SEAM(31);
    if (IN(32)) { GEMM_CALL(pg8::EpiBf16<0>, Z, ws + WS_SCOUT + SZ_SQ, SEQ, DM, DM, Y, DM, nullptr, 0, 0, 1.f); } SEAM(32);
    if (IN(33)) { Frame Fp = fresh(F); row_phase<true, true, RXS, RXD>(Fp, 0, SEQ, (int)blockIdx.x, F.G, XRL, XC, XRL, XC, Y, MODV(3, 0, 2), MODV(3, 1, 2), GAIN(3, 1), HB, GAIN(3, 2), MODV(3, 0, 3), MODV(3, 1, 3), MODV(3, 0, 4), MODV(3, 1, 4)); } SEAM(33);
    if (IN(34)) { GEMM_CALL(pg8::EpiSwiglu, HB, ws + WS_WGU + 3 * SZ_WGU, SEQ, NGU, DM, U, FFP); } SEAM(34);
    if (IN(35)) { GEMM_DOWN(U, ws + WS_WD + 3 * SZ_WD, Y, DM, nullptr, 0, 0, 1.f); } SEAM(35);
    if (IN(36)) { Frame Fp = fresh(F); row_phase<true, false, RXS, 2>(Fp, 0, SEQ, (int)blockIdx.x, F.G, XRL, XC, XL, XC, Y, MODV(3, 0, 5), MODV(3, 1, 5), GAIN(3, 3), nullptr, nullptr, nullptr, nullptr, nullptr, nullptr); }
#undef IN
#undef SEAM
}

extern "C" void kernel_launch(void* const* d_in, const int* in_sizes, int n_in, void* d_out, int out_size, void* d_ws, size_t ws_size, hipStream_t stream) {
    static int grid = 0;
    if (grid == 0) {
        if (n_in != 32 || in_sizes[0] != SEQ * DM || out_size != SEQ * DM || ws_size < WS_END) {
            fprintf(stderr, "kernel_launch: shape mismatch: n_in %d in0 %d out %d ws %zu (need >= %zu); nothing launched\n", n_in, n_in > 0 ? in_sizes[0] : -1, out_size, ws_size, (size_t)WS_END); grid = -1; return; }
        int dev = 0, cus = 0, per_cu = 0;
        if (hipGetDevice(&dev) != hipSuccess || hipDeviceGetAttribute(&cus, hipDeviceAttributeMultiprocessorCount, dev) != hipSuccess) { fprintf(stderr, "kernel_launch: device query failed\n"); grid = -1; return; }
        if (hipFuncSetAttribute((const void*)mega_fwd, hipFuncAttributeMaxDynamicSharedMemorySize, LDS_BYTES) != hipSuccess) { fprintf(stderr, "kernel_launch: hipFuncSetAttribute failed\n"); grid = -1; return; }
        if (hipOccupancyMaxActiveBlocksPerMultiprocessor(&per_cu, (const void*)mega_fwd, NTHR, LDS_BYTES) != hipSuccess || per_cu < 1)
            fprintf(stderr, "kernel_launch: note: occupancy query reports %d workgroups per CU\n", per_cu);
        (void)hipGetLastError();
        grid = cus;
    }
    if (grid < 0) return;
    if (hipMemsetAsync((char*)d_ws + WS_CTL, 0, CTL_BYTES, stream) != hipSuccess) { fprintf(stderr, "kernel_launch: memset failed\n"); return; }
    Args a{};
    for (int i = 0; i < 32; ++i) a.in[i] = (const float*)d_in[i];
    a.out = (float*)d_out; a.ws = (unsigned char*)d_ws;
#if MK_MULTI
    for (int p = 0; p < MK_PH_END; ++p) { a.ph_lo = p; a.ph_hi = p + 1; hipLaunchKernelGGL(mega_fwd, dim3(grid), dim3(NTHR), LDS_BYTES, stream, a); }
#else
    a.ph_lo = 0; a.ph_hi = MK_PH_END;
    hipLaunchKernelGGL(mega_fwd, dim3(grid), dim3(NTHR), LDS_BYTES, stream, a);
#endif
    const hipError_t le = hipPeekAtLastError();
    if (le != hipSuccess) fprintf(stderr, "kernel_launch: launch failed: %s\n", hipGetErrorName(le));
}
```

```cpp
#include <hip/hip_runtime.h>
#include <cstdio>
#include <cstdint>
namespace pg8 {
#define PG8_LAS __attribute__((address_space(3)))
typedef unsigned short bf16_t;
typedef short bf16x8 __attribute__((ext_vector_type(8)));
typedef float f32x4 __attribute__((ext_vector_type(4)));
typedef unsigned u32x4 __attribute__((ext_vector_type(4)));
constexpr int BM = 256, BK = 64, HALF = 128, HTB = HALF * BK * 2  , STAGE_BYTES = 8 * HTB, NXCD = 8, WGM = 8;

__host__ __device__ __forceinline__ int lds_byte(int r, int c) { const int st = (r >> 4) * 2 + (c >> 5), rr = r & 15, cc = c & 31, ob = rr * 64 + cc * 2; return st * 1024 + (ob ^ (((ob >> 9) & 1) << 5)); }
__host__ __device__ __forceinline__ void stage_rc(int b, int& R, int& C) { const int st = b / 1024, sb = b % 1024, swz = sb ^ (((sb >> 9) & 1) << 5); R = (st >> 1) * 16 + swz / 64; C = (st & 1) * 32 + (swz % 64) / 2; }
__host__ __device__ __forceinline__ int perm32(int rho) { const int n = rho >> 4, i = rho & 15; return 8 * (i >> 2) + 4 * n + (i & 3); }

struct Unit { int pm, pn; };
struct Gemm { const bf16_t* A; const bf16_t* Bt; int M, N, K; int ld; };

struct StaticOrder {
    int nM, nN, nwg, G, c;
    __host__ __device__ void init(int M, int N, int G_, int c_) { nM = M / BM; nN = N / BM; nwg = nM * nN; G = G_; c = c_; }
    __host__ __device__ bool next(int i, Unit& u) const {
        const long L = (long)i * G + c; if (L >= nwg) return false;
        int wgid = (int)L; { const int q = nwg / NXCD, r = nwg % NXCD, xcd = wgid % NXCD, off = wgid / NXCD; wgid = (xcd < r ? xcd * (q + 1) : r * (q + 1) + (xcd - r) * q) + off; }
        const int nig = WGM * nN, gid = wgid / nig, fm = gid * WGM, gsz = (nM - fm) < WGM ? (nM - fm) : WGM;
        u.pm = fm + ((wgid % nig) % gsz); u.pn = (wgid % nig) / gsz; return true;
    }
    __device__ __forceinline__ void a_ready(const Unit&) const {}
    __device__ __forceinline__ void done(const Unit&) const {}
};

template <int RB, int CB> struct BlockOrder {
    static_assert(RB * CB == 32 && 8 % RB == 0 && 16 % CB == 0, "32 tiles per XCD and round");
    int c;
    __host__ __device__ void init(int c_) { c = c_; }
    __host__ __device__ bool next(int i, Unit& u) const {
        constexpr int NCG = 16 / CB, NRS = 8 / RB; if (i >= NCG * NRS) return false;
        const int x = c & 7, s = c >> 3, cg = i % NCG, rs = i / NCG;
        u.pm = 8 * x + rs * RB + (s % RB); u.pn = cg * CB + (s / RB); return true;
    }
    __device__ __forceinline__ void a_ready(const Unit&) const {}
    __device__ __forceinline__ void done(const Unit&) const {}
};
__device__ __forceinline__ unsigned cvt_pk_bf16(float lo, float hi) { unsigned r; asm volatile("v_cvt_pk_bf16_f32 %0, %1, %2" : "=v"(r) : "v"(lo), "v"(hi)); return r; }
typedef float f32x2 __attribute__((ext_vector_type(2)));
__device__ __forceinline__ f32x2 gelu_pk(f32x2 v) {
    const f32x2 av = __builtin_elementwise_abs(v), d = av * 0.2316418882f + 1.0f;
    f32x2 t; t.x = __builtin_amdgcn_rcpf(d.x); t.y = __builtin_amdgcn_rcpf(d.y);
    f32x2 q = t * 0.5307027145f + (-0.7265760135f); q = q * t + 0.7107068705f; q = q * t + (-0.142248368f); q = q * t + 0.127414796f; q = q * t;
    const f32x2 s = (v * v) * (-0.72134752044f);
    f32x2 e; e.x = __builtin_amdgcn_exp2f(s.x); e.y = __builtin_amdgcn_exp2f(s.y);
    const f32x2 m = v * (q * e), r = v - m;
    f32x2 o; o.x = v.x < 0.f ? m.x : r.x; o.y = v.y < 0.f ? m.y : r.y; return o;
}

template <int ACT  > struct EpiBf16 {
    static constexpr bool PERM = true, AFTER_DRAIN = false; static_assert(ACT == 0 || ACT == 1, "EpiBf16: ACT is 0 (none) or 1 (gelu_pk)");
    bf16_t* O; int ldc; const float* bias; int split_cols; size_t split_stride; float scale0;
    __device__ __forceinline__ void operator()(const f32x4 (&acc)[2][2][4][2], const Unit& u, int wr, int wc, int fr, int fq) const {
        const int row0 = u.pm * BM + wr * 64 + fr; int colt = u.pn * BM; bf16_t* base = O;
        float sc = 1.f; if (split_cols) { const int t = colt / split_cols; base += (size_t)t * split_stride; colt -= t * split_cols; if (t == 0) sc = scale0; }
        const int col0 = colt + wc * 32 + 8 * fq, bcol0 = u.pn * BM + wc * 32 + 8 * fq;
        f32x4 bv[2][2];
#pragma unroll
        for (int bj = 0; bj < 2; ++bj)
#pragma unroll
            for (int n = 0; n < 2; ++n) bv[bj][n] = bias ? *(const f32x4*)(bias + bcol0 + bj * HALF + 4 * n) : (f32x4){0.f, 0.f, 0.f, 0.f};
#pragma unroll
        for (int ai = 0; ai < 2; ++ai)
#pragma unroll
            for (int m = 0; m < 4; ++m) { bf16_t* rowp = base + (size_t)(row0 + ai * HALF + m * 16) * ldc + col0;
#pragma unroll
                for (int bj = 0; bj < 2; ++bj) { f32x4 v0 = acc[ai][bj][m][0] + bv[bj][0], v1 = acc[ai][bj][m][1] + bv[bj][1];
                    if (ACT == 1) { f32x2 a = gelu_pk((f32x2){v0[0], v0[1]}), b = gelu_pk((f32x2){v0[2], v0[3]}), c = gelu_pk((f32x2){v1[0], v1[1]}), d = gelu_pk((f32x2){v1[2], v1[3]});
                        v0 = (f32x4){a.x, a.y, b.x, b.y}; v1 = (f32x4){c.x, c.y, d.x, d.y}; }
                    v0 = v0 * sc; v1 = v1 * sc; u32x4 w; w.x = cvt_pk_bf16(v0[0], v0[1]); w.y = cvt_pk_bf16(v0[2], v0[3]); w.z = cvt_pk_bf16(v1[0], v1[1]); w.w = cvt_pk_bf16(v1[2], v1[3]);
                    *(u32x4*)(rowp + bj * HALF) = w; } }
    }
};
__device__ __forceinline__ float silu_fast(float g) { return g * __builtin_amdgcn_rcpf(1.0f + __builtin_amdgcn_exp2f(-1.4426950408889634f * g)); }
__device__ __forceinline__ u32x4 pack8(const f32x4 v0, const f32x4 v1) { u32x4 w; w.x = cvt_pk_bf16(v0[0], v0[1]); w.y = cvt_pk_bf16(v0[2], v0[3]); w.z = cvt_pk_bf16(v1[0], v1[1]); w.w = cvt_pk_bf16(v1[2], v1[3]); return w; }
struct EpiF32 {
    static constexpr bool PERM = false, AFTER_DRAIN = false;
    float* C; int ldc;
    __device__ __forceinline__ void operator()(const f32x4 (&acc)[2][2][4][2], const Unit& u, int wr, int wc, int fr, int fq) const {
        const int row0 = u.pm * BM + wr * 64 + fr, col0 = u.pn * BM + wc * 32 + 4 * fq;
#pragma unroll
        for (int ai = 0; ai < 2; ++ai)
#pragma unroll
            for (int m = 0; m < 4; ++m) { float* rowp = C + (size_t)(row0 + ai * HALF + m * 16) * ldc + col0;
#pragma unroll
                for (int bj = 0; bj < 2; ++bj)
#pragma unroll
                    for (int n = 0; n < 2; ++n) *(f32x4*)(rowp + bj * HALF + n * 16) = acc[ai][bj][m][n]; }
    }
};
struct EpiSwiglu {
    static constexpr bool PERM = true, AFTER_DRAIN = false;
    bf16_t* O; int ldc;
    __device__ __forceinline__ void operator()(const f32x4 (&acc)[2][2][4][2], const Unit& u, int wr, int wc, int fr, int fq) const {
        const int row0 = u.pm * BM + wr * 64 + fr, col0 = u.pn * HALF + wc * 32 + 8 * fq;
#pragma unroll
        for (int ai = 0; ai < 2; ++ai)
#pragma unroll
            for (int m = 0; m < 4; ++m) { bf16_t* rowp = O + (size_t)(row0 + ai * HALF + m * 16) * ldc + col0;
                f32x4 r0, r1;
#pragma unroll
                for (int e = 0; e < 4; ++e) { r0[e] = silu_fast(acc[ai][0][m][0][e]) * acc[ai][1][m][0][e]; r1[e] = silu_fast(acc[ai][0][m][1][e]) * acc[ai][1][m][1][e]; }
                __builtin_nontemporal_store(pack8(r0, r1), (u32x4*)rowp); }
    }
};
struct EpiScIn {
    static constexpr bool PERM = true, AFTER_DRAIN = false;
    bf16_t* P; bf16_t* Bq; int ldc;
    __device__ __forceinline__ void operator()(const f32x4 (&acc)[2][2][4][2], const Unit& u, int wr, int wc, int fr, int fq) const {
        const int row0 = u.pm * BM + wr * 64 + fr;
        if (u.pn < 32) {
            const int col0 = u.pn * HALF + wc * 32 + 8 * fq;
#pragma unroll
            for (int ai = 0; ai < 2; ++ai)
#pragma unroll
                for (int m = 0; m < 4; ++m) { bf16_t* rowp = P + (size_t)(row0 + ai * HALF + m * 16) * ldc + col0;
                    *(u32x4*)rowp = pack8(acc[ai][0][m][0] * acc[ai][1][m][0], acc[ai][0][m][1] * acc[ai][1][m][1]); }
        } else {
            const int col0 = (u.pn - 32) * BM + wc * 32 + 8 * fq;
#pragma unroll
            for (int ai = 0; ai < 2; ++ai)
#pragma unroll
                for (int m = 0; m < 4; ++m) { bf16_t* rowp = Bq + (size_t)(row0 + ai * HALF + m * 16) * ldc + col0;
#pragma unroll
                    for (int bj = 0; bj < 2; ++bj) *(u32x4*)(rowp + bj * HALF) = pack8(acc[ai][bj][m][0], acc[ai][bj][m][1]); }
        }
    }
};
template <class Epi, class Sched, bool ALIGN_EPI = false, bool SP2 = false>
__device__ __forceinline__ void gemm_phase(PG8_LAS unsigned char* lds, const Gemm g, const Sched& S, const Epi& E) {
    int tid_ = threadIdx.x; asm volatile("" : "+v"(tid_));
    const int tid = tid_, wid = __builtin_amdgcn_readfirstlane(tid >> 6), lane = tid & 63, wr = wid >> 2, wc = wid & 3, fr = lane & 15, fq = lane >> 4;
    const int nt = g.K / BK, K = g.ld ? g.ld : g.K;
    unsigned voffA[2], voffB[2];
#pragma unroll
    for (int i = 0; i < 2; ++i) { int R, C; stage_rc(tid * 16 + i * 8192, R, C); const int Rb = Epi::PERM ? ((R & ~31) + perm32(R & 31)) : R;
        voffA[i] = (unsigned)(R * K + C) * 2u; voffB[i] = (unsigned)(Rb * K + C) * 2u; }
    const size_t kstep = (size_t)(BK * 2);
    const size_t hstep = (size_t)HALF * K * 2;
    const size_t tstep = 2 * hstep;
    const unsigned ldsw = (unsigned)wid * 1024u;
    const int aoff = lds_byte(wr * 64 + fr, fq * 8), boff = lds_byte(wc * 32 + fr, fq * 8);
#define PG8_SA(b, h) (((b) * 2 + (h)) * HTB)
#define PG8_SB(b, h) ((4 + (b) * 2 + (h)) * HTB)
#define PG8_STAGE(bufoff, gbase, voff) do { _Pragma("unroll") for (int _i = 0; _i < 2; ++_i) \
        __builtin_amdgcn_global_load_lds((const unsigned*)((const char*)(gbase) + (voff)[_i]), (PG8_LAS unsigned*)(lds + (bufoff) + ldsw + _i * 8192), 16, 0, 0); } while (0)
#define PG8_LDA(dst, b, h) do { _Pragma("unroll") for (int m = 0; m < 4; ++m) _Pragma("unroll") for (int k = 0; k < 2; ++k) dst[m][k] = *(const PG8_LAS bf16x8*)(lds + PG8_SA(b, h) + aoff + m * 2048 + k * 1024); } while (0)
#define PG8_LDB(dst, b, h) do { _Pragma("unroll") for (int n = 0; n < 2; ++n) _Pragma("unroll") for (int k = 0; k < 2; ++k) dst[n][k] = *(const PG8_LAS bf16x8*)(lds + PG8_SB(b, h) + boff + n * 2048 + k * 1024); } while (0)
#define PG8_MMA(ai, bj, At, Bt) do { __builtin_amdgcn_s_setprio(1); _Pragma("unroll") for (int m = 0; m < 4; ++m) _Pragma("unroll") for (int n = 0; n < 2; ++n) _Pragma("unroll") for (int k = 0; k < 2; ++k) \
        acc[ai][bj][m][n] = __builtin_amdgcn_mfma_f32_16x16x32_bf16(Bt[n][k], At[m][k], acc[ai][bj][m][n], 0, 0, 0); __builtin_amdgcn_s_setprio(0); } while (0)
#define PG8_WAIT_V(n) asm volatile("s_waitcnt vmcnt(" #n ")" ::: "memory")
#define PG8_WAIT_L(n) asm volatile("s_waitcnt lgkmcnt(" #n ")" ::: "memory")
#define PG8_BAR __builtin_amdgcn_s_barrier()
#define PG8_SCHED __builtin_amdgcn_sched_barrier(0)
    Unit cur, nxt; int ui = 0;
    if (!S.next(0, cur)) return;
    f32x4 acc[2][2][4][2];
#pragma unroll
    for (int a = 0; a < 2; ++a)
#pragma unroll
        for (int b = 0; b < 2; ++b)
#pragma unroll
            for (int m = 0; m < 4; ++m)
#pragma unroll
                for (int n = 0; n < 2; ++n) acc[a][b][m][n] = (f32x4){0.f, 0.f, 0.f, 0.f};
    bf16x8 At[4][2], B0[2][2], B1[2][2];
    const char* cA = (const char*)g.A + (size_t)cur.pm * tstep; const char* cB = (const char*)g.Bt + (size_t)cur.pn * tstep;
    S.a_ready(cur);
    if constexpr (SP2) {
        PG8_STAGE(PG8_SB(0, 0), cB, voffB); PG8_STAGE(PG8_SB(0, 1), cB + hstep, voffB); PG8_STAGE(PG8_SA(0, 0), cA, voffA); PG8_STAGE(PG8_SA(0, 1), cA + hstep, voffA);
        if (wr == 1) PG8_BAR;
        PG8_WAIT_V(2); PG8_BAR;
        PG8_STAGE(PG8_SB(1, 0), cB + kstep, voffB); PG8_STAGE(PG8_SA(1, 0), cA + kstep, voffA); PG8_STAGE(PG8_SB(1, 1), cB + hstep + kstep, voffB);
        PG8_WAIT_V(6); PG8_BAR;
    } else {
        PG8_STAGE(PG8_SB(0, 0), cB, voffB); PG8_STAGE(PG8_SA(0, 0), cA, voffA); PG8_STAGE(PG8_SB(0, 1), cB + hstep, voffB); PG8_STAGE(PG8_SA(0, 1), cA + hstep, voffA);
        if (wr == 1) PG8_BAR;
        PG8_WAIT_V(4); PG8_BAR;
        PG8_STAGE(PG8_SB(1, 0), cB + kstep, voffB); PG8_STAGE(PG8_SA(1, 0), cA + kstep, voffA); PG8_STAGE(PG8_SB(1, 1), cB + hstep + kstep, voffB);
        PG8_WAIT_V(6); PG8_BAR;
    }
    for (;;) {
        const bool has_next = S.next(ui + 1, nxt);
        const char* nA = has_next ? (const char*)g.A + (size_t)nxt.pm * tstep : cA; const char* nB = has_next ? (const char*)g.Bt + (size_t)nxt.pn * tstep : cB;
        for (int t = 0; t < nt; t += 2) {
            const bool last = (t == nt - 2);
            const char* a1 = cA + (size_t)(t + 1) * kstep;
            const char* a2 = last ? nA : cA + (size_t)(t + 2) * kstep; const char* b2 = last ? nB : cB + (size_t)(t + 2) * kstep;
            const char* a3 = a2 + kstep; const char* b3 = b2 + kstep;
            if (last && has_next) S.a_ready(nxt);
            if constexpr (SP2) {
            PG8_LDB(B0, 0, 0); PG8_LDB(B1, 0, 1); PG8_SCHED; PG8_LDA(At, 0, 0); PG8_STAGE(PG8_SA(1, 1), a1 + hstep, voffA);
            PG8_WAIT_V(8); PG8_WAIT_L(0); PG8_BAR; PG8_MMA(0, 0, At, B0); PG8_MMA(0, 1, At, B1); PG8_BAR; PG8_SCHED;
            PG8_LDA(At, 0, 1); PG8_STAGE(PG8_SB(0, 0), b2, voffB); PG8_STAGE(PG8_SB(0, 1), b2 + hstep, voffB); PG8_STAGE(PG8_SA(0, 0), a2, voffA);
            PG8_WAIT_V(8); PG8_WAIT_L(0); PG8_BAR; PG8_MMA(1, 0, At, B0); PG8_MMA(1, 1, At, B1); PG8_BAR; PG8_SCHED;
            PG8_LDB(B0, 1, 0); PG8_LDB(B1, 1, 1); PG8_SCHED; PG8_LDA(At, 1, 0); PG8_STAGE(PG8_SA(0, 1), a2 + hstep, voffA);
            PG8_WAIT_V(8); PG8_WAIT_L(0); PG8_BAR; PG8_MMA(0, 0, At, B0); PG8_MMA(0, 1, At, B1); PG8_BAR; PG8_SCHED;
            PG8_LDA(At, 1, 1); PG8_STAGE(PG8_SB(1, 0), b3, voffB); PG8_STAGE(PG8_SB(1, 1), b3 + hstep, voffB); PG8_STAGE(PG8_SA(1, 0), a3, voffA);
            PG8_WAIT_V(8); PG8_WAIT_L(0); PG8_BAR; PG8_MMA(1, 0, At, B0); PG8_MMA(1, 1, At, B1); PG8_BAR; PG8_SCHED;
            } else {
            PG8_LDB(B0, 0, 0); PG8_SCHED; PG8_LDA(At, 0, 0); PG8_STAGE(PG8_SA(1, 1), a1 + hstep, voffA);
            PG8_WAIT_L(8); PG8_BAR; PG8_WAIT_L(0); PG8_MMA(0, 0, At, B0); PG8_BAR; PG8_SCHED;
            PG8_LDB(B1, 0, 1); PG8_STAGE(PG8_SB(0, 0), b2, voffB);
            PG8_BAR; PG8_WAIT_L(0); PG8_MMA(0, 1, At, B1); PG8_BAR;
            PG8_LDA(At, 0, 1); PG8_STAGE(PG8_SA(0, 0), a2, voffA);
            PG8_BAR; PG8_WAIT_L(0); PG8_MMA(1, 0, At, B0); PG8_BAR; PG8_SCHED;
            PG8_STAGE(PG8_SB(0, 1), b2 + hstep, voffB);
            PG8_WAIT_V(6); PG8_BAR; PG8_MMA(1, 1, At, B1); PG8_BAR;
            PG8_LDB(B0, 1, 0); PG8_SCHED; PG8_LDA(At, 1, 0); PG8_STAGE(PG8_SA(0, 1), a2 + hstep, voffA);
            PG8_WAIT_L(8); PG8_BAR; PG8_WAIT_L(0); PG8_MMA(0, 0, At, B0); PG8_BAR; PG8_SCHED;
            PG8_LDB(B1, 1, 1); PG8_STAGE(PG8_SB(1, 0), b3, voffB);
            PG8_BAR; PG8_WAIT_L(0); PG8_MMA(0, 1, At, B1); PG8_BAR;
            PG8_LDA(At, 1, 1); PG8_STAGE(PG8_SA(1, 0), a3, voffA);
            PG8_BAR; PG8_WAIT_L(0); PG8_MMA(1, 0, At, B0); PG8_BAR; PG8_SCHED;
            PG8_STAGE(PG8_SB(1, 1), b3 + hstep, voffB);
            PG8_WAIT_V(6); PG8_BAR; PG8_MMA(1, 1, At, B1); PG8_BAR;
            }
        }
        if constexpr (ALIGN_EPI) { if (wr == 0) PG8_BAR; }
        if constexpr (!Epi::AFTER_DRAIN) { E(acc, cur, wr, wc, fr, fq); S.done(cur); }
        if (!has_next) break;
#pragma unroll
        for (int a = 0; a < 2; ++a)
#pragma unroll
            for (int b = 0; b < 2; ++b)
#pragma unroll
                for (int m = 0; m < 4; ++m)
#pragma unroll
                    for (int n = 0; n < 2; ++n) acc[a][b][m][n] = (f32x4){0.f, 0.f, 0.f, 0.f};
        cur = nxt; cA = nA; cB = nB; ++ui;
        if constexpr (ALIGN_EPI) { if (wr == 1) PG8_BAR; }
    }
    PG8_WAIT_V(0);
    if constexpr (!ALIGN_EPI) { if (wr == 0) PG8_BAR; }
    PG8_BAR;
    if constexpr (Epi::AFTER_DRAIN) { E.fused(acc, cur, wr, wc, fr, fq, lds, wid, lane); S.done(cur); }
#undef PG8_SA
#undef PG8_SB
#undef PG8_STAGE
#undef PG8_LDA
#undef PG8_LDB
#undef PG8_MMA
#undef PG8_WAIT_V
#undef PG8_WAIT_L
#undef PG8_BAR
#undef PG8_SCHED
}
}

#ifndef PG8_SP2
#define PG8_SP2 true
#endif
#ifndef PG8_ALIGN
#define PG8_ALIGN true
#endif
#define GAS __attribute__((address_space(1)))
#define LAS __attribute__((address_space(3)))
typedef unsigned short bf16;
typedef unsigned v4u __attribute__((ext_vector_type(4)));
typedef unsigned v2u __attribute__((ext_vector_type(2)));
typedef float f32x4 __attribute__((ext_vector_type(4)));
typedef float f32x2 __attribute__((ext_vector_type(2)));
typedef GAS unsigned gu32;
#define RLX_AGENT __ATOMIC_RELAXED, __HIP_MEMORY_SCOPE_AGENT
#define LDS_WAIT() asm volatile("s_waitcnt lgkmcnt(0)" ::: "memory")
#define VM_WAIT() asm volatile("s_waitcnt vmcnt(0)" ::: "memory")
__device__ __forceinline__ unsigned pk2(float lo, float hi) { return pg8::cvt_pk_bf16(lo, hi); }
__device__ __forceinline__ float bflo(unsigned w) { return __uint_as_float(w << 16); }
__device__ __forceinline__ float bfhi(unsigned w) { return __uint_as_float(w & 0xffff0000u); }
__device__ __forceinline__ float bf1(unsigned short h) { return __uint_as_float((unsigned)h << 16); }

#define XB_TMO      128
#define XB_XCNT(j)  (256  + 64 * (j))
#define XB_XSUB(j)  (1280 + 64 * (j))
#define XB_XGEN(j)  (2304 + 64 * (j))
#define XB_TOP      3328
#define XB_TOPGEN   3392
#define XCD_BAR_WORDS 3456
#define XB_SPIN_CAP (1u << 18)

__device__ __forceinline__ unsigned xb_ld(unsigned* p)              { return __hip_atomic_load(p, __ATOMIC_RELAXED, __HIP_MEMORY_SCOPE_AGENT); }
__device__ __forceinline__ unsigned xb_add(unsigned* p, unsigned v) { return __hip_atomic_fetch_add(p, v, __ATOMIC_RELAXED, __HIP_MEMORY_SCOPE_AGENT); }
__device__ __forceinline__ unsigned xb_xcc_id() { return (unsigned)__builtin_amdgcn_s_getreg((3 << 11) | 20) & 0xFu; }
#define XB_SPIN(cond, bar) do { unsigned _sp = 0; while (cond) { __builtin_amdgcn_s_sleep(1); \
    if ((++_sp & 255u) == 0u) { if (xb_ld(&(bar)[XB_TMO])) break; if (_sp > XB_SPIN_CAP) { atomicAdd(&(bar)[XB_TMO], 1u); break; } } } } while (0)

struct XcdBarrier {
    unsigned* bar; unsigned x;
    volatile LAS unsigned* st;
};

__device__ __forceinline__ XcdBarrier xcd_barrier_post(unsigned* bar, volatile LAS unsigned* st) {
    XcdBarrier b; b.bar = bar; b.x = xb_xcc_id(); b.st = st;
    if (threadIdx.x == 0) (void)xb_add(&bar[XB_XCNT(b.x)], 1u);
    return b;
}
__device__ __forceinline__ void xcd_barrier_complete(unsigned* bar, unsigned x, unsigned& nloc, unsigned& nx) {
    const unsigned G = gridDim.x * gridDim.y * gridDim.z;
    unsigned sum, cnt, mine, sp = 0u;
    for (;;) {
        sum = 0u; cnt = 0u; mine = 0u;
#pragma unroll
        for (unsigned j = 0; j < 16; ++j) { const unsigned c = xb_ld(&bar[XB_XCNT(j)]); sum += c; cnt += (c > 0u) ? 1u : 0u; mine = (j == x) ? c : mine; }
        if (sum == G) break;
        __builtin_amdgcn_s_sleep(1);
        if ((++sp & 255u) == 0u) { if (xb_ld(&bar[XB_TMO])) break; if (sp > XB_SPIN_CAP) { atomicAdd(&bar[XB_TMO], 1u); break; } }
    }
    nloc = mine > 0u ? mine : 1u; nx = cnt > 0u ? cnt : 1u;
}

__device__ __forceinline__ void xcd_barrier(const XcdBarrier& b) {
    asm volatile("s_waitcnt vmcnt(0)" ::: "memory");
    __syncthreads();
    if (threadIdx.x == 0) {
        unsigned* bar = b.bar;
        __builtin_amdgcn_s_waitcnt(0);
        unsigned nloc = b.st[0], nx = b.st[1];
        if (nloc == 0u) { xcd_barrier_complete(bar, b.x, nloc, nx); b.st[0] = nloc; b.st[1] = nx; }
        const unsigned old = xb_add(&bar[XB_XSUB(b.x)], 1u);
        const unsigned gen = old / nloc;
        if (old + 1u == (gen + 1u) * nloc) {
            __builtin_amdgcn_fence(__ATOMIC_RELEASE, "agent");
            asm volatile("s_waitcnt vmcnt(0)" ::: "memory");
            const unsigned og = xb_add(&bar[XB_TOP], 1u);
            const unsigned tg = og / nx;
            if (og + 1u == (tg + 1u) * nx) xb_add(&bar[XB_TOPGEN], 1u);
            else XB_SPIN(xb_ld(&bar[XB_TOPGEN]) == tg, bar);
            __builtin_amdgcn_fence(__ATOMIC_ACQUIRE, "agent");
            xb_add(&bar[XB_XGEN(b.x)], 1u);
            asm volatile("s_waitcnt vmcnt(0)" ::: "memory");
        } else {
            XB_SPIN(xb_ld(&bar[XB_XGEN(b.x)]) == gen, bar);
            __builtin_amdgcn_fence(__ATOMIC_ACQUIRE, "agent");
            asm volatile("s_waitcnt vmcnt(0)" ::: "memory");
        }
    }
    __syncthreads();
}

constexpr int NWAVES = 8, NTHR = 512;
constexpr int DM = 4096, SEQ = 16384, CTXL = 256, MT = SEQ + CTXL, FF = 11008, NGU = 2 * FF, DEPTH = 4;
constexpr int ADA_R = 256, NMOD = 6, MODW = NMOD * DM;
constexpr int QR = 1024, KVR = 512, ROPE = 64, NOPE = 128, VD = 128, NH = 32;
constexpr int MDN = QR + KVR + ROPE, MDNP = 1792;
constexpr int QW = NH * (NOPE + ROPE), KVW = NH * (NOPE + VD);
constexpr int FHP = 256;
constexpr float EPS = 1e-6f;
#ifndef MK_MULTI
#define MK_MULTI 0
#endif
#ifndef MK_PH_END
#define MK_PH_END 37
#endif
constexpr int N_PHASES = 37;

constexpr size_t WS_CTL = 0, CTL_BYTES = 1u << 20;
constexpr size_t WS_MOD = WS_CTL + CTL_BYTES;
#ifndef FF_PAD
#define FF_PAD 64
#endif
constexpr int FFP = FF + FF_PAD;
constexpr size_t SZ_WGU = (size_t)NGU * DM * 2, SZ_WD = (size_t)DM * FFP * 2, SZ_W3 = (size_t)3 * DM * DM * 2, SZ_SQ = (size_t)DM * DM * 2;
constexpr size_t WS_WGU = WS_MOD + (size_t)DEPTH * 2 * MODW * 4;
constexpr size_t WS_WD = WS_WGU + 4 * SZ_WGU;
constexpr size_t WS_SCIN = WS_WD + 4 * SZ_WD;
constexpr size_t WS_SCOUT = WS_SCIN + 2 * SZ_W3;
constexpr size_t WS_MDOWN = WS_SCOUT + 2 * SZ_SQ;
constexpr size_t WS_MUQ = WS_MDOWN + (size_t)MDNP * DM * 2;
constexpr size_t WS_MUKV = WS_MUQ + (size_t)QW * QR * 2;
constexpr size_t WS_MOUT = WS_MUKV + (size_t)KVW * KVR * 2;
constexpr size_t WS_HYIN = WS_MOUT + SZ_SQ;
constexpr size_t WS_HYOUT = WS_HYIN + SZ_W3;
constexpr size_t WS_W4T = WS_HYOUT + SZ_SQ;
constexpr size_t WS_HD3 = WS_W4T + (size_t)8192 * FHP * 2;
constexpr size_t WS_XC = WS_HD3 + (size_t)SEQ * FHP * 2;
constexpr size_t WS_HB = WS_XC + (size_t)CTXL * DM * 4;
constexpr size_t WS_U = WS_HB + (size_t)MT * DM * 2;
constexpr size_t WS_Z = WS_U + (size_t)MT * 3 * DM * 2;
constexpr size_t WS_Y = WS_Z + (size_t)MT * DM * 2;
constexpr size_t WS_D = WS_Y + (size_t)MT * DM * 2;
constexpr size_t WS_CQN = WS_D + (size_t)MT * MDNP * 4;
constexpr size_t WS_CKVN = WS_CQN + (size_t)MT * QR * 2;
constexpr size_t WS_KR = WS_CKVN + (size_t)MT * KVR * 2;
constexpr size_t WS_Q = WS_KR + (size_t)MT * ROPE * 2;
constexpr size_t WS_KV = WS_Q + (size_t)SEQ * QW * 2;
constexpr size_t WS_GT = WS_KV + (size_t)MT * KVW * 2;
constexpr size_t WS_VVT = WS_GT + (size_t)8192 * SEQ * 2;
constexpr size_t WS_YT = WS_VVT + (size_t)DM * SEQ * 2;
constexpr size_t WS_PART = WS_YT + (size_t)DM * SEQ * 2;
constexpr size_t WS_XB = WS_PART + (size_t)DEPTH * 64 * 2 * 256 * 4;
constexpr size_t WS_END = WS_XB + (size_t)SEQ * DM * 2;
static_assert(WS_WGU % 256 == 0 && WS_END % 256 == 0, "ws map alignment");
constexpr int CW_TMO = 0, CW_CODE = 1, CW_BAR = 4096, CW_T = 16384;

constexpr int LDS_BYTES = 163840;
constexpr int LDSCTL_OFF = 159744, MISC_OFF = LDSCTL_OFF + 320;
static_assert(MISC_OFF + 128 <= LDS_BYTES, "LDS map");


struct Frame {
    LAS unsigned char* lds;
    volatile LAS unsigned* MISC;
    gu32* ctl;
    int tid, lane, wave;
    int G;
};
__device__ __forceinline__ Frame fresh(const Frame& F) { Frame P = F; int t = F.tid; asm volatile("" : "+v"(t)); P.tid = t; P.lane = t & 63; return P; }
__device__ __forceinline__ float wave_sum(float v) {
#pragma unroll
    for (int o = 1; o < 64; o <<= 1) v += __shfl_xor(v, o);
    return v;
}
__device__ __forceinline__ void unpack8(const v4u w, float (&f)[8]) {
    f[0] = bflo(w.x); f[1] = bfhi(w.x); f[2] = bflo(w.y); f[3] = bfhi(w.y); f[4] = bflo(w.z); f[5] = bfhi(w.z); f[6] = bflo(w.w); f[7] = bfhi(w.w);
}
__device__ __forceinline__ v4u pack8f(const float (&f)[8]) { v4u w; w.x = pk2(f[0], f[1]); w.y = pk2(f[2], f[3]); w.z = pk2(f[4], f[5]); w.w = pk2(f[6], f[7]); return w; }

__device__ __forceinline__ void conv_item(const float* W, int N, bf16* WT, int KD, int k0, int n0, int drow0, LAS float* scr, int lane) {
#pragma unroll 8
    for (int i = 0; i < 32; ++i) { const int kk = 2 * i + (lane >> 5); scr[kk * 33 + (lane & 31)] = W[(size_t)(k0 + kk) * N + n0 + (lane & 31)]; }
    LDS_WAIT(); asm volatile("" ::: "memory");
    const int c = lane & 7;
#pragma unroll
    for (int j = 0; j < 4; ++j) { const int n = (lane >> 3) + 8 * j; const LAS float* s = scr + (8 * c) * 33 + n;
        v4u o; o.x = pk2(s[0 * 33], s[1 * 33]); o.y = pk2(s[2 * 33], s[3 * 33]); o.z = pk2(s[4 * 33], s[5 * 33]); o.w = pk2(s[6 * 33], s[7 * 33]);
        *(GAS v4u*)(WT + (size_t)(drow0 + n) * KD + k0 + 8 * c) = o; }
    LDS_WAIT(); asm volatile("" ::: "memory");
}
__device__ __forceinline__ int map_pair(int n0, int half) { return n0 < half ? ((n0 >> 7) * 256 + (n0 & 127)) : ((((n0 - half) >> 7) * 256) + 128 + ((n0 - half) & 127)); }
__device__ __forceinline__ int map_scin(int n0) { return n0 < DM ? (2 * DM + n0) : map_pair(n0 - DM, DM); }

struct Args { const float* in[32]; float* out; unsigned char* ws; int ph_lo, ph_hi; };

__device__ __forceinline__ void p0_prologue(Frame& F, const Args& A) {
    unsigned char* ws = A.ws;
    LAS float* scr = (LAS float*)(F.lds + F.wave * 16384);
    const int gw = blockIdx.x * NWAVES + F.wave, NGW = F.G * NWAVES, lane = F.lane;
    constexpr int I_GU = (DM / 64) * (NGU / 32), I_D = (FF / 64) * (DM / 32), I_3 = (DM / 64) * (3 * DM / 32), I_SQ = (DM / 64) * (DM / 32);
    constexpr int I_MD = (DM / 64) * (MDN / 32), I_UQ = (QR / 64) * (QW / 32), I_UKV = (KVR / 64) * (KVW / 32), I_W4 = 8192 / 32;
    constexpr int NITEMS = 4 * I_GU + 4 * I_D + 2 * I_3 + 2 * I_SQ + I_MD + I_UQ + I_UKV + I_SQ + I_3 + I_SQ + I_W4;
    for (int it = gw; it < NITEMS; it += NGW) {
        int r = it;
        if (r < 4 * I_GU) { const int L = r / I_GU, rr = r % I_GU, nblk = NGU / 32, kb = rr / nblk, n0 = (rr % nblk) * 32;
            conv_item(A.in[8] + (size_t)L * DM * NGU, NGU, (bf16*)(ws + WS_WGU + L * SZ_WGU), DM, kb * 64, n0, map_pair(n0, FF), scr, lane); continue; } r -= 4 * I_GU;
        if (r < 4 * I_D) { const int L = r / I_D, rr = r % I_D, nblk = DM / 32, kb = rr / nblk, n0 = (rr % nblk) * 32;
            conv_item(A.in[9] + (size_t)L * FF * DM, DM, (bf16*)(ws + WS_WD + L * SZ_WD), FFP, kb * 64, n0, n0, scr, lane); continue; } r -= 4 * I_D;
        if (r < 2 * I_3) { const int L = r / I_3, rr = r % I_3, nblk = 3 * DM / 32, kb = rr / nblk, n0 = (rr % nblk) * 32;
            conv_item(A.in[10] + (size_t)L * DM * 3 * DM, 3 * DM, (bf16*)(ws + WS_SCIN + L * SZ_W3), DM, kb * 64, n0, map_scin(n0), scr, lane); continue; } r -= 2 * I_3;
        if (r < 2 * I_SQ) { const int L = r / I_SQ, rr = r % I_SQ, nblk = DM / 32, kb = rr / nblk, n0 = (rr % nblk) * 32;
            conv_item(A.in[12] + (size_t)L * DM * DM, DM, (bf16*)(ws + WS_SCOUT + L * SZ_SQ), DM, kb * 64, n0, n0, scr, lane); continue; } r -= 2 * I_SQ;
        if (r < I_MD) { const int nblk = MDN / 32, kb = r / nblk, n0 = (r % nblk) * 32;
            conv_item(A.in[13], MDN, (bf16*)(ws + WS_MDOWN), DM, kb * 64, n0, n0, scr, lane); continue; } r -= I_MD;
        if (r < I_UQ) { const int nblk = QW / 32, kb = r / nblk, n0 = (r % nblk) * 32;
            conv_item(A.in[16], QW, (bf16*)(ws + WS_MUQ), QR, kb * 64, n0, n0, scr, lane); continue; } r -= I_UQ;
        if (r < I_UKV) { const int nblk = KVW / 32, kb = r / nblk, n0 = (r % nblk) * 32;
            conv_item(A.in[17], KVW, (bf16*)(ws + WS_MUKV), KVR, kb * 64, n0, n0, scr, lane); continue; } r -= I_UKV;
        if (r < I_SQ) { const int nblk = DM / 32, kb = r / nblk, n0 = (r % nblk) * 32;
            conv_item(A.in[18], DM, (bf16*)(ws + WS_MOUT), DM, kb * 64, n0, n0, scr, lane); continue; } r -= I_SQ;
        if (r < I_3) { const int nblk = 3 * DM / 32, kb = r / nblk, n0 = (r % nblk) * 32;
            conv_item(A.in[19], 3 * DM, (bf16*)(ws + WS_HYIN), DM, kb * 64, n0, n0, scr, lane); continue; } r -= I_3;
        if (r < I_SQ) { const int nblk = DM / 32, kb = r / nblk, n0 = (r % nblk) * 32;
            conv_item(A.in[31], DM, (bf16*)(ws + WS_HYOUT), DM, kb * 64, n0, n0, scr, lane); continue; } r -= I_SQ;
        { const int n0 = r * 32; conv_item(A.in[29], 8192, (bf16*)(ws + WS_W4T), FHP, 0, n0, n0, scr, lane); }
    }
    const int gt = blockIdx.x * NTHR + F.tid, NGT = F.G * NTHR;
    { GAS v4u* z = (GAS v4u*)(ws + WS_MDOWN + (size_t)MDN * DM * 2); const int nz = (MDNP - MDN) * DM * 2 / 16;
      for (int i = gt; i < nz; i += NGT) z[i] = (v4u){0u, 0u, 0u, 0u}; }
    { const int nz = 8192 * 24;
      for (int i = gt; i < nz; i += NGT) { const int row = i / 24, ch = i % 24; *(GAS v4u*)(ws + WS_W4T + (size_t)row * FHP * 2 + 128 + ch * 16) = (v4u){0u, 0u, 0u, 0u}; } }
    { float* PART = (float*)(ws + WS_PART); const float* cl = A.in[1]; const float* cc = A.in[3];
      for (int it = blockIdx.x; it < 128; it += F.G) { const int L = it >> 5, kc = it & 31, j = F.tid & 255, kh = F.tid >> 8, k0 = kc * 128 + kh * 64;
          const float* wd = A.in[4] + (size_t)L * DM * ADA_R; float al = 0.f, ac = 0.f;
#pragma unroll 8
          for (int kk = 0; kk < 64; ++kk) { const int k = k0 + kk; const float w = wd[(size_t)k * ADA_R + j]; const float a = cl[k], b = cc[k];
              al += (a / (1.f + expf(-a))) * w; ac += (b / (1.f + expf(-b))) * w; }
          float* p = PART + ((size_t)(L * 64 + kc * 2 + kh) * 2) * 256 + j; p[0] = al; p[256] = ac; } }
    __syncthreads();
    { LAS float* W1 = (LAS float*)F.lds; LAS float* W2 = W1 + 33 * 64; LAS float* W3 = W2 + 4096;
      for (int i = F.tid; i < 33 * 64; i += NTHR) W1[i] = A.in[22][i];
      for (int i = F.tid; i < 4096; i += NTHR) { W2[i] = A.in[24][i]; W3[i] = A.in[26][i]; }
      __syncthreads();
      const float b1 = A.in[23][lane], b2 = A.in[25][lane], b3 = A.in[27][lane], f0 = A.in[28][lane], f1 = A.in[28][64 + lane], f2 = A.in[28][128 + lane];
      bf16* HD3 = (bf16*)(ws + WS_HD3);
      const float bstep = (15.0f - 1e-4f) / 15.0f;
      for (int p = gw; p < SEQ; p += NGW) {
          const float tl = (float)p * (1.0f / 16383.0f), w = (float)p * (6.283185307179586f / 16384.0f);
          float z = 0.f;
          if (lane == 0) z = tl; else if (lane <= 16) z = cosf((1e-4f + (float)(lane - 1) * bstep) * w); else if (lane <= 32) z = -sinf((1e-4f + (float)(lane - 17) * bstep) * w);
          float a = b1;
#pragma unroll
          for (int i = 0; i < 33; ++i) a += __uint_as_float(__builtin_amdgcn_readlane(__float_as_uint(z), i)) * W1[i * 64 + lane];
          const float h1 = sinf(f0 * a); a = b2;
#pragma unroll
          for (int i = 0; i < 64; ++i) a += __uint_as_float(__builtin_amdgcn_readlane(__float_as_uint(h1), i)) * W2[i * 64 + lane];
          const float h2 = sinf(f1 * a); a = b3;
#pragma unroll
          for (int i = 0; i < 64; ++i) a += __uint_as_float(__builtin_amdgcn_readlane(__float_as_uint(h2), i)) * W3[i * 64 + lane];
          const float h3 = sinf(f2 * a);
          bf16* o = HD3 + (size_t)p * FHP + lane; o[0] = (bf16)(pk2(h3, 0.f) & 0xffffu); o[64] = 0; o[128] = 0; o[192] = 0; }
    }
}
__device__ __forceinline__ void p1_adaln(Frame& F, const Args& A) {
    LAS float* Tl = (LAS float*)F.lds; const float* PART = (const float*)(A.ws + WS_PART); float* MOD = (float*)(A.ws + WS_MOD);
    for (int it = blockIdx.x; it < DEPTH * 2 * 48; it += F.G) { const int L = it / 96, rem = it % 96, r = rem / 48, col = (rem % 48) * 512 + F.tid;
        __syncthreads(); if (F.tid < 256) { float t = 0.f; for (int i = 0; i < 64; ++i) t += PART[((size_t)(L * 64 + i) * 2 + r) * 256 + F.tid]; Tl[F.tid] = t; } __syncthreads();
        const float* up = A.in[5] + (size_t)L * ADA_R * MODW + col; float a = A.in[6][L * MODW + col];
#pragma unroll 8
        for (int j = 0; j < ADA_R; ++j) a += Tl[j] * up[(size_t)j * MODW];
        MOD[(size_t)(L * 2 + r) * MODW + col] = a; }
}
template <bool HAS_Y, bool HAS_H, int XS, int XD>
__device__ __forceinline__ void row_phase(Frame& F, int row_lo, int row_hi, int bid, int nb, const void* xs_l, const void* xs_c, void* xd_l, void* xd_c, const bf16* Y,
                                          const float* gate_l, const float* gate_c, const float* gy, bf16* HB, const float* gh,
                                          const float* shift_l, const float* shift_c, const float* scale_l, const float* scale_c) {
    const int gw = bid * NWAVES + F.wave, NGW = nb * NWAVES;
    LAS float* const LV = (LAS float*)F.lds;
    __syncthreads();
    for (int i = F.tid; i < 2 * 1024; i += NTHR) { const int r = i >> 10, c4 = (i & 1023) * 4;
        if (r == 0 ? (row_lo < SEQ) : (row_hi > SEQ)) {
            if (HAS_Y) { const f32x4 g = *(const GAS f32x4*)((r ? gate_c : gate_l) + c4), gg = *(const GAS f32x4*)(gy + c4); *(LAS f32x4*)(LV + (0 + r) * DM + c4) = g * gg; }
            if (HAS_H) { const f32x4 g = *(const GAS f32x4*)(gh + c4), s1 = *(const GAS f32x4*)((r ? scale_c : scale_l) + c4), s0 = *(const GAS f32x4*)((r ? shift_c : shift_l) + c4);
                *(LAS f32x4*)(LV + (2 + r) * DM + c4) = g * (s1 + 1.0f); *(LAS f32x4*)(LV + (4 + r) * DM + c4) = s0; } } }
    __syncthreads();
#define ROW_FENCE(j) do { if (((j) & 3) == 3) asm volatile("" ::: "memory"); } while (0)
    for (int row = row_lo + gw; row < row_hi; row += NGW) {
        int lane_ = F.lane; asm volatile("" : "+v"(lane_)); const int lane = lane_;
        const bool isc = row >= SEQ;
        const bf16* yr = Y + (size_t)row * DM;
        float rn = 0.f;
        v2u yk[16], xk[16];
        const bf16* xsb0 = (const bf16*)xs_l + (size_t)row * DM;
        if (HAS_Y) { float ss = 0.f;
#pragma unroll
            for (int j = 0; j < 16; ++j) { const v2u w = *(const GAS v2u*)(yr + 256 * j + 4 * lane); yk[j] = w; if (XS == 1) xk[j] = *(const GAS v2u*)(xsb0 + 256 * j + 4 * lane);
                const float a = bflo(w.x), b = bfhi(w.x), c = bflo(w.y), d = bfhi(w.y); ss += (a * a + b * b) + (c * c + d * d); ROW_FENCE(j); }
            rn = rsqrtf(wave_sum(ss) * (1.0f / DM) + EPS); }
        f32x4 xv[16]; float ssx = 0.f;
        const float* xsf = (const float*)(isc ? xs_c : xs_l) + (isc ? (size_t)(row - SEQ) * DM : (size_t)row * DM); const bf16* xsb = (const bf16*)xs_l + (size_t)row * DM;
        const LAS float* lv = LV + (isc ? DM : 0) + 4 * lane;
        bf16* xdb = (bf16*)xd_l + (size_t)row * DM; float* xdf = (float*)(isc ? xd_c : xd_l) + (isc ? (size_t)(row - SEQ) * DM : (size_t)row * DM);
#pragma unroll
        for (int j = 0; j < 16; ++j) {
            f32x4 x;
            if (XS == 0) x = *(const GAS f32x4*)(xsf + 256 * j + 4 * lane);
            else { const v2u w = HAS_Y ? xk[j] : *(const GAS v2u*)(xsb + 256 * j + 4 * lane); x = (f32x4){bflo(w.x), bfhi(w.x), bflo(w.y), bfhi(w.y)}; }
            if (HAS_Y) { const v2u w = yk[j]; const f32x4 yv = (f32x4){bflo(w.x), bfhi(w.x), bflo(w.y), bfhi(w.y)};
                const f32x4 v1 = *(const LAS f32x4*)(lv + 256 * j);
                x = x + (yv * rn) * v1; }
            if (XD == 1) { v2u o; o.x = pk2(x.x, x.y); o.y = pk2(x.z, x.w); *(GAS v2u*)(xdb + 256 * j + 4 * lane) = o; }
            else if (XD == 2) *(GAS f32x4*)(xdf + 256 * j + 4 * lane) = x;
            ssx += (x.x * x.x + x.y * x.y) + (x.z * x.z + x.w * x.w); xv[j] = x; ROW_FENCE(j);
        }
        if (HAS_H) {
            const float rh = rsqrtf(wave_sum(ssx) * (1.0f / DM) + EPS);
            bf16* hr = HB + (size_t)row * DM;
#pragma unroll
            for (int j = 0; j < 16; ++j) { const f32x4 v2 = *(const LAS f32x4*)(lv + 2 * DM + 256 * j), v3 = *(const LAS f32x4*)(lv + 4 * DM + 256 * j);
                const f32x4 h = (xv[j] * rh) * v2 + v3; v2u o; o.x = pk2(h.x, h.y); o.y = pk2(h.z, h.w);
                *(GAS v2u*)(hr + 256 * j + 4 * lane) = o; ROW_FENCE(j); }
        }
    }
#undef ROW_FENCE
}
__device__ __forceinline__ void sc_conv_phase(Frame& F, int row_lo, int row_hi, int bid, int nb, const bf16* P, const bf16* Bq, const float* wc, bf16* Z) {
    const int gw = bid * NWAVES + F.wave, NGW = nb * NWAVES, lane = F.lane; const int items = ((row_hi - row_lo) / 32) * 8;
    for (int it = gw; it < items; it += NGW) { const int r0 = row_lo + (it >> 3) * 32, c0 = (it & 7) * 512 + lane * 8;
        const int seg_lo = r0 < SEQ ? 0 : SEQ, seg_hi = r0 < SEQ ? SEQ : MT;
        float w0[8], w1[8], w2[8];
        { const f32x4 a = *(const f32x4*)(wc + c0), b = *(const f32x4*)(wc + c0 + 4); w0[0] = a.x; w0[1] = a.y; w0[2] = a.z; w0[3] = a.w; w0[4] = b.x; w0[5] = b.y; w0[6] = b.z; w0[7] = b.w; }
        { const f32x4 a = *(const f32x4*)(wc + DM + c0), b = *(const f32x4*)(wc + DM + c0 + 4); w1[0] = a.x; w1[1] = a.y; w1[2] = a.z; w1[3] = a.w; w1[4] = b.x; w1[5] = b.y; w1[6] = b.z; w1[7] = b.w; }
        { const f32x4 a = *(const f32x4*)(wc + 2 * DM + c0), b = *(const f32x4*)(wc + 2 * DM + c0 + 4); w2[0] = a.x; w2[1] = a.y; w2[2] = a.z; w2[3] = a.w; w2[4] = b.x; w2[5] = b.y; w2[6] = b.z; w2[7] = b.w; }
        float pv[8], cu[8], nx[8], bq[8], o[8];
        if (r0 == seg_lo) {
#pragma unroll
            for (int e = 0; e < 8; ++e) pv[e] = 0.f;
        } else unpack8(*(const GAS v4u*)(P + (size_t)(r0 - 1) * DM + c0), pv);
        unpack8(*(const GAS v4u*)(P + (size_t)r0 * DM + c0), cu);
        v4u pa[8], ba[8], pb[8], bb[8];
#define SC_LOAD(RS, PN, BV) do { _Pragma("unroll") for (int i = 0; i < 8; ++i) { const int r = (RS) + i; PN[i] = (v4u){0u, 0u, 0u, 0u}; \
            if (r + 1 < seg_hi) PN[i] = *(const GAS v4u*)(P + (size_t)(r + 1) * DM + c0); BV[i] = *(const GAS v4u*)(Bq + (size_t)r * DM + c0); } asm volatile("" ::: "memory"); } while (0)
#define SC_COMP(RS, PN, BV) do { _Pragma("unroll") for (int i = 0; i < 8; ++i) { unpack8(PN[i], nx); unpack8(BV[i], bq); \
            _Pragma("unroll") for (int e = 0; e < 8; ++e) { o[e] = bq[e] * (w0[e] * pv[e] + w1[e] * cu[e] + w2[e] * nx[e]); pv[e] = cu[e]; cu[e] = nx[e]; } \
            *(GAS v4u*)(Z + (size_t)((RS) + i) * DM + c0) = pack8f(o); } } while (0)
        SC_LOAD(r0, pa, ba);
        SC_LOAD(r0 + 8, pb, bb);  SC_COMP(r0, pa, ba);
        SC_LOAD(r0 + 16, pa, ba); SC_COMP(r0 + 8, pb, bb);
        SC_LOAD(r0 + 24, pb, bb); SC_COMP(r0 + 16, pa, ba);
        SC_COMP(r0 + 24, pb, bb);
#undef SC_LOAD
#undef SC_COMP
    }
}
__device__ __forceinline__ void mla_row_phase(Frame& F, const float* D, const float* qn, const float* kvn, bf16* CQN, bf16* CKVN, bf16* KR) {
    const int gw = blockIdx.x * NWAVES + F.wave, NGW = F.G * NWAVES, lane = F.lane;
    for (int row = gw; row < MT; row += NGW) { const float* d = D + (size_t)row * MDNP;
        f32x4 q[4]; float ss = 0.f;
#pragma unroll
        for (int j = 0; j < 4; ++j) { q[j] = *(const GAS f32x4*)(d + 256 * j + 4 * lane); ss += (q[j].x * q[j].x + q[j].y * q[j].y) + (q[j].z * q[j].z + q[j].w * q[j].w); }
        const float rq = rsqrtf(wave_sum(ss) * (1.0f / QR) + EPS);
#pragma unroll
        for (int j = 0; j < 4; ++j) { const f32x4 g = *(const f32x4*)(qn + 256 * j + 4 * lane); const f32x4 h = (q[j] * rq) * g; v2u o; o.x = pk2(h.x, h.y); o.y = pk2(h.z, h.w);
            *(GAS v2u*)(CQN + (size_t)row * QR + 256 * j + 4 * lane) = o; }
        f32x4 k[2]; ss = 0.f;
#pragma unroll
        for (int j = 0; j < 2; ++j) { k[j] = *(const GAS f32x4*)(d + QR + 256 * j + 4 * lane); ss += (k[j].x * k[j].x + k[j].y * k[j].y) + (k[j].z * k[j].z + k[j].w * k[j].w); }
        const float rk = rsqrtf(wave_sum(ss) * (1.0f / KVR) + EPS);
#pragma unroll
        for (int j = 0; j < 2; ++j) { const f32x4 g = *(const f32x4*)(kvn + 256 * j + 4 * lane); const f32x4 h = (k[j] * rk) * g; v2u o; o.x = pk2(h.x, h.y); o.y = pk2(h.z, h.w);
            *(GAS v2u*)(CKVN + (size_t)row * KVR + 256 * j + 4 * lane) = o; }
        const float v = *(const GAS float*)(d + QR + KVR + lane); const float pt = __shfl_xor(v, 16); float out = v;
        if (row < SEQ) { const int i = lane & 15; const float pos = (float)((lane < 32) ? (row >> 6) : (row & 63));
            const float ang = pos * exp2f(-(float)i * 0.83048202372184059f); const float cs = cosf(ang), sn = sinf(ang);
            out = (lane & 16) ? (v * cs + pt * sn) : (v * cs - pt * sn); }
        KR[(size_t)row * ROPE + lane] = (bf16)(pk2(out, 0.f) & 0xffffu);
    }
}

namespace att {
using bf16x8 = __attribute__((ext_vector_type(8))) short;
using s16x4  = __attribute__((ext_vector_type(4))) short;
using f32x16 = __attribute__((ext_vector_type(16))) float;
using u32x4  = __attribute__((ext_vector_type(4))) unsigned;
constexpr int NW = 8, QBLK = 32, KVBLK = 64;
constexpr float SCALE_DEF = 0.07216878364870322f, SCALE = SCALE_DEF;
constexpr float THR = 8.f;
#ifndef ATT_AUG
#define ATT_AUG 1
#endif
constexpr bool ATT_AUG_ON = (ATT_AUG != 0);
constexpr float QC = SCALE_DEF * 1.4426950408889634f;
#ifndef ATT_SDEPTH
#define ATT_SDEPTH 1
#endif
constexpr int SDEPTH = ATT_SDEPTH;
constexpr int LDQ = 6144, LDK = 8192, LDR = 64, LDO = 4096;
constexpr int SHM_V = KVBLK * 128 * 2, SHM_K = KVBLK * 128 * 2, SHM_R = KVBLK * 64 * 2;
#ifndef ATT_NBUF
#define ATT_NBUF 3
#endif
constexpr int NBUF = ATT_NBUF;
static_assert(NBUF == 2 || (NBUF == 3 && SDEPTH == 1), "3 buffers use the single staging slot");
constexpr int OFF_V = 0, OFF_K = NBUF * SHM_V, OFF_R = OFF_K + NBUF * SHM_K, OFF_WS = OFF_R + NBUF * SHM_R, OFF_QR = OFF_WS + NW * 64 * 4, LDS_NEED = OFF_QR + NW * 4096;
#define KSWZ(row, colB) ((row) * 256 + ((colB) ^ (((row) & 15) << 4)))
#define RSWZ(row, colB) ((row) * 128 + ((colB) ^ ((((row) >> 1) & 7) << 4)))
#define SBAR() __builtin_amdgcn_sched_barrier(0)
__device__ __forceinline__ int crow(int r, int hi) { return (r & 3) + 8 * (r >> 2) + 4 * hi; }
__device__ __forceinline__ unsigned cvtpk(float lo, float hi) { unsigned r; asm volatile("v_cvt_pk_bf16_f32 %0, %1, %2" : "=v"(r) : "v"(lo), "v"(hi)); return r; }
__device__ __forceinline__ bf16x8 ld8(const unsigned short* p) { return *reinterpret_cast<const bf16x8*>(p); }

__device__ __forceinline__ void partialSM(f32x16& p0, f32x16& p1, float& m_reg, float& mn, float& alpha) {
  constexpr float C = SCALE * 1.4426950408889634f;
  float pmax = p0[0]; for (int r = 1; r < 16; ++r) pmax = fmaxf(pmax, p0[r]); for (int r = 0; r < 16; ++r) pmax = fmaxf(pmax, p1[r]);
  { auto rr = __builtin_amdgcn_permlane32_swap(__float_as_uint(pmax), __float_as_uint(pmax), false, false);
    pmax = fmaxf(__uint_as_float(rr[0]), __uint_as_float(rr[1])); }
  if (__builtin_expect(__all(pmax - m_reg <= THR / SCALE), 1)) { mn = m_reg; alpha = 1.f; }
  else { mn = fmaxf(m_reg, pmax); alpha = __builtin_amdgcn_exp2f((m_reg - mn) * C); m_reg = mn; }
  float mnC = -mn * C;
  for (int r = 0; r < 16; ++r) p0[r] = fmaf(p0[r], C, mnC); for (int r = 0; r < 16; ++r) p1[r] = fmaf(p1[r], C, mnC);
  for (int r = 0; r < 16; ++r) p0[r] = __builtin_amdgcn_exp2f(p0[r]);
}
__device__ __forceinline__ void finishSM(f32x16& p0, f32x16& p1, float alpha, float& l_reg, bf16x8& pa0, bf16x8& pa1, bf16x8& pa2, bf16x8& pa3) {
  for (int r = 0; r < 16; ++r) p1[r] = __builtin_amdgcn_exp2f(p1[r]);
  float ps = 0; for (int r = 0; r < 16; ++r) ps += p0[r]; for (int r = 0; r < 16; ++r) ps += p1[r];
  { auto rr = __builtin_amdgcn_permlane32_swap(__float_as_uint(ps), __float_as_uint(ps), false, false);
    ps = __uint_as_float(rr[0]) + __uint_as_float(rr[1]); }
  l_reg = l_reg * alpha + ps;
#define PK4(P, BASE, OUT) do { unsigned a0 = cvtpk(P[BASE + 0], P[BASE + 1]), a1 = cvtpk(P[BASE + 2], P[BASE + 3]);   \
    unsigned b0 = cvtpk(P[BASE + 4], P[BASE + 5]), b1 = cvtpk(P[BASE + 6], P[BASE + 7]);                              \
    auto r0 = __builtin_amdgcn_permlane32_swap(a0, b0, false, false); auto r1 = __builtin_amdgcn_permlane32_swap(a1, b1, false, false); \
    u32x4 w = {r0[0], r1[0], r0[1], r1[1]}; OUT = *reinterpret_cast<bf16x8*>(&w); } while (0)
  PK4(p0, 0, pa0); PK4(p0, 8, pa1); PK4(p1, 0, pa2); PK4(p1, 8, pa3);
#undef PK4
}
__device__ __forceinline__ void qkt(f32x16& p0, f32x16& p1, const char* Ks, const char* Rs, const bf16x8* qr, const char* Qf, int r32, int hi) {
  p0 = f32x16{}; p1 = f32x16{};
#pragma unroll
  for (int d0 = 0; d0 < 8; ++d0) { int cb = (d0 * 16 + hi * 8) * 2;
    bf16x8 b0 = *reinterpret_cast<const bf16x8*>(Ks + KSWZ(r32, cb));
    bf16x8 b1 = *reinterpret_cast<const bf16x8*>(Ks + KSWZ(32 + r32, cb));
    p0 = __builtin_amdgcn_mfma_f32_32x32x16_bf16(b0, qr[d0], p0, 0, 0, 0);
    p1 = __builtin_amdgcn_mfma_f32_32x32x16_bf16(b1, qr[d0], p1, 0, 0, 0); }
#pragma unroll
  for (int d0 = 0; d0 < 4; ++d0) { int cb = (d0 * 16 + hi * 8) * 2;
    bf16x8 b0 = *reinterpret_cast<const bf16x8*>(Rs + RSWZ(r32, cb));
    bf16x8 b1 = *reinterpret_cast<const bf16x8*>(Rs + RSWZ(32 + r32, cb));
    bf16x8 qf = *reinterpret_cast<const bf16x8*>(Qf + d0 * 1024);
    p0 = __builtin_amdgcn_mfma_f32_32x32x16_bf16(b0, qf, p0, 0, 0, 0);
    p1 = __builtin_amdgcn_mfma_f32_32x32x16_bf16(b1, qf, p1, 0, 0, 0); }
}
template <int D0> __device__ __forceinline__ void kld_pp(bf16x8& a0, bf16x8& a1, bf16x8& qf, const char* Ks, const char* Rs, const char* Qf, int r32, int hi) {
  if constexpr (D0 < 8) { const int cb = (D0 * 16 + hi * 8) * 2; a0 = *reinterpret_cast<const bf16x8*>(Ks + KSWZ(r32, cb)); a1 = *reinterpret_cast<const bf16x8*>(Ks + KSWZ(32 + r32, cb)); }
  else { const int cb = ((D0 - 8) * 16 + hi * 8) * 2; a0 = *reinterpret_cast<const bf16x8*>(Rs + RSWZ(r32, cb)); a1 = *reinterpret_cast<const bf16x8*>(Rs + RSWZ(32 + r32, cb));
         qf = *reinterpret_cast<const bf16x8*>(Qf + (D0 - 8) * 1024); }
}
__device__ __forceinline__ void qkt_pp(f32x16& p0, f32x16& p1, const char* Ks, const char* Rs, const bf16x8* qr, const char* Qf, int r32, int hi) {
  p0 = f32x16{}; p1 = f32x16{};
  bf16x8 xa0, xa1, xq, ya0, ya1, yq, za0, za1, zq;
  kld_pp<0>(xa0, xa1, xq, Ks, Rs, Qf, r32, hi); kld_pp<1>(ya0, ya1, yq, Ks, Rs, Qf, r32, hi);
  __builtin_amdgcn_sched_group_barrier(0x100, 4, 0);
#define QK_STEP(D0, A0, A1, Q, NA0, NA1, NQ) do { if constexpr ((D0) + 2 < 12) kld_pp<(D0) + 2>(NA0, NA1, NQ, Ks, Rs, Qf, r32, hi); \
    { const bf16x8 bq_ = (D0) < 8 ? qr[(D0) < 8 ? (D0) : 0] : Q; p0 = __builtin_amdgcn_mfma_f32_32x32x16_bf16(A0, bq_, p0, 0, 0, 0); p1 = __builtin_amdgcn_mfma_f32_32x32x16_bf16(A1, bq_, p1, 0, 0, 0); } \
    if constexpr ((D0) + 2 < 8) __builtin_amdgcn_sched_group_barrier(0x100, 2, 0); else if constexpr ((D0) + 2 < 12) __builtin_amdgcn_sched_group_barrier(0x100, 3, 0); \
    __builtin_amdgcn_sched_group_barrier(0x8, 2, 0); } while (0)
  QK_STEP(0, xa0, xa1, xq, za0, za1, zq); QK_STEP(1, ya0, ya1, yq, xa0, xa1, xq); QK_STEP(2, za0, za1, zq, ya0, ya1, yq);
  QK_STEP(3, xa0, xa1, xq, za0, za1, zq); QK_STEP(4, ya0, ya1, yq, xa0, xa1, xq); QK_STEP(5, za0, za1, zq, ya0, ya1, yq);
  QK_STEP(6, xa0, xa1, xq, za0, za1, zq); QK_STEP(7, ya0, ya1, yq, xa0, xa1, xq); QK_STEP(8, za0, za1, zq, ya0, ya1, yq);
  QK_STEP(9, xa0, xa1, xq, za0, za1, zq); QK_STEP(10, ya0, ya1, yq, xa0, xa1, xq); QK_STEP(11, za0, za1, zq, ya0, ya1, yq);
#undef QK_STEP
}
template <int D0> __device__ __forceinline__ void kld_pr(bf16x8& a0, bf16x8& a1, const char* Ks, const char* Rs, int r32, int hi) {
  if constexpr (D0 < 8) { const int cb = (D0 * 16 + hi * 8) * 2; a0 = *reinterpret_cast<const bf16x8*>(Ks + KSWZ(r32, cb)); a1 = *reinterpret_cast<const bf16x8*>(Ks + KSWZ(32 + r32, cb)); }
  else { const int cb = ((D0 - 8) * 16 + hi * 8) * 2; a0 = *reinterpret_cast<const bf16x8*>(Rs + RSWZ(r32, cb)); a1 = *reinterpret_cast<const bf16x8*>(Rs + RSWZ(32 + r32, cb)); }
}
__device__ __forceinline__ void qkt_pr(f32x16& p0, f32x16& p1, const char* Ks, const char* Rs, const bf16x8* qr, int r32, int hi) {
  p0 = f32x16{}; p1 = f32x16{};
  bf16x8 xa0, xa1, ya0, ya1, za0, za1;
  kld_pr<0>(xa0, xa1, Ks, Rs, r32, hi); kld_pr<1>(ya0, ya1, Ks, Rs, r32, hi);
  __builtin_amdgcn_sched_group_barrier(0x100, 4, 0);
#define QK_STEP(D0, A0, A1, NA0, NA1) do { if constexpr ((D0) + 2 < 12) kld_pr<(D0) + 2>(NA0, NA1, Ks, Rs, r32, hi); \
    p0 = __builtin_amdgcn_mfma_f32_32x32x16_bf16(A0, qr[D0], p0, 0, 0, 0); p1 = __builtin_amdgcn_mfma_f32_32x32x16_bf16(A1, qr[D0], p1, 0, 0, 0); \
    if constexpr ((D0) + 2 < 12) __builtin_amdgcn_sched_group_barrier(0x100, 2, 0); \
    __builtin_amdgcn_sched_group_barrier(0x8, 2, 0); } while (0)
  QK_STEP(0, xa0, xa1, za0, za1); QK_STEP(1, ya0, ya1, xa0, xa1); QK_STEP(2, za0, za1, ya0, ya1);
  QK_STEP(3, xa0, xa1, za0, za1); QK_STEP(4, ya0, ya1, xa0, xa1); QK_STEP(5, za0, za1, ya0, ya1);
  QK_STEP(6, xa0, xa1, za0, za1); QK_STEP(7, ya0, ya1, xa0, xa1); QK_STEP(8, za0, za1, ya0, ya1);
  QK_STEP(9, xa0, xa1, za0, za1); QK_STEP(10, ya0, ya1, xa0, xa1); QK_STEP(11, za0, za1, ya0, ya1);
#undef QK_STEP
}
__device__ __forceinline__ void qkt_aug(f32x16& p0, f32x16& p1, const char* Ks, const char* Rs, const bf16x8* qr, bf16x8 kone, bf16x8 qx, int r32, int hi) {
  p0 = __builtin_amdgcn_mfma_f32_32x32x16_bf16(kone, qx, f32x16{}, 0, 0, 0); p1 = __builtin_amdgcn_mfma_f32_32x32x16_bf16(kone, qx, f32x16{}, 0, 0, 0);
  bf16x8 xa0, xa1, ya0, ya1, za0, za1;
  kld_pr<0>(xa0, xa1, Ks, Rs, r32, hi); kld_pr<1>(ya0, ya1, Ks, Rs, r32, hi);
  __builtin_amdgcn_sched_group_barrier(0x100, 4, 0);
#define QK_STEP(D0, A0, A1, NA0, NA1) do { if constexpr ((D0) + 2 < 12) kld_pr<(D0) + 2>(NA0, NA1, Ks, Rs, r32, hi); \
    p0 = __builtin_amdgcn_mfma_f32_32x32x16_bf16(A0, qr[D0], p0, 0, 0, 0); p1 = __builtin_amdgcn_mfma_f32_32x32x16_bf16(A1, qr[D0], p1, 0, 0, 0); \
    if constexpr ((D0) + 2 < 12) __builtin_amdgcn_sched_group_barrier(0x100, 2, 0); \
    __builtin_amdgcn_sched_group_barrier(0x8, 2, 0); } while (0)
  QK_STEP(0, xa0, xa1, za0, za1); QK_STEP(1, ya0, ya1, xa0, xa1); QK_STEP(2, za0, za1, ya0, ya1);
  QK_STEP(3, xa0, xa1, za0, za1); QK_STEP(4, ya0, ya1, xa0, xa1); QK_STEP(5, za0, za1, ya0, ya1);
  QK_STEP(6, xa0, xa1, za0, za1); QK_STEP(7, ya0, ya1, xa0, xa1); QK_STEP(8, za0, za1, ya0, ya1);
  QK_STEP(9, xa0, xa1, za0, za1); QK_STEP(10, ya0, ya1, xa0, xa1); QK_STEP(11, za0, za1, ya0, ya1);
#undef QK_STEP
}
__device__ __forceinline__ void partialSM_aug(f32x16& p0, f32x16& p1, float& mq, float& alpha, bf16x8& qx, int hi, bool first) {
  constexpr float THR2 = THR * 1.4426950408889634f;
  float pmax = p0[0]; for (int r = 1; r < 16; ++r) pmax = fmaxf(pmax, p0[r]); for (int r = 0; r < 16; ++r) pmax = fmaxf(pmax, p1[r]);
  { auto rr = __builtin_amdgcn_permlane32_swap(__float_as_uint(pmax), __float_as_uint(pmax), false, false);
    pmax = fmaxf(__uint_as_float(rr[0]), __uint_as_float(rr[1])); }
  if (__builtin_expect(!first && __all(pmax <= THR2), 1)) { alpha = 1.f; }
  else { const float d = first ? pmax : fmaxf(pmax, 0.f);
    const float mnew = __uint_as_float(cvtpk(mq + d, 0.f) << 16); const float dr = mnew - mq; alpha = first ? 1.f : __builtin_amdgcn_exp2f(-dr); mq = mnew;
    for (int r = 0; r < 16; ++r) { p0[r] -= dr; p1[r] -= dr; }
    qx[0] = (hi == 0) ? (short)(cvtpk(-mq, 0.f) & 0xffffu) : (short)0; }
  for (int r = 0; r < 16; ++r) p0[r] = __builtin_amdgcn_exp2f(p0[r]);
}
__device__ __forceinline__ int v_st(int k, int c) { const int kk = (k & ~0xC) | ((k & 4) << 1) | ((k & 8) >> 1); return ((kk >> 3) * 4 + (c >> 5)) * 512 + ((kk & 7) * 32 + (c & 31)) * 2; }
__device__ __forceinline__ int v_rd_base(int lane) { return ((lane & 3) << 3) | (((lane >> 2) & 3) << 6) | (((lane >> 4) & 1) << 5) | (((lane >> 5) & 1) << 8); }
constexpr int v_rd_off(int d0, int ks, int half) { return d0 * 512 + ks * 4096 + half * 2048; }
template <int OFF> __device__ __forceinline__ s16x4 tr_read(int vb) {
  s16x4 r; asm volatile("ds_read_b64_tr_b16 %0, %1 offset:%2" : "=&v"(r) : "v"(vb), "i"(OFF) : "memory"); return r;
}
template <int D0> __device__ __forceinline__ void pv_one(f32x16& od, int vb, bf16x8 pa0, bf16x8 pa1, bf16x8 pa2, bf16x8 pa3) {
  const s16x4 l0 = tr_read<v_rd_off(D0, 0, 0)>(vb), h0 = tr_read<v_rd_off(D0, 0, 1)>(vb), l1 = tr_read<v_rd_off(D0, 1, 0)>(vb), h1 = tr_read<v_rd_off(D0, 1, 1)>(vb);
  const s16x4 l2 = tr_read<v_rd_off(D0, 2, 0)>(vb), h2 = tr_read<v_rd_off(D0, 2, 1)>(vb), l3 = tr_read<v_rd_off(D0, 3, 0)>(vb), h3 = tr_read<v_rd_off(D0, 3, 1)>(vb);
  asm volatile("s_waitcnt lgkmcnt(0)" ::: "memory"); SBAR();
#define PK(L, H) (bf16x8){L[0], L[1], L[2], L[3], H[0], H[1], H[2], H[3]}
  od = __builtin_amdgcn_mfma_f32_32x32x16_bf16(pa0, PK(l0, h0), od, 0, 0, 0);
  od = __builtin_amdgcn_mfma_f32_32x32x16_bf16(pa1, PK(l1, h1), od, 0, 0, 0);
  od = __builtin_amdgcn_mfma_f32_32x32x16_bf16(pa2, PK(l2, h2), od, 0, 0, 0);
  od = __builtin_amdgcn_mfma_f32_32x32x16_bf16(pa3, PK(l3, h3), od, 0, 0, 0);
#undef PK
}
__device__ __forceinline__ void pv_d0(f32x16* o, int vb, bf16x8 pa0, bf16x8 pa1, bf16x8 pa2, bf16x8 pa3) {
  pv_one<0>(o[0], vb, pa0, pa1, pa2, pa3); pv_one<1>(o[1], vb, pa0, pa1, pa2, pa3); pv_one<2>(o[2], vb, pa0, pa1, pa2, pa3); pv_one<3>(o[3], vb, pa0, pa1, pa2, pa3);
}
__device__ __forceinline__ float bfv(short s) { return __uint_as_float(((unsigned)(unsigned short)s) << 16); }
__device__ __forceinline__ void attn_unit(const unsigned short* Qb, const unsigned short* Kn, const unsigned short* Vh, const unsigned short* Kr, unsigned short* Ob, int t0, int seq, char* lds) {
  int tid_ = threadIdx.x; asm volatile("" : "+v"(tid_));
  const int tid = tid_, wid = tid >> 6, lane = tid & 63, r32 = lane & 31, hi = lane >> 5;
  char* V_lds = lds + OFF_V; char* K_lds = lds + OFF_K; char* R_lds = lds + OFF_R;
  float* ws = (float*)(lds + OFF_WS) + wid * 64; float* li_l = ws; float* al_l = ws + 32;
  float m_reg = -1e30f, l_reg = 0; f32x16 o[4] = {}; bf16x8 qr[12];
  { const unsigned oq = (unsigned)((wid * QBLK + r32) * LDQ + hi * 8);
#pragma unroll
    for (int d0 = 0; d0 < 8; ++d0) { qr[d0] = ld8(Qb + (oq + d0 * 16));
      if constexpr (ATT_AUG_ON) { u32x4 w_;
#pragma unroll
        for (int e = 0; e < 4; ++e) w_[e] = cvtpk(bfv(qr[d0][2 * e]) * QC, bfv(qr[d0][2 * e + 1]) * QC);
        qr[d0] = *reinterpret_cast<bf16x8*>(&w_); } } }
  {
    const int row = tid >> 1, ax = tid & 1, t = t0 + row; const float pos = (float)(ax ? (t & 63) : (t >> 6));
    const unsigned oqp = (unsigned)(row * LDQ + 128 + 32 * ax);
    const bf16x8 xa0 = ld8(Qb + oqp), xa1 = ld8(Qb + (oqp + 8)), xb0 = ld8(Qb + (oqp + 16)), xb1 = ld8(Qb + (oqp + 24));
    unsigned oa[8], ob[8];
#pragma unroll
    for (int jj = 0; jj < 8; ++jj) { float r1[2], r2[2];
#pragma unroll
      for (int e = 0; e < 2; ++e) { const int i = 2 * jj + e; const float ang = pos * exp2f(-(float)i * 0.83048202372184059f); const float cs = __cosf(ang), sn = __sinf(ang);
        const float a = bfv(i < 8 ? xa0[i & 7] : xa1[i & 7]), b = bfv(i < 8 ? xb0[i & 7] : xb1[i & 7]); r1[e] = a * cs - b * sn; r2[e] = b * cs + a * sn; }
      if constexpr (ATT_AUG_ON) { r1[0] *= QC; r1[1] *= QC; r2[0] *= QC; r2[1] *= QC; }
      oa[jj] = cvtpk(r1[0], r1[1]); ob[jj] = cvtpk(r2[0], r2[1]); }
    char* qd = lds + OFF_QR + (row >> 5) * 4096 + (row & 31) * 16;
    *(u32x4*)(qd + (2 * ax) * 1024)           = (u32x4){oa[0], oa[1], oa[2], oa[3]};
    *(u32x4*)(qd + (2 * ax) * 1024 + 512)     = (u32x4){oa[4], oa[5], oa[6], oa[7]};
    *(u32x4*)(qd + (2 * ax + 1) * 1024)       = (u32x4){ob[0], ob[1], ob[2], ob[3]};
    *(u32x4*)(qd + (2 * ax + 1) * 1024 + 512) = (u32x4){ob[4], ob[5], ob[6], ob[7]}; }
  const char* Qf = lds + OFF_QR + wid * 4096 + lane * 16;
  const int sr = tid >> 4, sc = (tid & 15) * 8, vst0 = v_st(sr, sc), vst1 = v_st(32 + sr, sc);
  const int rr = tid >> 3, rc = (tid & 7) * 8;
  const int vb0 = (int)(uintptr_t)V_lds + v_rd_base(lane);
  struct { bf16x8 vs0, vs1, ks0, ks1, rs; } sr_[SDEPTH];
  unsigned okv0 = (unsigned)(sr * LDK + sc), okv1 = (unsigned)((32 + sr) * LDK + sc), okr = (unsigned)(rr * LDR + rc);
  asm volatile("" : "+v"(okv0), "+v"(okv1), "+v"(okr));
#define SLOAD(i, k0) do { const unsigned short* vt_ = Vh + (size_t)(k0) * LDK; const unsigned short* kt_ = Kn + (size_t)(k0) * LDK; const unsigned short* rt_ = Kr + (size_t)(k0) * LDR; \
    sr_[i].vs0 = ld8(vt_ + okv0); sr_[i].vs1 = ld8(vt_ + okv1); sr_[i].ks0 = ld8(kt_ + okv0); sr_[i].ks1 = ld8(kt_ + okv1); sr_[i].rs = ld8(rt_ + okr); } while (0)
#ifndef ATT_PF
#define ATT_PF 0
#endif
  unsigned opf; { const int t_ = tid < 320 ? tid : tid - 320; const unsigned nx = tid < 320 ? 0u : 64u;
    opf = (t_ < 128) ? (unsigned)((nx + (t_ >> 1)) * LDK + (t_ & 1) * 64) : (t_ < 256 && tid < 320) ? (unsigned)(((t_ - 128) >> 1) * LDK + (t_ & 1) * 64) : (tid < 320) ? (unsigned)((t_ - 256) * LDR) : (unsigned)((nx + ((t_ - 128) >> 1)) * LDK + (t_ & 1) * 64); }
  asm volatile("" : "+v"(opf));
  const int pfsel = __builtin_amdgcn_readfirstlane(tid < 128 ? 0 : (tid < 256 ? 1 : (tid < 320 ? 2 : (tid < 448 ? 0 : 1))));
  unsigned pf_ = 0u;
#define PFETCH(k0) do { if (ATT_PF > 0) { asm volatile("" :: "v"(pf_)); const int kc_ = (k0) < seq - 128 ? (k0) : seq - 128; const unsigned short* pb_ = (pfsel == 0) ? Kn + (size_t)kc_ * LDK : (pfsel == 1) ? Vh + (size_t)kc_ * LDK : Kr + (size_t)kc_ * LDR; \
    pf_ = *(const __attribute__((address_space(1))) unsigned*)(pb_ + opf); } } while (0)
#define SWRITE(b, i) do { *(bf16x8*)(V_lds + (b) * SHM_V + vst0) = sr_[i].vs0;          \
    *(bf16x8*)(V_lds + (b) * SHM_V + vst1) = sr_[i].vs1; int kc = sc * 2;               \
    *(bf16x8*)(K_lds + (b) * SHM_K + KSWZ(sr, kc)) = sr_[i].ks0;                       \
    *(bf16x8*)(K_lds + (b) * SHM_K + KSWZ(32 + sr, kc)) = sr_[i].ks1;                  \
    *(bf16x8*)(R_lds + (b) * SHM_R + RSWZ(rr, rc * 2)) = sr_[i].rs; } while (0)
#define SWAIT() do { if constexpr (SDEPTH == 2) asm volatile("s_waitcnt vmcnt(5)" ::: "memory"); else if (ATT_PF == 0) asm volatile("s_waitcnt vmcnt(0)" ::: "memory"); } while (0)
#define RESC(a) do { if (__any((a) < 1.f)) { if (hi == 0) al_l[r32] = (a); asm volatile("s_waitcnt lgkmcnt(0)" ::: "memory"); \
    for (int d = 0; d < 4; ++d) for (int r = 0; r < 16; ++r) o[d][r] *= al_l[crow(r, hi)]; } } while (0)
#ifndef ATT_PP
#define ATT_PP 1
#endif
  if constexpr (ATT_PP != 0 && NBUF == 3) {
  const int half = __builtin_amdgcn_readfirstlane(wid >> 2);
  f32x16 p0, p1; float mn, al; bf16x8 pa0, pa1, pa2, pa3; const int NT = seq / KVBLK;
#ifndef ATT_DMA
#define ATT_DMA 1
#endif
  const int widu = __builtin_amdgcn_readfirstlane(wid);
  unsigned dk0, dk1, dv0, dv1, dr0;
  { { const int row = 4 * (2 * widu) + (lane >> 4), ch = (lane & 15) ^ (row & 15); dk0 = (unsigned)(row * LDK + ch * 8); }
    { const int row = 4 * (2 * widu + 1) + (lane >> 4), ch = (lane & 15) ^ (row & 15); dk1 = (unsigned)(row * LDK + ch * 8); }
    { const int sub = 2 * (2 * widu) + (lane >> 5), idx = lane & 31, kk = (sub >> 2) * 8 + (idx >> 2), k = (kk & ~0xC) | ((kk & 4) << 1) | ((kk & 8) >> 1), c = (sub & 3) * 32 + (idx & 3) * 8; dv0 = (unsigned)(k * LDK + c); }
    { const int sub = 2 * (2 * widu + 1) + (lane >> 5), idx = lane & 31, kk = (sub >> 2) * 8 + (idx >> 2), k = (kk & ~0xC) | ((kk & 4) << 1) | ((kk & 8) >> 1), c = (sub & 3) * 32 + (idx & 3) * 8; dv1 = (unsigned)(k * LDK + c); }
    { const int row = 8 * widu + (lane >> 3), ch = (lane & 7) ^ ((row >> 1) & 7); dr0 = (unsigned)(row * LDR + ch * 8); } }
  asm volatile("" : "+v"(dk0), "+v"(dk1), "+v"(dv0), "+v"(dv1), "+v"(dr0));
#define GLDS16(gp, lp) __builtin_amdgcn_global_load_lds((const unsigned*)(gp), (__attribute__((address_space(3))) unsigned*)(lp), 16, 0, 0)
#define DMA_TILE(b, k0) do { const unsigned short* vt_ = Vh + (size_t)(k0) * LDK; const unsigned short* kt_ = Kn + (size_t)(k0) * LDK; const unsigned short* rt_ = Kr + (size_t)(k0) * LDR; \
    GLDS16(kt_ + dk0, K_lds + (b) * SHM_K + (2 * widu) * 1024); GLDS16(kt_ + dk1, K_lds + (b) * SHM_K + (2 * widu + 1) * 1024); \
    GLDS16(vt_ + dv0, V_lds + (b) * SHM_V + (2 * widu) * 1024); GLDS16(vt_ + dv1, V_lds + (b) * SHM_V + (2 * widu + 1) * 1024); \
    GLDS16(rt_ + dr0, R_lds + (b) * SHM_R + widu * 1024); } while (0)
#define DMA_WAIT() asm volatile("s_waitcnt vmcnt(0)" ::: "memory")
  if constexpr (ATT_DMA != 0) { DMA_TILE(0, 0); DMA_WAIT(); __syncthreads(); }
  else { SLOAD(0, 0); asm volatile("s_waitcnt vmcnt(0)" ::: "memory"); SWRITE(0, 0); SLOAD(0, KVBLK); __syncthreads(); }
#ifndef ATT_QREG
#define ATT_QREG 1
#endif
  if constexpr (ATT_QREG != 0) {
#pragma unroll
    for (int d = 0; d < 4; ++d) qr[8 + d] = *reinterpret_cast<const bf16x8*>(Qf + d * 1024); }
  float mq = 0.f; bf16x8 qx = (bf16x8){0, 0, 0, 0, 0, 0, 0, 0}; const bf16x8 kone = (bf16x8){(short)(hi == 0 ? 0x3F80 : 0), 0, 0, 0, 0, 0, 0, 0};
#define QKT_PP(P0, P1, KS, RS) do { if constexpr (ATT_AUG_ON && ATT_QREG != 0) qkt_aug(P0, P1, KS, RS, qr, kone, qx, r32, hi); else if constexpr (ATT_QREG != 0) qkt_pr(P0, P1, KS, RS, qr, r32, hi); else qkt_pp(P0, P1, KS, RS, qr, Qf, r32, hi); } while (0)
#define PSM_PP(P0, P1) do { if constexpr (ATT_AUG_ON && ATT_QREG != 0) partialSM_aug(P0, P1, mq, al, qx, hi, j == 0); else partialSM(P0, P1, m_reg, mn, al); } while (0)
  if (half == 0) {
    int bc = 0, bp = 2, bn = 1;
    for (int j = 0; j < NT; ++j) {
      if constexpr (ATT_DMA != 0) { if (j + 1 < NT) DMA_TILE(bn, (j + 1) * KVBLK); }
      SBAR(); if (j > 0) pv_d0(o, vb0 + bp * (int)SHM_V, pa0, pa1, pa2, pa3);
      QKT_PP(p0, p1, K_lds + bc * SHM_K, R_lds + bc * SHM_R); SBAR();
      if constexpr (ATT_DMA != 0) DMA_WAIT(); else { if (j + 1 < NT) { asm volatile("s_waitcnt vmcnt(0)" ::: "memory"); SWRITE(bn, 0); } }
      __syncthreads();
      if constexpr (ATT_DMA == 0) { if (j + 2 < NT) SLOAD(0, (j + 2) * KVBLK); }
      SBAR(); PSM_PP(p0, p1); finishSM(p0, p1, al, l_reg, pa0, pa1, pa2, pa3); RESC(al); SBAR();
      __syncthreads();
      { const int t_ = bp; bp = bc; bc = bn; bn = t_; }
    }
    SBAR(); pv_d0(o, vb0 + bp * (int)SHM_V, pa0, pa1, pa2, pa3);
    __syncthreads();
  } else {
    if constexpr (ATT_DMA != 0) { DMA_TILE(1, KVBLK); DMA_WAIT(); } else { asm volatile("s_waitcnt vmcnt(0)" ::: "memory"); SWRITE(1, 0); }
    __syncthreads();
    int bc = 0, bp = 2, bn = 1, bnn = 2;
    for (int j = 0; j < NT; ++j) {
      if constexpr (ATT_DMA == 0) SLOAD(0, (j + 2 < NT ? j + 2 : NT - 1) * KVBLK);
      SBAR(); if (j > 0) pv_d0(o, vb0 + bp * (int)SHM_V, pa0, pa1, pa2, pa3);
      QKT_PP(p0, p1, K_lds + bc * SHM_K, R_lds + bc * SHM_R); SBAR();
      __syncthreads();
      if constexpr (ATT_DMA != 0) { if (j + 2 < NT) DMA_TILE(bnn, (j + 2) * KVBLK); }
      SBAR(); PSM_PP(p0, p1); finishSM(p0, p1, al, l_reg, pa0, pa1, pa2, pa3); RESC(al); SBAR();
      if constexpr (ATT_DMA != 0) DMA_WAIT(); else { if (j + 2 < NT) { asm volatile("s_waitcnt vmcnt(0)" ::: "memory"); SWRITE(bnn, 0); } }
      __syncthreads();
      { bp = bc; bc = bn; bn = bnn; bnn = bp; }
    }
    SBAR(); pv_d0(o, vb0 + bp * (int)SHM_V, pa0, pa1, pa2, pa3);
  }
  } else {
  f32x16 pA0, pA1, pB0, pB1; float mnA, mnB, alA, alB; bf16x8 pa0, pa1, pa2, pa3; const int NT = seq / KVBLK;
#ifdef ATT_PRIO
  if (__builtin_amdgcn_readfirstlane(tid) >= 256) __builtin_amdgcn_s_setprio(1);
#endif
  constexpr int SE = 0, SO = SDEPTH - 1;
  SLOAD(SE, 0); asm volatile("s_waitcnt vmcnt(0)" ::: "memory"); SWRITE(0, SE); __syncthreads();
  qkt(pA0, pA1, K_lds, R_lds, qr, Qf, r32, hi); partialSM(pA0, pA1, m_reg, mnA, alA);
  SLOAD(SO, KVBLK); if constexpr (SDEPTH == 2) { if (2 < NT) SLOAD(SE, 2 * KVBLK); }
  SWAIT(); SWRITE(1, SO); __syncthreads();
  if constexpr (NBUF == 2) {
  for (int j = 1; j + 1 < NT; j += 2) {
    SBAR(); qkt(pB0, pB1, K_lds + SHM_K, R_lds + SHM_R, qr, Qf, r32, hi);
    finishSM(pA0, pA1, alA, l_reg, pa0, pa1, pa2, pa3); SBAR();
    SLOAD(SO, (j + SDEPTH) * KVBLK); PFETCH((j + SDEPTH + ATT_PF) * KVBLK); SBAR();
    pv_d0(o, vb0, pa0, pa1, pa2, pa3); partialSM(pB0, pB1, m_reg, mnB, alB);
    __syncthreads(); SWAIT(); SWRITE(0, SE);
    RESC(alB); __syncthreads();
    SBAR(); qkt(pA0, pA1, K_lds, R_lds, qr, Qf, r32, hi);
    finishSM(pB0, pB1, alB, l_reg, pa0, pa1, pa2, pa3); SBAR();
    if (SDEPTH == 1 || j + 3 < NT) SLOAD(SE, (j + 1 + SDEPTH) * KVBLK); PFETCH((j + 1 + SDEPTH + ATT_PF) * KVBLK); SBAR();
    pv_d0(o, vb0 + (int)SHM_V, pa0, pa1, pa2, pa3); partialSM(pA0, pA1, m_reg, mnA, alA);
    __syncthreads(); SWAIT(); SWRITE(1, SO);
    RESC(alA); __syncthreads();
  }
  SBAR(); qkt(pB0, pB1, K_lds + SHM_K, R_lds + SHM_R, qr, Qf, r32, hi);
  finishSM(pA0, pA1, alA, l_reg, pa0, pa1, pa2, pa3); SBAR();
  pv_d0(o, vb0, pa0, pa1, pa2, pa3); partialSM(pB0, pB1, m_reg, mnB, alB);
  __syncthreads(); RESC(alB);
  finishSM(pB0, pB1, alB, l_reg, pa0, pa1, pa2, pa3); SBAR();
  pv_d0(o, vb0 + (int)SHM_V, pa0, pa1, pa2, pa3);
  } else {
  int bp = 0, bc = 1, bn = 2;
  for (int j = 1; j + 1 < NT; j += 2) {
    SBAR(); qkt(pB0, pB1, K_lds + bc * SHM_K, R_lds + bc * SHM_R, qr, Qf, r32, hi);
    finishSM(pA0, pA1, alA, l_reg, pa0, pa1, pa2, pa3); SBAR();
    SLOAD(0, (j + 1) * KVBLK); SBAR();
    pv_d0(o, vb0 + bp * (int)SHM_V, pa0, pa1, pa2, pa3); partialSM(pB0, pB1, m_reg, mnB, alB);
    SWAIT(); SWRITE(bn, 0);
    RESC(alB); __syncthreads();
    { const int t_ = bp; bp = bc; bc = bn; bn = t_; }
    SBAR(); qkt(pA0, pA1, K_lds + bc * SHM_K, R_lds + bc * SHM_R, qr, Qf, r32, hi);
    finishSM(pB0, pB1, alB, l_reg, pa0, pa1, pa2, pa3); SBAR();
    SLOAD(0, (j + 2) * KVBLK); SBAR();
    pv_d0(o, vb0 + bp * (int)SHM_V, pa0, pa1, pa2, pa3); partialSM(pA0, pA1, m_reg, mnA, alA);
    SWAIT(); SWRITE(bn, 0);
    RESC(alA); __syncthreads();
    { const int t_ = bp; bp = bc; bc = bn; bn = t_; }
  }
  SBAR(); qkt(pB0, pB1, K_lds + bc * SHM_K, R_lds + bc * SHM_R, qr, Qf, r32, hi);
  finishSM(pA0, pA1, alA, l_reg, pa0, pa1, pa2, pa3); SBAR();
  pv_d0(o, vb0 + bp * (int)SHM_V, pa0, pa1, pa2, pa3); partialSM(pB0, pB1, m_reg, mnB, alB);
  __syncthreads(); RESC(alB);
  finishSM(pB0, pB1, alB, l_reg, pa0, pa1, pa2, pa3); SBAR();
  pv_d0(o, vb0 + bc * (int)SHM_V, pa0, pa1, pa2, pa3);
  }
  }
  asm volatile("" :: "v"(pf_));
#ifdef ATT_PRIO
  __builtin_amdgcn_s_setprio(0);
#endif
  if (hi == 0) li_l[r32] = l_reg; asm volatile("s_waitcnt lgkmcnt(0)" ::: "memory");
  float rli[16];
#pragma unroll
  for (int r = 0; r < 16; ++r) rli[r] = __builtin_amdgcn_rcpf(li_l[crow(r, hi)]);
#pragma unroll
  for (int r = 0; r < 16; ++r) { const unsigned oo = (unsigned)((wid * QBLK + crow(r, hi)) * LDO + r32);
#pragma unroll
    for (int d0 = 0; d0 < 4; ++d0) Ob[oo + d0 * 32] = (unsigned short)(cvtpk(o[d0][r] * rli[r], 0.f) & 0xffffu); }
#undef SLOAD
#undef PFETCH
#undef GLDS16
#undef QKT_PP
#undef PSM_PP
#undef DMA_TILE
#undef DMA_WAIT
#undef SWRITE
#undef SWAIT
#undef RESC
}
}

__device__ __forceinline__ void hy_h2_phase(Frame& F, const bf16* U, const float* cw, const float* cb, bf16* VVT) {
    const int gw = blockIdx.x * NWAVES + F.wave, NGW = F.G * NWAVES, lane = F.lane;
    LAS unsigned char* S = F.lds + F.wave * 16896;
    const int chunk = lane & 7, rsub = lane >> 3;
    constexpr int NTILE = (SEQ / 64) * (DM / 64);
    v4u R[2][9];
#define H2_LOAD(IT) do { const int t0_ = ((IT) >> 6) * 64, c0_ = ((IT) & 63) * 64; \
        _Pragma("unroll") for (int part = 0; part < 2; ++part) _Pragma("unroll") for (int i = 0; i < 9; ++i) { const int rr = rsub + 8 * i; const int t = t0_ - 1 + rr; v4u v = (v4u){0u, 0u, 0u, 0u}; \
            if (rr < 66 && t >= 0 && t < SEQ) v = *(const GAS v4u*)(U + (size_t)t * (3 * DM) + (part + 1) * DM + c0_ + chunk * 8); R[part][i] = v; } } while (0)
    if (gw < NTILE) H2_LOAD(gw);
    for (int it = gw; it < NTILE; it += NGW) { const int t0 = (it >> 6) * 64, c0 = (it & 63) * 64;
#pragma unroll
        for (int part = 0; part < 2; ++part)
#pragma unroll
            for (int i = 0; i < 9; ++i) { const int rr = rsub + 8 * i; if (rr < 66) *(LAS v4u*)(S + part * 8448 + rr * 128 + chunk * 16) = R[part][i]; }
        { const int itn = (it + NGW < NTILE) ? it + NGW : it; H2_LOAD(itn); }
        LDS_WAIT(); asm volatile("" ::: "memory");
        const int c1 = DM + c0 + lane, c2 = 2 * DM + c0 + lane;
        const float a0 = cw[c1], a1 = cw[3 * DM + c1], a2 = cw[6 * DM + c1], ab = cb[c1], b0 = cw[c2], b1 = cw[3 * DM + c2], b2 = cw[6 * DM + c2], bb = cb[c2];
        const LAS unsigned short* S1 = (const LAS unsigned short*)S + lane; const LAS unsigned short* S2 = (const LAS unsigned short*)(S + 8448) + lane;
        float p1 = bf1(S1[0]), q1 = bf1(S1[64]), p2 = bf1(S2[0]), q2 = bf1(S2[64]);
        unsigned ow[32];
#pragma unroll
        for (int t = 0; t < 64; t += 2) { float vv[2];
#pragma unroll
            for (int e = 0; e < 2; ++e) { const float n1 = bf1(S1[(t + e + 2) * 64]), n2 = bf1(S2[(t + e + 2) * 64]);
                vv[e] = (a0 * p1 + a1 * q1 + a2 * n1 + ab) * (b0 * p2 + b1 * q2 + b2 * n2 + bb); p1 = q1; q1 = n1; p2 = q2; q2 = n2; }
            ow[t >> 1] = pk2(vv[0], vv[1]); }
        GAS v4u* dst = (GAS v4u*)(VVT + (size_t)(c0 + lane) * SEQ + t0);
#pragma unroll
        for (int i = 0; i < 8; ++i) dst[i] = (v4u){ow[4 * i], ow[4 * i + 1], ow[4 * i + 2], ow[4 * i + 3]};
        LDS_WAIT(); asm volatile("" ::: "memory");
    }
}
#undef H2_LOAD
__device__ __forceinline__ void hy_h4_phase(Frame& F, const bf16* U, const float* cw, const float* cb, const bf16* YT, bf16* Aout) {
    const int gw = blockIdx.x * NWAVES + F.wave, NGW = F.G * NWAVES, lane = F.lane;
    LAS unsigned char* S = F.lds + F.wave * 17408;
    LAS unsigned char* Tt = S + 8448;
    const int chunk = lane & 7, rsub = lane >> 3;
    for (int it = gw; it < (SEQ / 64) * (DM / 64); it += NGW) { const int t0 = (it >> 6) * 64, c0 = (it & 63) * 64;
#pragma unroll
        for (int i = 0; i < 9; ++i) { const int rr = rsub + 8 * i; if (rr < 66) { const int t = t0 - 1 + rr; v4u v = (v4u){0u, 0u, 0u, 0u};
            if (t >= 0 && t < SEQ) v = *(const GAS v4u*)(U + (size_t)t * (3 * DM) + c0 + chunk * 8);
            *(LAS v4u*)(S + rr * 128 + chunk * 16) = v; } }
#pragma unroll
        for (int i = 0; i < 8; ++i) { const int cr = rsub + 8 * i; const v4u v = *(const GAS v4u*)(YT + (size_t)(c0 + cr) * SEQ + t0 + chunk * 8);
            *(LAS v2u*)(Tt + cr * 136 + chunk * 16) = (v2u){v.x, v.y}; *(LAS v2u*)(Tt + cr * 136 + chunk * 16 + 8) = (v2u){v.z, v.w}; }
        LDS_WAIT(); asm volatile("" ::: "memory");
        const int c1 = c0 + lane; const float a0 = cw[c1], a1 = cw[3 * DM + c1], a2 = cw[6 * DM + c1], ab = cb[c1];
        const LAS unsigned short* S0 = (const LAS unsigned short*)S + lane; const LAS unsigned short* Ty = (const LAS unsigned short*)(Tt + lane * 136);
        float p = bf1(S0[0]), q = bf1(S0[64]);
        bf16* dst = Aout + (size_t)t0 * DM + c1;
#pragma unroll 8
        for (int t = 0; t < 64; ++t) { const float n = bf1(S0[(t + 2) * 64]); const float r = (a0 * p + a1 * q + a2 * n + ab) * bf1(Ty[t]); p = q; q = n;
            dst[(size_t)t * DM] = (bf16)(pk2(r, 0.f) & 0xffffu); }
        LDS_WAIT(); asm volatile("" ::: "memory");
    }
}
namespace fftc {
constexpr int LOGN = 14, N = 1 << LOGN;
__device__ __forceinline__ int PA(int i) { return i + ((i >> 6) << 2); }
__device__ __forceinline__ int opq(int t) { asm volatile("" : "+v"(t)); return t; }
__device__ __forceinline__ f32x2 cmulc(f32x2 a, f32x2 b) { return (f32x2){a.x * b.x - a.y * b.y, a.x * b.y + a.y * b.x}; }
__device__ __forceinline__ f32x2 cmul(f32x2 a, f32x2 b) { f32x2 t, r;
    asm("v_pk_mul_f32 %0, %1, %2 op_sel_hi:[0,1]" : "=v"(t) : "v"(a), "v"(b));
    asm("v_pk_fma_f32 %0, %1, %2, %3 op_sel:[1,1,0] op_sel_hi:[1,0,1] neg_lo:[1,0,0]" : "=v"(r) : "v"(a), "v"(b), "v"(t));
    return r; }
__device__ __forceinline__ f32x2 cmadd(f32x2 a, f32x2 b, f32x2 c) { f32x2 t, r;
    asm("v_pk_fma_f32 %0, %1, %2, %3 op_sel_hi:[0,1,1]" : "=v"(t) : "v"(a), "v"(b), "v"(c));
    asm("v_pk_fma_f32 %0, %1, %2, %3 op_sel:[1,1,0] op_sel_hi:[1,0,1] neg_lo:[1,0,0]" : "=v"(r) : "v"(a), "v"(b), "v"(t));
    return r; }
__device__ __forceinline__ f32x2 cmul_n(f32x2 a, f32x2 b) { f32x2 t, r;
    asm("v_pk_mul_f32 %0, %1, %2 op_sel_hi:[0,1]" : "=v"(t) : "v"(a), "v"(b));
    asm("v_pk_fma_f32 %0, %1, %2, %3 op_sel:[1,1,0] op_sel_hi:[1,0,1] neg_lo:[1,0,0]\n\ts_nop 1" : "=v"(r) : "v"(a), "v"(b), "v"(t));
    return r; }
template <int CTRL> __device__ __forceinline__ f32x2 quadx(f32x2 v) {
    return (f32x2){__int_as_float(__builtin_amdgcn_update_dpp(0, __float_as_int(v.x), CTRL, 0xF, 0xF, true)), __int_as_float(__builtin_amdgcn_update_dpp(0, __float_as_int(v.y), CTRL, 0xF, 0xF, true))}; }
__device__ __forceinline__ f32x2 cis(float ang) { f32x2 w = (f32x2){__cosf(ang), __sinf(ang)}; asm volatile("s_nop 1" : "+v"(w)); return w; }
__device__ __forceinline__ constexpr float c8(int k) { return k == 0 ? 1.0f : k == 1 ? 0.92387953251128674f : k == 2 ? 0.70710678118654752f : k == 3 ? 0.38268343236508977f : k == 4 ? 0.0f : k == 5 ? -0.38268343236508977f : k == 6 ? -0.70710678118654752f : -0.92387953251128674f; }
__device__ __forceinline__ constexpr float s8(int k) { return k == 0 ? 0.0f : k == 1 ? 0.38268343236508977f : k == 2 ? 0.70710678118654752f : k == 3 ? 0.92387953251128674f : k == 4 ? 1.0f : k == 5 ? 0.92387953251128674f : k == 6 ? 0.70710678118654752f : 0.38268343236508977f; }
template <int NR, int HL, bool INV, bool DPPNEXT = false> __device__ __forceinline__ void bfly_stage(f32x2 (&v)[NR], const f32x2 bq) {
#pragma unroll
    for (int mu = 0; mu < HL; ++mu) {
        constexpr int KS = 8 / HL; const float cr = c8(mu * KS), ci = INV ? s8(mu * KS) : -s8(mu * KS);
        const f32x2 tw = (mu == 0) ? bq : cmulc(bq, (f32x2){cr, ci});
#pragma unroll
        for (int blk = 0; blk < NR; blk += 2 * HL) {
            if (!INV) { const f32x2 a = v[blk + mu], b = v[blk + mu + HL]; v[blk + mu] = a + b; v[blk + mu + HL] = DPPNEXT ? cmul_n(a - b, tw) : cmul(a - b, tw); }
            else { const f32x2 a = v[blk + mu], b = cmul(v[blk + mu + HL], tw); v[blk + mu] = a + b; v[blk + mu + HL] = a - b; }
        }
    }
}
template <int LOGH, int R, bool TAIL = false> __device__ __forceinline__ void dif_pass(LAS f32x2* X, int tid_) {
    constexpr int H = 1 << LOGH, S = H >> (R - 1), LOGS = LOGH - (R - 1), NR = 1 << R, NG = N >> R;
    const int tid = opq(tid_);
#pragma unroll 1
    for (int g = tid; g < NG; g += NTHR) {
        const int j = g & (S - 1), base = ((g >> LOGS) << (LOGH + 1)) + j;
        constexpr int PS = S + ((S >> 6) << 2); static_assert(S % 64 == 0 || NR * S <= 64, "padded stride");
        const int p0 = PA(base);
        f32x2 v[NR];
#pragma unroll
        for (int m = 0; m < NR; ++m) v[m] = X[p0 + PS * m];
        const float ang = -3.14159265358979323846f * (float)j * (1.0f / (float)((NR / 2) * S));
        const f32x2 bw = cis(ang);
        if constexpr (R == 4) { const f32x2 b4 = cmul(bw, bw), b2 = cmul(b4, b4), b1 = cmul(b2, b2);
            bfly_stage<NR, 8, false>(v, bw); bfly_stage<NR, 4, false>(v, b4); bfly_stage<NR, 2, false>(v, b2); bfly_stage<NR, 1, false, TAIL>(v, b1); }
        else { const f32x2 b1 = cmul(bw, bw); bfly_stage<NR, 2, false>(v, bw); bfly_stage<NR, 1, false>(v, b1); }
        if constexpr (TAIL) {
            static_assert(S == 4 && R == 4, "quad tail");
            const int q = tid & 3; const float s2 = (q & 2) ? -1.f : 1.f, s1 = (q & 1) ? -1.f : 1.f; const bool q3 = q == 3;
#pragma unroll
            for (int m = 0; m < NR; ++m) { const f32x2 xp = quadx<0x4E>(v[m]); f32x2 r = xp + v[m] * s2;
                r = q3 ? (f32x2){r.y, -r.x} : r;
                const f32x2 rp = quadx<0xB1>(r); v[m] = rp + r * s1; }
        }
#pragma unroll
        for (int m = 0; m < NR; ++m) X[p0 + PS * m] = v[m];
    }
}
template <int LOGH0, int R, bool HEAD = false> __device__ __forceinline__ void dit_pass(LAS f32x2* X, int tid_) {
    constexpr int S = 1 << LOGH0, NR = 1 << R, NG = N >> R;
    const int tid = opq(tid_);
#pragma unroll 1
    for (int g = tid; g < NG; g += NTHR) {
        const int j = g & (S - 1), base = ((g >> LOGH0) << (LOGH0 + R)) + j;
        constexpr int PS = S + ((S >> 6) << 2); static_assert(S % 64 == 0 || NR * S <= 64, "padded stride");
        const int p0 = PA(base);
        f32x2 v[NR];
#pragma unroll
        for (int m = 0; m < NR; ++m) v[m] = X[p0 + PS * m];
        if constexpr (HEAD) {
            static_assert(S == 4 && R == 4, "quad head");
            const int q = tid & 3; const float s2 = (q & 2) ? -1.f : 1.f, s1 = (q & 1) ? -1.f : 1.f; const bool q3 = q == 3;
#pragma unroll
            for (int m = 0; m < NR; ++m) { const f32x2 xp = quadx<0xB1>(v[m]); f32x2 r = xp + v[m] * s1;
                r = q3 ? (f32x2){-r.y, r.x} : r;
                const f32x2 rp = quadx<0x4E>(r); v[m] = rp + r * s2; }
        }
        const float ang = 3.14159265358979323846f * (float)j * (1.0f / (float)((NR / 2) * S));
        const f32x2 bw = cis(ang);
        if constexpr (R == 4) { const f32x2 b4 = cmul(bw, bw), b2 = cmul(b4, b4), b1 = cmul(b2, b2);
            bfly_stage<NR, 1, true>(v, b1); bfly_stage<NR, 2, true>(v, b2); bfly_stage<NR, 4, true>(v, b4); bfly_stage<NR, 8, true>(v, bw); }
        else { const f32x2 b1 = cmul(bw, bw); bfly_stage<NR, 1, true>(v, b1); bfly_stage<NR, 2, true>(v, bw); }
#pragma unroll
        for (int m = 0; m < NR; ++m) X[p0 + PS * m] = v[m];
    }
}
__device__ __forceinline__ void fwd(LAS f32x2* X, int tid) {
    dif_pass<13, 4>(X, tid); __syncthreads(); dif_pass<9, 4>(X, tid); __syncthreads(); dif_pass<5, 4, true>(X, tid); __syncthreads();
}
__device__ __forceinline__ void inv(LAS f32x2* X, int tid) {
    dit_pass<2, 4, true>(X, tid); __syncthreads(); dit_pass<6, 4>(X, tid); __syncthreads(); dit_pass<10, 4>(X, tid); __syncthreads();
}
__device__ __forceinline__ int brev14(int k) { return (int)(__brev((unsigned)k) >> 18); }
}
__device__ __forceinline__ void hy_fft_phase(Frame& F, const bf16* GT, const bf16* VVT, const float* skip, bf16* YT, float d0, float dstep, float tscale) {
    using namespace fftc;
    LAS f32x2* X = (LAS f32x2*)F.lds; const int tid0 = F.tid;
    v4u G[8]; unsigned short GE[4]; v4u V[4];
#define FFT_LOAD_G(cc) do { const int t_ = opq(tid0); const bf16* gf_ = GT + (size_t)(cc) * SEQ; const bf16* gb_ = GT + (size_t)(DM + (cc)) * SEQ; \
        _Pragma("unroll") for (int jj = 0; jj < 4; ++jj) { const int m = 4 * (t_ + NTHR * jj); G[jj] = *(const GAS v4u*)(gf_ + 2 * m); } \
        _Pragma("unroll") for (int jj = 4; jj < 8; ++jj) { const int m = 4 * (t_ + NTHR * jj), mp = N - m; G[jj] = *(const GAS v4u*)(gb_ + 2 * mp - 8); GE[jj - 4] = (2 * mp < N) ? *(const GAS bf16*)(gb_ + 2 * mp) : (unsigned short)0; } } while (0)
    if ((int)blockIdx.x < DM) FFT_LOAD_G(blockIdx.x);
    for (int c = blockIdx.x; c < DM; c += F.G) {
        const bf16* vr = VVT + (size_t)c * SEQ;
        int tid = opq(tid0);
        const float dlc = -(d0 + (float)c * dstep) * tscale, rst = __builtin_amdgcn_exp2f(dlc);
#pragma unroll
        for (int jj = 0; jj < 4; ++jj) { const int m = 4 * (tid + NTHR * jj); float f[8]; unpack8(G[jj], f); float dk = __builtin_amdgcn_exp2f(dlc * (float)(2 * m));
#pragma unroll
            for (int e = 0; e < 8; ++e) { f[e] *= dk; dk *= rst; }
#pragma unroll
            for (int e = 0; e < 4; ++e) X[PA(m + e)] = (f32x2){f[2 * e], f[2 * e + 1]}; }
#pragma unroll
        for (int jj = 4; jj < 8; ++jj) { const int m = 4 * (tid + NTHR * jj), mp = N - m; float f[8]; unpack8(G[jj], f); float e0 = bf1(GE[jj - 4]);
            float dk = __builtin_amdgcn_exp2f(dlc * (float)(2 * mp - 8));
#pragma unroll
            for (int e = 0; e < 8; ++e) { f[e] *= dk; dk *= rst; }
            e0 *= dk;
            X[PA(m)] = (f32x2){e0, f[7]}; X[PA(m + 1)] = (f32x2){f[6], f[5]}; X[PA(m + 2)] = (f32x2){f[4], f[3]}; X[PA(m + 3)] = (f32x2){f[2], f[1]}; }
        tid = opq(tid0);
#pragma unroll
        for (int jj = 0; jj < 4; ++jj) { const int m = 4 * (tid + NTHR * jj); V[jj] = *(const GAS v4u*)(vr + 2 * m); }
        __syncthreads();
        fwd(X, tid);
        tid = opq(tid0);
#define KMAP(t_, jj_) ((((t_) & 31) << 8) | (((t_) >> 5) << 4) | (jj_))
        f32x2 zg[16][2];
#pragma unroll
        for (int jj = 0; jj < 16; ++jj) { const int k = KMAP(tid, jj); zg[jj][0] = X[PA(brev14(k))]; zg[jj][1] = X[PA(brev14((N - k) & (N - 1)))]; }
        const f32x2 zgh = X[PA(1)];
        __syncthreads();
        tid = opq(tid0);
#pragma unroll
        for (int jj = 0; jj < 8; ++jj) { const int m = 4 * (tid + NTHR * jj);
            if (jj < 4) { float f[8]; unpack8(V[jj], f);
#pragma unroll
                for (int e = 0; e < 4; ++e) X[PA(m + e)] = (f32x2){f[2 * e], f[2 * e + 1]}; }
            else {
#pragma unroll
                for (int e = 0; e < 4; ++e) X[PA(m + e)] = (f32x2){0.f, 0.f}; } }
        if (c + F.G < DM) FFT_LOAD_G(c + F.G);
        __syncthreads();
        fwd(X, tid);
        tid = opq(tid0);
        constexpr float SC = 1.0f / (float)N;
#pragma unroll
        for (int jj = 0; jj < 16; ++jj) { const int k = KMAP(tid, jj), p = PA(brev14(k)), p2 = PA(brev14((N - k) & (N - 1)));
            const f32x2 a = X[p], b = X[p2], ga = zg[jj][0], gc = zg[jj][1];
            const f32x2 Ev = (f32x2){0.5f * (a.x + b.x), 0.5f * (a.y - b.y)}, Ov = (f32x2){0.5f * (a.y + b.y), 0.5f * (b.x - a.x)};
            const f32x2 Eg = (f32x2){0.5f * (ga.x + gc.x), 0.5f * (ga.y - gc.y)}, Og = (f32x2){0.5f * (ga.y + gc.y), 0.5f * (gc.x - ga.x)};
            const float ang = -6.283185307179586f * (float)k / (float)N; const f32x2 wk = cis(ang);
            f32x2 Pe = cmadd(Ev, Eg, cmul(wk, cmul(Ov, Og))), Po = cmadd(Ev, Og, cmul(Ov, Eg)); Pe = Pe * SC; Po = Po * SC;
            X[p] = (f32x2){Pe.x - Po.y, Pe.y + Po.x};
            if (k != 0) X[p2] = (f32x2){Pe.x + Po.y, Po.x - Pe.y}; }
        if (tid == 0) { const f32x2 a = X[PA(1)];
            const float Ev = a.x, Ov = a.y, Eg = zgh.x, Og = zgh.y; X[PA(1)] = (f32x2){(Ev * Eg - Ov * Og) * SC, (Ev * Og + Ov * Eg) * SC}; }
        __syncthreads();
        inv(X, tid);
        tid = opq(tid0);
        const float sk = skip[c];
#pragma unroll
        for (int jj = 0; jj < 4; ++jj) { const int m = 4 * (tid + NTHR * jj); float f[8], o[8]; unpack8(*(const GAS v4u*)(vr + 2 * m), f);
#pragma unroll
            for (int e = 0; e < 4; ++e) { const f32x2 q = X[PA(m + e)]; o[2 * e] = q.x + f[2 * e] * sk; o[2 * e + 1] = q.y + f[2 * e + 1] * sk; }
            *(GAS v4u*)(YT + (size_t)c * SEQ + 2 * m) = pack8f(o); }
        __syncthreads();
    }
#undef FFT_LOAD_G
#undef KMAP
}

#define GEMM_CALL(EPI, Aptr, Bptr, Mv, Nv, Kv, ...) do { pg8::Gemm g_{(const pg8::bf16_t*)(Aptr), (const pg8::bf16_t*)(Bptr), (Mv), (Nv), (Kv)}; pg8::StaticOrder S_; S_.init((Mv), (Nv), F.G, (int)blockIdx.x); \
    EPI E_{__VA_ARGS__}; pg8::gemm_phase<EPI, pg8::StaticOrder, PG8_ALIGN, PG8_SP2>(F.lds, g_, S_, E_); } while (0)

#ifndef DOWN_RB
#define DOWN_RB 2
#endif
#define GEMM_DOWN(Aptr, Bptr, ...) do { if (F.G == 256) { pg8::Gemm g_{(const pg8::bf16_t*)(Aptr), (const pg8::bf16_t*)(Bptr), SEQ, DM, FF, FFP}; pg8::BlockOrder<DOWN_RB, 32 / DOWN_RB> S_; S_.init((int)blockIdx.x); \
        pg8::EpiBf16<0> E_{__VA_ARGS__}; pg8::gemm_phase<pg8::EpiBf16<0>, pg8::BlockOrder<DOWN_RB, 32 / DOWN_RB>, PG8_ALIGN, PG8_SP2>(F.lds, g_, S_, E_); } \
    else { pg8::Gemm g_{(const pg8::bf16_t*)(Aptr), (const pg8::bf16_t*)(Bptr), SEQ, DM, FF, FFP}; pg8::StaticOrder S_; S_.init(SEQ, DM, F.G, (int)blockIdx.x); pg8::EpiBf16<0> E_{__VA_ARGS__}; pg8::gemm_phase<pg8::EpiBf16<0>, pg8::StaticOrder, PG8_ALIGN, PG8_SP2>(F.lds, g_, S_, E_); } } while (0)
#ifndef REP_P0
#define REP_P0 1
#endif
#ifndef REP_ATT
#define REP_ATT 1
#endif
#ifndef REP_GU
#define REP_GU 1
#endif
#ifndef REP_FFT
#define REP_FFT 1
#endif
#ifndef REP_DN
#define REP_DN 1
#endif
#ifndef REP_ROW
#define REP_ROW 1
#endif
#ifndef REP_SCIN
#define REP_SCIN 1
#endif
#ifndef REP_MISC
#define REP_MISC 1
#endif
#define GEMM_CALL_SUB(EPI, Aptr, Bptr, Mv, Nv, Kv, Gs, cs, ...) do { pg8::Gemm g_{(const pg8::bf16_t*)(Aptr), (const pg8::bf16_t*)(Bptr), (Mv), (Nv), (Kv)}; pg8::StaticOrder S_; S_.init((Mv), (Nv), (Gs), (cs)); \
    EPI E_{__VA_ARGS__}; pg8::gemm_phase<EPI, pg8::StaticOrder, PG8_ALIGN, PG8_SP2>(F.lds, g_, S_, E_); } while (0)
static_assert(att::LDS_NEED <= LDSCTL_OFF && 8 * 17408 <= LDSCTL_OFF && pg8::STAGE_BYTES <= LDSCTL_OFF, "phase LDS regions stay below the control words");
__global__ void __launch_bounds__(NTHR, 2) mega_fwd(Args args) {
    extern __shared__ __attribute__((aligned(16))) unsigned char lds[];
    Frame F;
    F.lds = (LAS unsigned char*)lds;
    F.MISC = (volatile LAS unsigned*)(F.lds + MISC_OFF);
    F.tid = threadIdx.x; F.lane = F.tid & 63; F.wave = __builtin_amdgcn_readfirstlane(F.tid >> 6);
    F.G = gridDim.x;
    unsigned char* ws = args.ws;
    F.ctl = (gu32*)(ws + WS_CTL);
    for (int u = F.tid; u < (LDS_BYTES - LDSCTL_OFF) / 4; u += NTHR) ((LAS unsigned*)(F.lds + LDSCTL_OFF))[u] = 0u;
    __syncthreads();
    const int lo = args.ph_lo, hi = args.ph_hi;
    XcdBarrier bar; bar.bar = (unsigned*)(F.ctl + CW_BAR); bar.x = 0; bar.st = nullptr;
    if (hi - lo > 1) bar = xcd_barrier_post((unsigned*)(F.ctl + CW_BAR), F.MISC + 8);
#ifndef MK_MASK
#define MK_MASK 0xFFFFFFFFFFFFFFFFull
#endif
#define IN(k) ((((MK_MASK) >> (k)) & 1ull) != 0ull && lo <= (k) && (k) < hi)
#define SEAM(k) do { if (IN(k) && IN((k) + 1)) xcd_barrier(bar); } while (0)

    float* const MOD = (float*)(ws + WS_MOD);
#define MODV(L, r, i) (MOD + ((size_t)((L) * 2 + (r)) * NMOD + (i)) * DM)
#define GAIN(L, i) (args.in[7] + ((size_t)(L) * 4 + (i)) * DM)
    bf16* const HB = (bf16*)(ws + WS_HB); bf16* const U = (bf16*)(ws + WS_U); bf16* const Z = (bf16*)(ws + WS_Z); bf16* const Y = (bf16*)(ws + WS_Y);
    float* const XC = (float*)(ws + WS_XC); float* const XL = args.out;
#ifndef XRES_BF16
#define XRES_BF16 1
#endif
    constexpr int RXS = XRES_BF16 ? 1 : 0, RXD = XRES_BF16 ? 1 : 2;
    void* const XRL = XRES_BF16 ? (void*)(ws + WS_XB) : (void*)XL;
    bf16* const Pb = U; bf16* const Bqb = U + (size_t)MT * DM;

    if (IN(0)) { for (int rep_ = 0; rep_ < REP_P0; ++rep_) { Frame Fp = fresh(F); p0_prologue(Fp, args); __syncthreads(); } } SEAM(0);
    if (IN(1)) { Frame Fp = fresh(F); p1_adaln(Fp, args); } SEAM(1);
    if (IN(2)) { Frame Fp = fresh(F); row_phase<false, true, 0, 0>(Fp, 0, MT, (int)blockIdx.x, F.G, args.in[0], args.in[2], nullptr, nullptr, nullptr, nullptr, nullptr, nullptr, HB, GAIN(0, 0), MODV(0, 0, 0), MODV(0, 1, 0), MODV(0, 0, 1), MODV(0, 1, 1)); } SEAM(2);

    const int gsi = F.G >= 96 ? 48 : F.G / 2, gso = F.G >= 32 ? 16 : F.G / 2;
    if (IN(3)) { GEMM_CALL(pg8::EpiScIn, HB, ws + WS_SCIN, SEQ, 3 * DM, DM, Pb, Bqb, DM); } SEAM(3);
    if (IN(4)) { if ((int)blockIdx.x < gsi) { GEMM_CALL_SUB(pg8::EpiScIn, HB + (size_t)SEQ * DM, ws + WS_SCIN, CTXL, 3 * DM, DM, gsi, (int)blockIdx.x, Pb + (size_t)SEQ * DM, Bqb + (size_t)SEQ * DM, DM); }
                 else { Frame Fp = fresh(F); sc_conv_phase(Fp, 0, SEQ, (int)blockIdx.x - gsi, F.G - gsi, Pb, Bqb, args.in[11], Z); } } SEAM(4);
    if (IN(5)) { { Frame Fp = fresh(F); sc_conv_phase(Fp, SEQ, MT, (int)blockIdx.x, F.G, Pb, Bqb, args.in[11], Z); }
                 GEMM_CALL(pg8::EpiBf16<0>, Z, ws + WS_SCOUT, SEQ, DM, DM, Y, DM, nullptr, 0, 0, 1.f); } SEAM(5);
    if (IN(6)) { if ((int)blockIdx.x < gso) { GEMM_CALL_SUB(pg8::EpiBf16<0>, Z + (size_t)SEQ * DM, ws + WS_SCOUT, CTXL, DM, DM, gso, (int)blockIdx.x, Y + (size_t)SEQ * DM, DM, nullptr, 0, 0, 1.f); }
                 else { Frame Fp = fresh(F); row_phase<true, true, 0, RXD>(Fp, 0, SEQ, (int)blockIdx.x - gso, F.G - gso, args.in[0], args.in[2], XRL, XC, Y, MODV(0, 0, 2), MODV(0, 1, 2), GAIN(0, 1), HB, GAIN(0, 2), MODV(0, 0, 3), MODV(0, 1, 3), MODV(0, 0, 4), MODV(0, 1, 4)); } } SEAM(6);
    if (IN(7)) { Frame Fp = fresh(F); row_phase<true, true, 0, 2>(Fp, SEQ, MT, (int)blockIdx.x, F.G, args.in[0], args.in[2], XL, XC, Y, MODV(0, 0, 2), MODV(0, 1, 2), GAIN(0, 1), HB, GAIN(0, 2), MODV(0, 0, 3), MODV(0, 1, 3), MODV(0, 0, 4), MODV(0, 1, 4)); } SEAM(7);
    if (IN(8)) { GEMM_CALL(pg8::EpiSwiglu, HB, ws + WS_WGU, MT, NGU, DM, U, FFP); } SEAM(8);
    if (IN(9)) { GEMM_DOWN(U, ws + WS_WD, Y, DM, nullptr, 0, 0, 1.f); } SEAM(9);
    if (IN(10)) { if ((int)blockIdx.x < gso) { { pg8::Gemm g_{(const pg8::bf16_t*)(U + (size_t)SEQ * FFP), (const pg8::bf16_t*)(ws + WS_WD), CTXL, DM, FF, FFP}; pg8::StaticOrder S_; S_.init(CTXL, DM, gso, (int)blockIdx.x); pg8::EpiBf16<0> E_{Y + (size_t)SEQ * DM, DM, nullptr, 0, 0, 1.f}; pg8::gemm_phase<pg8::EpiBf16<0>, pg8::StaticOrder, PG8_ALIGN, PG8_SP2>(F.lds, g_, S_, E_); } }
                  else { Frame Fp = fresh(F); row_phase<true, true, RXS, RXD>(Fp, 0, SEQ, (int)blockIdx.x - gso, F.G - gso, XRL, XC, XRL, XC, Y, MODV(0, 0, 5), MODV(0, 1, 5), GAIN(0, 3), HB, GAIN(1, 0), MODV(1, 0, 0), MODV(1, 1, 0), MODV(1, 0, 1), MODV(1, 1, 1)); } } SEAM(10);
    if (IN(11)) { Frame Fp = fresh(F); row_phase<true, true, 0, 2>(Fp, SEQ, MT, (int)blockIdx.x, F.G, XL, XC, XL, XC, Y, MODV(0, 0, 5), MODV(0, 1, 5), GAIN(0, 3), HB, GAIN(1, 0), MODV(1, 0, 0), MODV(1, 1, 0), MODV(1, 0, 1), MODV(1, 1, 1)); } SEAM(11);

    float* const Dd = (float*)(ws + WS_D); bf16* const CQN = (bf16*)(ws + WS_CQN); bf16* const CKVN = (bf16*)(ws + WS_CKVN); bf16* const KR = (bf16*)(ws + WS_KR);
    bf16* const Qb = (bf16*)(ws + WS_Q); bf16* const KVb = (bf16*)(ws + WS_KV);
    if (IN(12)) { GEMM_CALL(pg8::EpiF32, HB, ws + WS_MDOWN, MT, MDNP, DM, Dd, MDNP); } SEAM(12);
    if (IN(13)) { Frame Fp = fresh(F); mla_row_phase(Fp, Dd, args.in[14], args.in[15], CQN, CKVN, KR); } SEAM(13);
    if (IN(14)) { GEMM_CALL(pg8::EpiBf16<0>, CQN, ws + WS_MUQ, SEQ, QW, QR, Qb, QW, nullptr, 0, 0, 1.f);
                  GEMM_CALL(pg8::EpiBf16<0>, CKVN, ws + WS_MUKV, MT, KVW, KVR, KVb, KVW, nullptr, 0, 0, 1.f); } SEAM(14);
    if (IN(15)) for (int rep_ = 0; rep_ < REP_ATT; ++rep_) {
        const int c = blockIdx.x;
        for (int i = 0;; ++i) { int head, qb;
            if (F.G == 256) { if (i >= 8) break; head = i * 4 + ((c & 7) >> 1); qb = (c & 1) * 32 + (c >> 3); }
            else { const int u = i * F.G + c; if (u >= NH * (SEQ / 256)) break; head = u >> 6; qb = u & 63; }
            att::attn_unit(Qb + (size_t)qb * 256 * QW + head * (NOPE + ROPE), KVb + head * (NOPE + VD), KVb + head * (NOPE + VD) + NOPE, KR, Z + (size_t)qb * 256 * DM + head * VD, qb * 256, MT, (char*)lds);
            __syncthreads(); }
    } SEAM(15);
    if (IN(16)) { GEMM_CALL(pg8::EpiBf16<0>, Z, ws + WS_MOUT, SEQ, DM, DM, Y, DM, nullptr, 0, 0, 1.f); } SEAM(16);
    if (IN(17)) { Frame Fp = fresh(F); row_phase<true, true, RXS, RXD>(Fp, 0, SEQ, (int)blockIdx.x, F.G, XRL, XC, XRL, XC, Y, MODV(1, 0, 2), MODV(1, 1, 2), GAIN(1, 1), HB, GAIN(1, 2), MODV(1, 0, 3), MODV(1, 1, 3), MODV(1, 0, 4), MODV(1, 1, 4)); } SEAM(17);
    if (IN(17)) { for (int rep_ = 1; rep_ < REP_ROW; ++rep_) { Frame Fp = fresh(F); row_phase<true, true, 0, 2>(Fp, 0, SEQ, (int)blockIdx.x, F.G, XL, XC, (float*)(ws + WS_KV), XC, Y, MODV(1, 0, 2), MODV(1, 1, 2), GAIN(1, 1), (bf16*)(ws + WS_Q), GAIN(1, 2), MODV(1, 0, 3), MODV(1, 1, 3), MODV(1, 0, 4), MODV(1, 1, 4)); } }
#ifdef REP_BAR
    if (IN(17) && IN(18)) { for (int rep_ = 0; rep_ < REP_BAR; ++rep_) xcd_barrier(bar); }
#endif
    if (IN(18)) { for (int rep_ = 0; rep_ < REP_GU; ++rep_) { GEMM_CALL(pg8::EpiSwiglu, HB, ws + WS_WGU + SZ_WGU, SEQ, NGU, DM, U, FFP); } } SEAM(18);
    if (IN(19)) { for (int rep_ = 0; rep_ < REP_DN; ++rep_) { GEMM_DOWN(U, ws + WS_WD + SZ_WD, Y, DM, nullptr, 0, 0, 1.f); } } SEAM(19);
    if (IN(20)) { Frame Fp = fresh(F); row_phase<true, true, RXS, RXD>(Fp, 0, SEQ, (int)blockIdx.x, F.G, XRL, XC, XRL, XC, Y, MODV(1, 0, 5), MODV(1, 1, 5), GAIN(1, 3), HB, GAIN(2, 0), MODV(2, 0, 0), MODV(2, 1, 0), MODV(2, 0, 1), MODV(2, 1, 1)); } SEAM(20);

    bf16* const GT = (bf16*)(ws + WS_GT); bf16* const VVT = (bf16*)(ws + WS_VVT); bf16* const YT = (bf16*)(ws + WS_YT);
    if (IN(21)) { GEMM_CALL(pg8::EpiBf16<0>, HB, ws + WS_HYIN, SEQ, 3 * DM, DM, U, 3 * DM, nullptr, 0, 0, 1.f);
                  GEMM_CALL(pg8::EpiBf16<0>, ws + WS_W4T, ws + WS_HD3, 8192, SEQ, FHP, GT, SEQ, nullptr, 0, 0, 1.f); } SEAM(21);
    if (IN(22)) { for (int rep_ = 0; rep_ < REP_MISC; ++rep_) { Frame Fp = fresh(F); hy_h2_phase(Fp, U, args.in[20], args.in[21], VVT); } } SEAM(22);
    if (IN(23)) { for (int rep_ = 0; rep_ < REP_FFT; ++rep_) { Frame Fp = fresh(F); hy_fft_phase(Fp, GT, VVT, args.in[30], YT, 3.0701134573253945f, (15.350567286626972f - 3.0701134573253945f) / 4095.0f, 1.4426950408889634f / 16383.0f); } } SEAM(23);
    if (IN(24)) { for (int rep_ = 0; rep_ < REP_MISC; ++rep_) { Frame Fp = fresh(F); hy_h4_phase(Fp, U, args.in[20], args.in[21], YT, Z); } } SEAM(24);
    if (IN(25)) { GEMM_CALL(pg8::EpiBf16<0>, Z, ws + WS_HYOUT, SEQ, DM, DM, Y, DM, nullptr, 0, 0, 1.f); } SEAM(25);
    if (IN(26)) { Frame Fp = fresh(F); row_phase<true, true, RXS, RXD>(Fp, 0, SEQ, (int)blockIdx.x, F.G, XRL, XC, XRL, XC, Y, MODV(2, 0, 2), MODV(2, 1, 2), GAIN(2, 1), HB, GAIN(2, 2), MODV(2, 0, 3), MODV(2, 1, 3), MODV(2, 0, 4), MODV(2, 1, 4)); } SEAM(26);
    if (IN(27)) { GEMM_CALL(pg8::EpiSwiglu, HB, ws + WS_WGU + 2 * SZ_WGU, SEQ, NGU, DM, U, FFP); } SEAM(27);
    if (IN(28)) { GEMM_DOWN(U, ws + WS_WD + 2 * SZ_WD, Y, DM, nullptr, 0, 0, 1.f); } SEAM(28);
    if (IN(29)) { Frame Fp = fresh(F); row_phase<true, true, RXS, RXD>(Fp, 0, SEQ, (int)blockIdx.x, F.G, XRL, XC, XRL, XC, Y, MODV(2, 0, 5), MODV(2, 1, 5), GAIN(2, 3), HB, GAIN(3, 0), MODV(3, 0, 0), MODV(3, 1, 0), MODV(3, 0, 1), MODV(3, 1, 1)); } SEAM(29);

    if (IN(30)) { for (int rep_ = 0; rep_ < REP_SCIN; ++rep_) { GEMM_CALL(pg8::EpiScIn, HB, ws + WS_SCIN + SZ_W3, SEQ, 3 * DM, DM, Pb, Bqb, DM); } } SEAM(30);
    if (IN(31)) { for (int rep_ = 0; rep_ < REP_MISC; ++rep_) { Frame Fp = fresh(F); sc_conv_phase(Fp, 0, SEQ, (int)blockIdx.x, F.G, Pb, Bqb, args.in[11] + 3 * DM, Z); } } SEAM(31);
    if (IN(32)) { GEMM_CALL(pg8::EpiBf16<0>, Z, ws + WS_SCOUT + SZ_SQ, SEQ, DM, DM, Y, DM, nullptr, 0, 0, 1.f); } SEAM(32);
    if (IN(33)) { Frame Fp = fresh(F); row_phase<true, true, RXS, RXD>(Fp, 0, SEQ, (int)blockIdx.x, F.G, XRL, XC, XRL, XC, Y, MODV(3, 0, 2), MODV(3, 1, 2), GAIN(3, 1), HB, GAIN(3, 2), MODV(3, 0, 3), MODV(3, 1, 3), MODV(3, 0, 4), MODV(3, 1, 4)); } SEAM(33);
    if (IN(34)) { GEMM_CALL(pg8::EpiSwiglu, HB, ws + WS_WGU + 3 * SZ_WGU, SEQ, NGU, DM, U, FFP); } SEAM(34);
    if (IN(35)) { GEMM_DOWN(U, ws + WS_WD + 3 * SZ_WD, Y, DM, nullptr, 0, 0, 1.f); } SEAM(35);
    if (IN(36)) { Frame Fp = fresh(F); row_phase<true, false, RXS, 2>(Fp, 0, SEQ, (int)blockIdx.x, F.G, XRL, XC, XL, XC, Y, MODV(3, 0, 5), MODV(3, 1, 5), GAIN(3, 3), nullptr, nullptr, nullptr, nullptr, nullptr, nullptr); }
#undef IN
#undef SEAM
}

extern "C" void kernel_launch(void* const* d_in, const int* in_sizes, int n_in, void* d_out, int out_size, void* d_ws, size_t ws_size, hipStream_t stream) {
    static int grid = 0;
    if (grid == 0) {
        if (n_in != 32 || in_sizes[0] != SEQ * DM || out_size != SEQ * DM || ws_size < WS_END) {
            fprintf(stderr, "kernel_launch: shape mismatch: n_in %d in0 %d out %d ws %zu (need >= %zu); nothing launched\n", n_in, n_in > 0 ? in_sizes[0] : -1, out_size, ws_size, (size_t)WS_END); grid = -1; return; }
        int dev = 0, cus = 0, per_cu = 0;
        if (hipGetDevice(&dev) != hipSuccess || hipDeviceGetAttribute(&cus, hipDeviceAttributeMultiprocessorCount, dev) != hipSuccess) { fprintf(stderr, "kernel_launch: device query failed\n"); grid = -1; return; }
        if (hipFuncSetAttribute((const void*)mega_fwd, hipFuncAttributeMaxDynamicSharedMemorySize, LDS_BYTES) != hipSuccess) { fprintf(stderr, "kernel_launch: hipFuncSetAttribute failed\n"); grid = -1; return; }
        if (hipOccupancyMaxActiveBlocksPerMultiprocessor(&per_cu, (const void*)mega_fwd, NTHR, LDS_BYTES) != hipSuccess || per_cu < 1)
            fprintf(stderr, "kernel_launch: note: occupancy query reports %d workgroups per CU\n", per_cu);
        (void)hipGetLastError();
        grid = cus;
    }
    if (grid < 0) return;
    if (hipMemsetAsync((char*)d_ws + WS_CTL, 0, CTL_BYTES, stream) != hipSuccess) { fprintf(stderr, "kernel_launch: memset failed\n"); return; }
    Args a{};
    for (int i = 0; i < 32; ++i) a.in[i] = (const float*)d_in[i];
    a.out = (float*)d_out; a.ws = (unsigned char*)d_ws;
#if MK_MULTI
    for (int p = 0; p < MK_PH_END; ++p) { a.ph_lo = p; a.ph_hi = p + 1; hipLaunchKernelGGL(mega_fwd, dim3(grid), dim3(NTHR), LDS_BYTES, stream, a); }
#else
    a.ph_lo = 0; a.ph_hi = MK_PH_END;
    hipLaunchKernelGGL(mega_fwd, dim3(grid), dim3(NTHR), LDS_BYTES, stream, a);
#endif
    const hipError_t le = hipPeekAtLastError();
    if (le != hipSuccess) fprintf(stderr, "kernel_launch: launch failed: %s\n", hipGetErrorName(le));
}
```

```cpp
#include <hip/hip_runtime.h>
#include <cstdio>
#include <cstdint>
namespace pg8 {
#define PG8_LAS __attribute__((address_space(3)))
typedef unsigned short bf16_t;
typedef short bf16x8 __attribute__((ext_vector_type(8)));
typedef float f32x4 __attribute__((ext_vector_type(4)));
typedef unsigned u32x4 __attribute__((ext_vector_type(4)));
constexpr int BM = 256, BK = 64, HALF = 128, HTB = HALF * BK * 2  , STAGE_BYTES = 8 * HTB, NXCD = 8, WGM = 8;

__host__ __device__ __forceinline__ int lds_byte(int r, int c) { const int st = (r >> 4) * 2 + (c >> 5), rr = r & 15, cc = c & 31, ob = rr * 64 + cc * 2; return st * 1024 + (ob ^ (((ob >> 9) & 1) << 5)); }
__host__ __device__ __forceinline__ void stage_rc(int b, int& R, int& C) { const int st = b / 1024, sb = b % 1024, swz = sb ^ (((sb >> 9) & 1) << 5); R = (st >> 1) * 16 + swz / 64; C = (st & 1) * 32 + (swz % 64) / 2; }
__host__ __device__ __forceinline__ int perm32(int rho) { const int n = rho >> 4, i = rho & 15; return 8 * (i >> 2) + 4 * n + (i & 3); }

struct Unit { int pm, pn; };
struct Gemm { const bf16_t* A; const bf16_t* Bt; int M, N, K; int ld; };

struct StaticOrder {
    int nM, nN, nwg, G, c;
    __host__ __device__ void init(int M, int N, int G_, int c_) { nM = M / BM; nN = N / BM; nwg = nM * nN; G = G_; c = c_; }
    __host__ __device__ bool next(int i, Unit& u) const {
        const long L = (long)i * G + c; if (L >= nwg) return false;
        int wgid = (int)L; { const int q = nwg / NXCD, r = nwg % NXCD, xcd = wgid % NXCD, off = wgid / NXCD; wgid = (xcd < r ? xcd * (q + 1) : r * (q + 1) + (xcd - r) * q) + off; }
        const int nig = WGM * nN, gid = wgid / nig, fm = gid * WGM, gsz = (nM - fm) < WGM ? (nM - fm) : WGM;
        u.pm = fm + ((wgid % nig) % gsz); u.pn = (wgid % nig) / gsz; return true;
    }
    __device__ __forceinline__ void a_ready(const Unit&) const {}
    __device__ __forceinline__ void done(const Unit&) const {}
};

template <int RB, int CB> struct BlockOrder {
    static_assert(RB * CB == 32 && 8 % RB == 0 && 16 % CB == 0, "32 tiles per XCD and round");
    int c;
    __host__ __device__ void init(int c_) { c = c_; }
    __host__ __device__ bool next(int i, Unit& u) const {
        constexpr int NCG = 16 / CB, NRS = 8 / RB; if (i >= NCG * NRS) return false;
        const int x = c & 7, s = c >> 3, cg = i % NCG, rs = i / NCG;
        u.pm = 8 * x + rs * RB + (s % RB); u.pn = cg * CB + (s / RB); return true;
    }
    __device__ __forceinline__ void a_ready(const Unit&) const {}
    __device__ __forceinline__ void done(const Unit&) const {}
};
__device__ __forceinline__ unsigned cvt_pk_bf16(float lo, float hi) { unsigned r; asm volatile("v_cvt_pk_bf16_f32 %0, %1, %2" : "=v"(r) : "v"(lo), "v"(hi)); return r; }
typedef float f32x2 __attribute__((ext_vector_type(2)));
__device__ __forceinline__ f32x2 gelu_pk(f32x2 v) {
    const f32x2 av = __builtin_elementwise_abs(v), d = av * 0.2316418882f + 1.0f;
    f32x2 t; t.x = __builtin_amdgcn_rcpf(d.x); t.y = __builtin_amdgcn_rcpf(d.y);
    f32x2 q = t * 0.5307027145f + (-0.7265760135f); q = q * t + 0.7107068705f; q = q * t + (-0.142248368f); q = q * t + 0.127414796f; q = q * t;
    const f32x2 s = (v * v) * (-0.72134752044f);
    f32x2 e; e.x = __builtin_amdgcn_exp2f(s.x); e.y = __builtin_amdgcn_exp2f(s.y);
    const f32x2 m = v * (q * e), r = v - m;
    f32x2 o; o.x = v.x < 0.f ? m.x : r.x; o.y = v.y < 0.f ? m.y : r.y; return o;
}

template <int ACT  > struct EpiBf16 {
    static constexpr bool PERM = true, AFTER_DRAIN = false; static_assert(ACT == 0 || ACT == 1, "EpiBf16: ACT is 0 (none) or 1 (gelu_pk)");
    bf16_t* O; int ldc; const float* bias; int split_cols; size_t split_stride; float scale0;
    __device__ __forceinline__ void operator()(const f32x4 (&acc)[2][2][4][2], const Unit& u, int wr, int wc, int fr, int fq) const {
        const int row0 = u.pm * BM + wr * 64 + fr; int colt = u.pn * BM; bf16_t* base = O;
        float sc = 1.f; if (split_cols) { const int t = colt / split_cols; base += (size_t)t * split_stride; colt -= t * split_cols; if (t == 0) sc = scale0; }
        const int col0 = colt + wc * 32 + 8 * fq, bcol0 = u.pn * BM + wc * 32 + 8 * fq;
        f32x4 bv[2][2];
#pragma unroll
        for (int bj = 0; bj < 2; ++bj)
#pragma unroll
            for (int n = 0; n < 2; ++n) bv[bj][n] = bias ? *(const f32x4*)(bias + bcol0 + bj * HALF + 4 * n) : (f32x4){0.f, 0.f, 0.f, 0.f};
#pragma unroll
        for (int ai = 0; ai < 2; ++ai)
#pragma unroll
            for (int m = 0; m < 4; ++m) { bf16_t* rowp = base + (size_t)(row0 + ai * HALF + m * 16) * ldc + col0;
#pragma unroll
                for (int bj = 0; bj < 2; ++bj) { f32x4 v0 = acc[ai][bj][m][0] + bv[bj][0], v1 = acc[ai][bj][m][1] + bv[bj][1];
                    if (ACT == 1) { f32x2 a = gelu_pk((f32x2){v0[0], v0[1]}), b = gelu_pk((f32x2){v0[2], v0[3]}), c = gelu_pk((f32x2){v1[0], v1[1]}), d = gelu_pk((f32x2){v1[2], v1[3]});
                        v0 = (f32x4){a.x, a.y, b.x, b.y}; v1 = (f32x4){c.x, c.y, d.x, d.y}; }
                    v0 = v0 * sc; v1 = v1 * sc; u32x4 w; w.x = cvt_pk_bf16(v0[0], v0[1]); w.y = cvt_pk_bf16(v0[2], v0[3]); w.z = cvt_pk_bf16(v1[0], v1[1]); w.w = cvt_pk_bf16(v1[2], v1[3]);
                    *(u32x4*)(rowp + bj * HALF) = w; } }
    }
};
__device__ __forceinline__ float silu_fast(float g) { return g * __builtin_amdgcn_rcpf(1.0f + __builtin_amdgcn_exp2f(-1.4426950408889634f * g)); }
__device__ __forceinline__ u32x4 pack8(const f32x4 v0, const f32x4 v1) { u32x4 w; w.x = cvt_pk_bf16(v0[0], v0[1]); w.y = cvt_pk_bf16(v0[2], v0[3]); w.z = cvt_pk_bf16(v1[0], v1[1]); w.w = cvt_pk_bf16(v1[2], v1[3]); return w; }
struct EpiF32 {
    static constexpr bool PERM = false, AFTER_DRAIN = false;
    float* C; int ldc;
    __device__ __forceinline__ void operator()(const f32x4 (&acc)[2][2][4][2], const Unit& u, int wr, int wc, int fr, int fq) const {
        const int row0 = u.pm * BM + wr * 64 + fr, col0 = u.pn * BM + wc * 32 + 4 * fq;
#pragma unroll
        for (int ai = 0; ai < 2; ++ai)
#pragma unroll
            for (int m = 0; m < 4; ++m) { float* rowp = C + (size_t)(row0 + ai * HALF + m * 16) * ldc + col0;
#pragma unroll
                for (int bj = 0; bj < 2; ++bj)
#pragma unroll
                    for (int n = 0; n < 2; ++n) *(f32x4*)(rowp + bj * HALF + n * 16) = acc[ai][bj][m][n]; }
    }
};
struct EpiSwiglu {
    static constexpr bool PERM = true, AFTER_DRAIN = false;
    bf16_t* O; int ldc;
    __device__ __forceinline__ void operator()(const f32x4 (&acc)[2][2][4][2], const Unit& u, int wr, int wc, int fr, int fq) const {
        const int row0 = u.pm * BM + wr * 64 + fr, col0 = u.pn * HALF + wc * 32 + 8 * fq;
#pragma unroll
        for (int ai = 0; ai < 2; ++ai)
#pragma unroll
            for (int m = 0; m < 4; ++m) { bf16_t* rowp = O + (size_t)(row0 + ai * HALF + m * 16) * ldc + col0;
                f32x4 r0, r1;
#pragma unroll
                for (int e = 0; e < 4; ++e) { r0[e] = silu_fast(acc[ai][0][m][0][e]) * acc[ai][1][m][0][e]; r1[e] = silu_fast(acc[ai][0][m][1][e]) * acc[ai][1][m][1][e]; }
                __builtin_nontemporal_store(pack8(r0, r1), (u32x4*)rowp); }
    }
};
struct EpiScIn {
    static constexpr bool PERM = true, AFTER_DRAIN = false;
    bf16_t* P; bf16_t* Bq; int ldc;
    __device__ __forceinline__ void operator()(const f32x4 (&acc)[2][2][4][2], const Unit& u, int wr, int wc, int fr, int fq) const {
        const int row0 = u.pm * BM + wr * 64 + fr;
        if (u.pn < 32) {
            const int col0 = u.pn * HALF + wc * 32 + 8 * fq;
#pragma unroll
            for (int ai = 0; ai < 2; ++ai)
#pragma unroll
                for (int m = 0; m < 4; ++m) { bf16_t* rowp = P + (size_t)(row0 + ai * HALF + m * 16) * ldc + col0;
                    *(u32x4*)rowp = pack8(acc[ai][0][m][0] * acc[ai][1][m][0], acc[ai][0][m][1] * acc[ai][1][m][1]); }
        } else {
            const int col0 = (u.pn - 32) * BM + wc * 32 + 8 * fq;
#pragma unroll
            for (int ai = 0; ai < 2; ++ai)
#pragma unroll
                for (int m = 0; m < 4; ++m) { bf16_t* rowp = Bq + (size_t)(row0 + ai * HALF + m * 16) * ldc + col0;
#pragma unroll
                    for (int bj = 0; bj < 2; ++bj) *(u32x4*)(rowp + bj * HALF) = pack8(acc[ai][bj][m][0], acc[ai][bj][m][1]); }
        }
    }
};
template <class Epi, class Sched, bool ALIGN_EPI = false, bool SP2 = false>
__device__ __forceinline__ void gemm_phase(PG8_LAS unsigned char* lds, const Gemm g, const Sched& S, const Epi& E) {
    int tid_ = threadIdx.x; asm volatile("" : "+v"(tid_));
    const int tid = tid_, wid = __builtin_amdgcn_readfirstlane(tid >> 6), lane = tid & 63, wr = wid >> 2, wc = wid & 3, fr = lane & 15, fq = lane >> 4;
    const int nt = g.K / BK, K = g.ld ? g.ld : g.K;
    unsigned voffA[2], voffB[2];
#pragma unroll
    for (int i = 0; i < 2; ++i) { int R, C; stage_rc(tid * 16 + i * 8192, R, C); const int Rb = Epi::PERM ? ((R & ~31) + perm32(R & 31)) : R;
        voffA[i] = (unsigned)(R * K + C) * 2u; voffB[i] = (unsigned)(Rb * K + C) * 2u; }
    const size_t kstep = (size_t)(BK * 2);
    const size_t hstep = (size_t)HALF * K * 2;
    const size_t tstep = 2 * hstep;
    const unsigned ldsw = (unsigned)wid * 1024u;
    const int aoff = lds_byte(wr * 64 + fr, fq * 8), boff = lds_byte(wc * 32 + fr, fq * 8);
#define PG8_SA(b, h) (((b) * 2 + (h)) * HTB)
#define PG8_SB(b, h) ((4 + (b) * 2 + (h)) * HTB)
#define PG8_STAGE(bufoff, gbase, voff) do { _Pragma("unroll") for (int _i = 0; _i < 2; ++_i) \
        __builtin_amdgcn_global_load_lds((const unsigned*)((const char*)(gbase) + (voff)[_i]), (PG8_LAS unsigned*)(lds + (bufoff) + ldsw + _i * 8192), 16, 0, 0); } while (0)
#define PG8_LDA(dst, b, h) do { _Pragma("unroll") for (int m = 0; m < 4; ++m) _Pragma("unroll") for (int k = 0; k < 2; ++k) dst[m][k] = *(const PG8_LAS bf16x8*)(lds + PG8_SA(b, h) + aoff + m * 2048 + k * 1024); } while (0)
#define PG8_LDB(dst, b, h) do { _Pragma("unroll") for (int n = 0; n < 2; ++n) _Pragma("unroll") for (int k = 0; k < 2; ++k) dst[n][k] = *(const PG8_LAS bf16x8*)(lds + PG8_SB(b, h) + boff + n * 2048 + k * 1024); } while (0)
#define PG8_MMA(ai, bj, At, Bt) do { __builtin_amdgcn_s_setprio(1); _Pragma("unroll") for (int m = 0; m < 4; ++m) _Pragma("unroll") for (int n = 0; n < 2; ++n) _Pragma("unroll") for (int k = 0; k < 2; ++k) \
        acc[ai][bj][m][n] = __builtin_amdgcn_mfma_f32_16x16x32_bf16(Bt[n][k], At[m][k], acc[ai][bj][m][n], 0, 0, 0); __builtin_amdgcn_s_setprio(0); } while (0)
#define PG8_WAIT_V(n) asm volatile("s_waitcnt vmcnt(" #n ")" ::: "memory")
#define PG8_WAIT_L(n) asm volatile("s_waitcnt lgkmcnt(" #n ")" ::: "memory")
#define PG8_BAR __builtin_amdgcn_s_barrier()
#define PG8_SCHED __builtin_amdgcn_sched_barrier(0)
    Unit cur, nxt; int ui = 0;
    if (!S.next(0, cur)) return;
    f32x4 acc[2][2][4][2];
#pragma unroll
    for (int a = 0; a < 2; ++a)
#pragma unroll
        for (int b = 0; b < 2; ++b)
#pragma unroll
            for (int m = 0; m < 4; ++m)
#pragma unroll
                for (int n = 0; n < 2; ++n) acc[a][b][m][n] = (f32x4){0.f, 0.f, 0.f, 0.f};
    bf16x8 At[4][2], B0[2][2], B1[2][2];
    const char* cA = (const char*)g.A + (size_t)cur.pm * tstep; const char* cB = (const char*)g.Bt + (size_t)cur.pn * tstep;
    S.a_ready(cur);
    if constexpr (SP2) {
        PG8_STAGE(PG8_SB(0, 0), cB, voffB); PG8_STAGE(PG8_SB(0, 1), cB + hstep, voffB); PG8_STAGE(PG8_SA(0, 0), cA, voffA); PG8_STAGE(PG8_SA(0, 1), cA + hstep, voffA);
        if (wr == 1) PG8_BAR;
        PG8_WAIT_V(2); PG8_BAR;
        PG8_STAGE(PG8_SB(1, 0), cB + kstep, voffB); PG8_STAGE(PG8_SA(1, 0), cA + kstep, voffA); PG8_STAGE(PG8_SB(1, 1), cB + hstep + kstep, voffB);
        PG8_WAIT_V(6); PG8_BAR;
    } else {
        PG8_STAGE(PG8_SB(0, 0), cB, voffB); PG8_STAGE(PG8_SA(0, 0), cA, voffA); PG8_STAGE(PG8_SB(0, 1), cB + hstep, voffB); PG8_STAGE(PG8_SA(0, 1), cA + hstep, voffA);
        if (wr == 1) PG8_BAR;
        PG8_WAIT_V(4); PG8_BAR;
        PG8_STAGE(PG8_SB(1, 0), cB + kstep, voffB); PG8_STAGE(PG8_SA(1, 0), cA + kstep, voffA); PG8_STAGE(PG8_SB(1, 1), cB + hstep + kstep, voffB);
        PG8_WAIT_V(6); PG8_BAR;
    }
    for (;;) {
        const bool has_next = S.next(ui + 1, nxt);
        const char* nA = has_next ? (const char*)g.A + (size_t)nxt.pm * tstep : cA; const char* nB = has_next ? (const char*)g.Bt + (size_t)nxt.pn * tstep : cB;
        for (int t = 0; t < nt; t += 2) {
            const bool last = (t == nt - 2);
            const char* a1 = cA + (size_t)(t + 1) * kstep;
            const char* a2 = last ? nA : cA + (size_t)(t + 2) * kstep; const char* b2 = last ? nB : cB + (size_t)(t + 2) * kstep;
            const char* a3 = a2 + kstep; const char* b3 = b2 + kstep;
            if (last && has_next) S.a_ready(nxt);
            if constexpr (SP2) {
            PG8_LDB(B0, 0, 0); PG8_LDB(B1, 0, 1); PG8_SCHED; PG8_LDA(At, 0, 0); PG8_STAGE(PG8_SA(1, 1), a1 + hstep, voffA);
            PG8_WAIT_V(8); PG8_WAIT_L(0); PG8_BAR; PG8_MMA(0, 0, At, B0); PG8_MMA(0, 1, At, B1); PG8_BAR; PG8_SCHED;
            PG8_LDA(At, 0, 1); PG8_STAGE(PG8_SB(0, 0), b2, voffB); PG8_STAGE(PG8_SB(0, 1), b2 + hstep, voffB); PG8_STAGE(PG8_SA(0, 0), a2, voffA);
            PG8_WAIT_V(8); PG8_WAIT_L(0); PG8_BAR; PG8_MMA(1, 0, At, B0); PG8_MMA(1, 1, At, B1); PG8_BAR; PG8_SCHED;
            PG8_LDB(B0, 1, 0); PG8_LDB(B1, 1, 1); PG8_SCHED; PG8_LDA(At, 1, 0); PG8_STAGE(PG8_SA(0, 1), a2 + hstep, voffA);
            PG8_WAIT_V(8); PG8_WAIT_L(0); PG8_BAR; PG8_MMA(0, 0, At, B0); PG8_MMA(0, 1, At, B1); PG8_BAR; PG8_SCHED;
            PG8_LDA(At, 1, 1); PG8_STAGE(PG8_SB(1, 0), b3, voffB); PG8_STAGE(PG8_SB(1, 1), b3 + hstep, voffB); PG8_STAGE(PG8_SA(1, 0), a3, voffA);
            PG8_WAIT_V(8); PG8_WAIT_L(0); PG8_BAR; PG8_MMA(1, 0, At, B0); PG8_MMA(1, 1, At, B1); PG8_BAR; PG8_SCHED;
            } else {
            PG8_LDB(B0, 0, 0); PG8_SCHED; PG8_LDA(At, 0, 0); PG8_STAGE(PG8_SA(1, 1), a1 + hstep, voffA);
            PG8_WAIT_L(8); PG8_BAR; PG8_WAIT_L(0); PG8_MMA(0, 0, At, B0); PG8_BAR; PG8_SCHED;
            PG8_LDB(B1, 0, 1); PG8_STAGE(PG8_SB(0, 0), b2, voffB);
            PG8_BAR; PG8_WAIT_L(0); PG8_MMA(0, 1, At, B1); PG8_BAR;
            PG8_LDA(At, 0, 1); PG8_STAGE(PG8_SA(0, 0), a2, voffA);
            PG8_BAR; PG8_WAIT_L(0); PG8_MMA(1, 0, At, B0); PG8_BAR; PG8_SCHED;
            PG8_STAGE(PG8_SB(0, 1), b2 + hstep, voffB);
            PG8_WAIT_V(6); PG8_BAR; PG8_MMA(1, 1, At, B1); PG8_BAR;
            PG8_LDB(B0, 1, 0); PG8_SCHED; PG8_LDA(At, 1, 0); PG8_STAGE(PG8_SA(0, 1), a2 + hstep, voffA);
            PG8_WAIT_L(8); PG8_BAR; PG8_WAIT_L(0); PG8_MMA(0, 0, At, B0); PG8_BAR; PG8_SCHED;
            PG8_LDB(B1, 1, 1); PG8_STAGE(PG8_SB(1, 0), b3, voffB);
            PG8_BAR; PG8_WAIT_L(0); PG8_MMA(0, 1, At, B1); PG8_BAR;
            PG8_LDA(At, 1, 1); PG8_STAGE(PG8_SA(1, 0), a3, voffA);
            PG8_BAR; PG8_WAIT_L(0); PG8_MMA(1, 0, At, B0); PG8_BAR; PG8_SCHED;
            PG8_STAGE(PG8_SB(1, 1), b3 + hstep, voffB);
            PG8_WAIT_V(6); PG8_BAR; PG8_MMA(1, 1, At, B1); PG8_BAR;
            }
        }
        if constexpr (ALIGN_EPI) { if (wr == 0) PG8_BAR; }
        if constexpr (!Epi::AFTER_DRAIN) { E(acc, cur, wr, wc, fr, fq); S.done(cur); }
        if (!has_next) break;
#pragma unroll
        for (int a = 0; a < 2; ++a)
#pragma unroll
            for (int b = 0; b < 2; ++b)
#pragma unroll
                for (int m = 0; m < 4; ++m)
#pragma unroll
                    for (int n = 0; n < 2; ++n) acc[a][b][m][n] = (f32x4){0.f, 0.f, 0.f, 0.f};
        cur = nxt; cA = nA; cB = nB; ++ui;
        if constexpr (ALIGN_EPI) { if (wr == 1) PG8_BAR; }
    }
    PG8_WAIT_V(0);
    if constexpr (!ALIGN_EPI) { if (wr == 0) PG8_BAR; }
    PG8_BAR;
    if constexpr (Epi::AFTER_DRAIN) { E.fused(acc, cur, wr, wc, fr, fq, lds, wid, lane); S.done(cur); }
#undef PG8_SA
#undef PG8_SB
#undef PG8_STAGE
#undef PG8_LDA
#undef PG8_LDB
#undef PG8_MMA
#undef PG8_WAIT_V
#undef PG8_WAIT_L
#undef PG8_BAR
#undef PG8_SCHED
}
}

#ifndef PG8_SP2
#define PG8_SP2 true
#endif
#ifndef PG8_ALIGN
#define PG8_ALIGN true
#endif
#define GAS __attribute__((address_space(1)))
#define LAS __attribute__((address_space(3)))
typedef unsigned short bf16;
typedef unsigned v4u __attribute__((ext_vector_type(4)));
typedef unsigned v2u __attribute__((ext_vector_type(2)));
typedef float f32x4 __attribute__((ext_vector_type(4)));
typedef float f32x2 __attribute__((ext_vector_type(2)));
typedef GAS unsigned gu32;
#define RLX_AGENT __ATOMIC_RELAXED, __HIP_MEMORY_SCOPE_AGENT
#define LDS_WAIT() asm volatile("s_waitcnt lgkmcnt(0)" ::: "memory")
#define VM_WAIT() asm volatile("s_waitcnt vmcnt(0)" ::: "memory")
__device__ __forceinline__ unsigned pk2(float lo, float hi) { return pg8::cvt_pk_bf16(lo, hi); }
__device__ __forceinline__ float bflo(unsigned w) { return __uint_as_float(w << 16); }
__device__ __forceinline__ float bfhi(unsigned w) { return __uint_as_float(w & 0xffff0000u); }
__device__ __forceinline__ float bf1(unsigned short h) { return __uint_as_float((unsigned)h << 16); }

#define XB_TMO      128
#define XB_XCNT(j)  (256  + 64 * (j))
#define XB_XSUB(j)  (1280 + 64 * (j))
#define XB_XGEN(j)  (2304 + 64 * (j))
#define XB_TOP      3328
#define XB_TOPGEN   3392
#define XCD_BAR_WORDS 3456
#define XB_SPIN_CAP (1u << 18)

__device__ __forceinline__ unsigned xb_ld(unsigned* p)              { return __hip_atomic_load(p, __ATOMIC_RELAXED, __HIP_MEMORY_SCOPE_AGENT); }
__device__ __forceinline__ unsigned xb_add(unsigned* p, unsigned v) { return __hip_atomic_fetch_add(p, v, __ATOMIC_RELAXED, __HIP_MEMORY_SCOPE_AGENT); }
__device__ __forceinline__ unsigned xb_xcc_id() { return (unsigned)__builtin_amdgcn_s_getreg((3 << 11) | 20) & 0xFu; }
#define XB_SPIN(cond, bar) do { unsigned _sp = 0; while (cond) { __builtin_amdgcn_s_sleep(1); \
    if ((++_sp & 255u) == 0u) { if (xb_ld(&(bar)[XB_TMO])) break; if (_sp > XB_SPIN_CAP) { atomicAdd(&(bar)[XB_TMO], 1u); break; } } } } while (0)

struct XcdBarrier {
    unsigned* bar; unsigned x;
    volatile LAS unsigned* st;
};

__device__ __forceinline__ XcdBarrier xcd_barrier_post(unsigned* bar, volatile LAS unsigned* st) {
    XcdBarrier b; b.bar = bar; b.x = xb_xcc_id(); b.st = st;
    if (threadIdx.x == 0) (void)xb_add(&bar[XB_XCNT(b.x)], 1u);
    return b;
}
__device__ __forceinline__ void xcd_barrier_complete(unsigned* bar, unsigned x, unsigned& nloc, unsigned& nx) {
    const unsigned G = gridDim.x * gridDim.y * gridDim.z;
    unsigned sum, cnt, mine, sp = 0u;
    for (;;) {
        sum = 0u; cnt = 0u; mine = 0u;
#pragma unroll
        for (unsigned j = 0; j < 16; ++j) { const unsigned c = xb_ld(&bar[XB_XCNT(j)]); sum += c; cnt += (c > 0u) ? 1u : 0u; mine = (j == x) ? c : mine; }
        if (sum == G) break;
        __builtin_amdgcn_s_sleep(1);
        if ((++sp & 255u) == 0u) { if (xb_ld(&bar[XB_TMO])) break; if (sp > XB_SPIN_CAP) { atomicAdd(&bar[XB_TMO], 1u); break; } }
    }
    nloc = mine > 0u ? mine : 1u; nx = cnt > 0u ? cnt : 1u;
}

__device__ __forceinline__ void xcd_barrier(const XcdBarrier& b) {
    asm volatile("s_waitcnt vmcnt(0)" ::: "memory");
    __syncthreads();
    if (threadIdx.x == 0) {
        unsigned* bar = b.bar;
        __builtin_amdgcn_s_waitcnt(0);
        unsigned nloc = b.st[0], nx = b.st[1];
        if (nloc == 0u) { xcd_barrier_complete(bar, b.x, nloc, nx); b.st[0] = nloc; b.st[1] = nx; }
        const unsigned old = xb_add(&bar[XB_XSUB(b.x)], 1u);
        const unsigned gen = old / nloc;
        if (old + 1u == (gen + 1u) * nloc) {
            __builtin_amdgcn_fence(__ATOMIC_RELEASE, "agent");
            asm volatile("s_waitcnt vmcnt(0)" ::: "memory");
            const unsigned og = xb_add(&bar[XB_TOP], 1u);
            const unsigned tg = og / nx;
            if (og + 1u == (tg + 1u) * nx) xb_add(&bar[XB_TOPGEN], 1u);
            else XB_SPIN(xb_ld(&bar[XB_TOPGEN]) == tg, bar);
            __builtin_amdgcn_fence(__ATOMIC_ACQUIRE, "agent");
            xb_add(&bar[XB_XGEN(b.x)], 1u);
            asm volatile("s_waitcnt vmcnt(0)" ::: "memory");
        } else {
            XB_SPIN(xb_ld(&bar[XB_XGEN(b.x)]) == gen, bar);
            __builtin_amdgcn_fence(__ATOMIC_ACQUIRE, "agent");
            asm volatile("s_waitcnt vmcnt(0)" ::: "memory");
        }
    }
    __syncthreads();
}

constexpr int NWAVES = 8, NTHR = 512;
constexpr int DM = 4096, SEQ = 16384, CTXL = 256, MT = SEQ + CTXL, FF = 11008, NGU = 2 * FF, DEPTH = 4;
constexpr int ADA_R = 256, NMOD = 6, MODW = NMOD * DM;
constexpr int QR = 1024, KVR = 512, ROPE = 64, NOPE = 128, VD = 128, NH = 32;
constexpr int MDN = QR + KVR + ROPE, MDNP = 1792;
constexpr int QW = NH * (NOPE + ROPE), KVW = NH * (NOPE + VD);
constexpr int FHP = 256;
constexpr float EPS = 1e-6f;
#ifndef MK_MULTI
#define MK_MULTI 0
#endif
#ifndef MK_PH_END
#define MK_PH_END 37
#endif
constexpr int N_PHASES = 37;

constexpr size_t WS_CTL = 0, CTL_BYTES = 1u << 20;
constexpr size_t WS_MOD = WS_CTL + CTL_BYTES;
#ifndef FF_PAD
#define FF_PAD 64
#endif
constexpr int FFP = FF + FF_PAD;
constexpr size_t SZ_WGU = (size_t)NGU * DM * 2, SZ_WD = (size_t)DM * FFP * 2, SZ_W3 = (size_t)3 * DM * DM * 2, SZ_SQ = (size_t)DM * DM * 2;
constexpr size_t WS_WGU = WS_MOD + (size_t)DEPTH * 2 * MODW * 4;
constexpr size_t WS_WD = WS_WGU + 4 * SZ_WGU;
constexpr size_t WS_SCIN = WS_WD + 4 * SZ_WD;
constexpr size_t WS_SCOUT = WS_SCIN + 2 * SZ_W3;
constexpr size_t WS_MDOWN = WS_SCOUT + 2 * SZ_SQ;
constexpr size_t WS_MUQ = WS_MDOWN + (size_t)MDNP * DM * 2;
constexpr size_t WS_MUKV = WS_MUQ + (size_t)QW * QR * 2;
constexpr size_t WS_MOUT = WS_MUKV + (size_t)KVW * KVR * 2;
constexpr size_t WS_HYIN = WS_MOUT + SZ_SQ;
constexpr size_t WS_HYOUT = WS_HYIN + SZ_W3;
constexpr size_t WS_W4T = WS_HYOUT + SZ_SQ;
constexpr size_t WS_HD3 = WS_W4T + (size_t)8192 * FHP * 2;
constexpr size_t WS_XC = WS_HD3 + (size_t)SEQ * FHP * 2;
constexpr size_t WS_HB = WS_XC + (size_t)CTXL * DM * 4;
constexpr size_t WS_U = WS_HB + (size_t)MT * DM * 2;
constexpr size_t WS_Z = WS_U + (size_t)MT * 3 * DM * 2;
constexpr size_t WS_Y = WS_Z + (size_t)MT * DM * 2;
constexpr size_t WS_D = WS_Y + (size_t)MT * DM * 2;
constexpr size_t WS_CQN = WS_D + (size_t)MT * MDNP * 4;
constexpr size_t WS_CKVN = WS_CQN + (size_t)MT * QR * 2;
constexpr size_t WS_KR = WS_CKVN + (size_t)MT * KVR * 2;
constexpr size_t WS_Q = WS_KR + (size_t)MT * ROPE * 2;
constexpr size_t WS_KV = WS_Q + (size_t)SEQ * QW * 2;
constexpr size_t WS_GT = WS_KV + (size_t)MT * KVW * 2;
constexpr size_t WS_VVT = WS_GT + (size_t)8192 * SEQ * 2;
constexpr size_t WS_YT = WS_VVT + (size_t)DM * SEQ * 2;
constexpr size_t WS_PART = WS_YT + (size_t)DM * SEQ * 2;
constexpr size_t WS_XB = WS_PART + (size_t)DEPTH * 64 * 2 * 256 * 4;
constexpr size_t WS_END = WS_XB + (size_t)SEQ * DM * 2;
static_assert(WS_WGU % 256 == 0 && WS_END % 256 == 0, "ws map alignment");
constexpr int CW_TMO = 0, CW_CODE = 1, CW_BAR = 4096, CW_T = 16384;

constexpr int LDS_BYTES = 163840;
constexpr int LDSCTL_OFF = 159744, MISC_OFF = LDSCTL_OFF + 320;
static_assert(MISC_OFF + 128 <= LDS_BYTES, "LDS map");


struct Frame {
    LAS unsigned char* lds;
    volatile LAS unsigned* MISC;
    gu32* ctl;
    int tid, lane, wave;
    int G;
};
__device__ __forceinline__ Frame fresh(const Frame& F) { Frame P = F; int t = F.tid; asm volatile("" : "+v"(t)); P.tid = t; P.lane = t & 63; return P; }
__device__ __forceinline__ float wave_sum(float v) {
#pragma unroll
    for (int o = 1; o < 64; o <<= 1) v += __shfl_xor(v, o);
    return v;
}
__device__ __forceinline__ void unpack8(const v4u w, float (&f)[8]) {
    f[0] = bflo(w.x); f[1] = bfhi(w.x); f[2] = bflo(w.y); f[3] = bfhi(w.y); f[4] = bflo(w.z); f[5] = bfhi(w.z); f[6] = bflo(w.w); f[7] = bfhi(w.w);
}
__device__ __forceinline__ v4u pack8f(const float (&f)[8]) { v4u w; w.x = pk2(f[0], f[1]); w.y = pk2(f[2], f[3]); w.z = pk2(f[4], f[5]); w.w = pk2(f[6], f[7]); return w; }

__device__ __forceinline__ void conv_item(const float* W, int N, bf16* WT, int KD, int k0, int n0, int drow0, LAS float* scr, int lane) {
#pragma unroll 8
    for (int i = 0; i < 32; ++i) { const int kk = 2 * i + (lane >> 5); scr[kk * 33 + (lane & 31)] = W[(size_t)(k0 + kk) * N + n0 + (lane & 31)]; }
    LDS_WAIT(); asm volatile("" ::: "memory");
    const int c = lane & 7;
#pragma unroll
    for (int j = 0; j < 4; ++j) { const int n = (lane >> 3) + 8 * j; const LAS float* s = scr + (8 * c) * 33 + n;
        v4u o; o.x = pk2(s[0 * 33], s[1 * 33]); o.y = pk2(s[2 * 33], s[3 * 33]); o.z = pk2(s[4 * 33], s[5 * 33]); o.w = pk2(s[6 * 33], s[7 * 33]);
        *(GAS v4u*)(WT + (size_t)(drow0 + n) * KD + k0 + 8 * c) = o; }
    LDS_WAIT(); asm volatile("" ::: "memory");
}
__device__ __forceinline__ int map_pair(int n0, int half) { return n0 < half ? ((n0 >> 7) * 256 + (n0 & 127)) : ((((n0 - half) >> 7) * 256) + 128 + ((n0 - half) & 127)); }
__device__ __forceinline__ int map_scin(int n0) { return n0 < DM ? (2 * DM + n0) : map_pair(n0 - DM, DM); }

struct Args { const float* in[32]; float* out; unsigned char* ws; int ph_lo, ph_hi; };

__device__ __forceinline__ void p0_prologue(Frame& F, const Args& A) {
    unsigned char* ws = A.ws;
    LAS float* scr = (LAS float*)(F.lds + F.wave * 16384);
    const int gw = blockIdx.x * NWAVES + F.wave, NGW = F.G * NWAVES, lane = F.lane;
    constexpr int I_GU = (DM / 64) * (NGU / 32), I_D = (FF / 64) * (DM / 32), I_3 = (DM / 64) * (3 * DM / 32), I_SQ = (DM / 64) * (DM / 32);
    constexpr int I_MD = (DM / 64) * (MDN / 32), I_UQ = (QR / 64) * (QW / 32), I_UKV = (KVR / 64) * (KVW / 32), I_W4 = 8192 / 32;
    constexpr int NITEMS = 4 * I_GU + 4 * I_D + 2 * I_3 + 2 * I_SQ + I_MD + I_UQ + I_UKV + I_SQ + I_3 + I_SQ + I_W4;
    for (int it = gw; it < NITEMS; it += NGW) {
        int r = it;
        if (r < 4 * I_GU) { const int L = r / I_GU, rr = r % I_GU, nblk = NGU / 32, kb = rr / nblk, n0 = (rr % nblk) * 32;
            conv_item(A.in[8] + (size_t)L * DM * NGU, NGU, (bf16*)(ws + WS_WGU + L * SZ_WGU), DM, kb * 64, n0, map_pair(n0, FF), scr, lane); continue; } r -= 4 * I_GU;
        if (r < 4 * I_D) { const int L = r / I_D, rr = r % I_D, nblk = DM / 32, kb = rr / nblk, n0 = (rr % nblk) * 32;
            conv_item(A.in[9] + (size_t)L * FF * DM, DM, (bf16*)(ws + WS_WD + L * SZ_WD), FFP, kb * 64, n0, n0, scr, lane); continue; } r -= 4 * I_D;
        if (r < 2 * I_3) { const int L = r / I_3, rr = r % I_3, nblk = 3 * DM / 32, kb = rr / nblk, n0 = (rr % nblk) * 32;
            conv_item(A.in[10] + (size_t)L * DM * 3 * DM, 3 * DM, (bf16*)(ws + WS_SCIN + L * SZ_W3), DM, kb * 64, n0, map_scin(n0), scr, lane); continue; } r -= 2 * I_3;
        if (r < 2 * I_SQ) { const int L = r / I_SQ, rr = r % I_SQ, nblk = DM / 32, kb = rr / nblk, n0 = (rr % nblk) * 32;
            conv_item(A.in[12] + (size_t)L * DM * DM, DM, (bf16*)(ws + WS_SCOUT + L * SZ_SQ), DM, kb * 64, n0, n0, scr, lane); continue; } r -= 2 * I_SQ;
        if (r < I_MD) { const int nblk = MDN / 32, kb = r / nblk, n0 = (r % nblk) * 32;
            conv_item(A.in[13], MDN, (bf16*)(ws + WS_MDOWN), DM, kb * 64, n0, n0, scr, lane); continue; } r -= I_MD;
        if (r < I_UQ) { const int nblk = QW / 32, kb = r / nblk, n0 = (r % nblk) * 32;
            conv_item(A.in[16], QW, (bf16*)(ws + WS_MUQ), QR, kb * 64, n0, n0, scr, lane); continue; } r -= I_UQ;
        if (r < I_UKV) { const int nblk = KVW / 32, kb = r / nblk, n0 = (r % nblk) * 32;
            conv_item(A.in[17], KVW, (bf16*)(ws + WS_MUKV), KVR, kb * 64, n0, n0, scr, lane); continue; } r -= I_UKV;
        if (r < I_SQ) { const int nblk = DM / 32, kb = r / nblk, n0 = (r % nblk) * 32;
            conv_item(A.in[18], DM, (bf16*)(ws + WS_MOUT), DM, kb * 64, n0, n0, scr, lane); continue; } r -= I_SQ;
        if (r < I_3) { const int nblk = 3 * DM / 32, kb = r / nblk, n0 = (r % nblk) * 32;
            conv_item(A.in[19], 3 * DM, (bf16*)(ws + WS_HYIN), DM, kb * 64, n0, n0, scr, lane); continue; } r -= I_3;
        if (r < I_SQ) { const int nblk = DM / 32, kb = r / nblk, n0 = (r % nblk) * 32;
            conv_item(A.in[31], DM, (bf16*)(ws + WS_HYOUT), DM, kb * 64, n0, n0, scr, lane); continue; } r -= I_SQ;
        { const int n0 = r * 32; conv_item(A.in[29], 8192, (bf16*)(ws + WS_W4T), FHP, 0, n0, n0, scr, lane); }
    }
    const int gt = blockIdx.x * NTHR + F.tid, NGT = F.G * NTHR;
    { GAS v4u* z = (GAS v4u*)(ws + WS_MDOWN + (size_t)MDN * DM * 2); const int nz = (MDNP - MDN) * DM * 2 / 16;
      for (int i = gt; i < nz; i += NGT) z[i] = (v4u){0u, 0u, 0u, 0u}; }
    { const int nz = 8192 * 24;
      for (int i = gt; i < nz; i += NGT) { const int row = i / 24, ch = i % 24; *(GAS v4u*)(ws + WS_W4T + (size_t)row * FHP * 2 + 128 + ch * 16) = (v4u){0u, 0u, 0u, 0u}; } }
    { float* PART = (float*)(ws + WS_PART); const float* cl = A.in[1]; const float* cc = A.in[3];
      for (int it = blockIdx.x; it < 128; it += F.G) { const int L = it >> 5, kc = it & 31, j = F.tid & 255, kh = F.tid >> 8, k0 = kc * 128 + kh * 64;
          const float* wd = A.in[4] + (size_t)L * DM * ADA_R; float al = 0.f, ac = 0.f;
#pragma unroll 8
          for (int kk = 0; kk < 64; ++kk) { const int k = k0 + kk; const float w = wd[(size_t)k * ADA_R + j]; const float a = cl[k], b = cc[k];
              al += (a / (1.f + expf(-a))) * w; ac += (b / (1.f + expf(-b))) * w; }
          float* p = PART + ((size_t)(L * 64 + kc * 2 + kh) * 2) * 256 + j; p[0] = al; p[256] = ac; } }
    __syncthreads();
    { LAS float* W1 = (LAS float*)F.lds; LAS float* W2 = W1 + 33 * 64; LAS float* W3 = W2 + 4096;
      for (int i = F.tid; i < 33 * 64; i += NTHR) W1[i] = A.in[22][i];
      for (int i = F.tid; i < 4096; i += NTHR) { W2[i] = A.in[24][i]; W3[i] = A.in[26][i]; }
      __syncthreads();
      const float b1 = A.in[23][lane], b2 = A.in[25][lane], b3 = A.in[27][lane], f0 = A.in[28][lane], f1 = A.in[28][64 + lane], f2 = A.in[28][128 + lane];
      bf16* HD3 = (bf16*)(ws + WS_HD3);
      const float bstep = (15.0f - 1e-4f) / 15.0f;
      for (int p = gw; p < SEQ; p += NGW) {
          const float tl = (float)p * (1.0f / 16383.0f), w = (float)p * (6.283185307179586f / 16384.0f);
          float z = 0.f;
          if (lane == 0) z = tl; else if (lane <= 16) z = cosf((1e-4f + (float)(lane - 1) * bstep) * w); else if (lane <= 32) z = -sinf((1e-4f + (float)(lane - 17) * bstep) * w);
          float a = b1;
#pragma unroll
          for (int i = 0; i < 33; ++i) a += __uint_as_float(__builtin_amdgcn_readlane(__float_as_uint(z), i)) * W1[i * 64 + lane];
          const float h1 = sinf(f0 * a); a = b2;
#pragma unroll
          for (int i = 0; i < 64; ++i) a += __uint_as_float(__builtin_amdgcn_readlane(__float_as_uint(h1), i)) * W2[i * 64 + lane];
          const float h2 = sinf(f1 * a); a = b3;
#pragma unroll
          for (int i = 0; i < 64; ++i) a += __uint_as_float(__builtin_amdgcn_readlane(__float_as_uint(h2), i)) * W3[i * 64 + lane];
          const float h3 = sinf(f2 * a);
          bf16* o = HD3 + (size_t)p * FHP + lane; o[0] = (bf16)(pk2(h3, 0.f) & 0xffffu); o[64] = 0; o[128] = 0; o[192] = 0; }
    }
}
__device__ __forceinline__ void p1_adaln(Frame& F, const Args& A) {
    LAS float* Tl = (LAS float*)F.lds; const float* PART = (const float*)(A.ws + WS_PART); float* MOD = (float*)(A.ws + WS_MOD);
    for (int it = blockIdx.x; it < DEPTH * 2 * 48; it += F.G) { const int L = it / 96, rem = it % 96, r = rem / 48, col = (rem % 48) * 512 + F.tid;
        __syncthreads(); if (F.tid < 256) { float t = 0.f; for (int i = 0; i < 64; ++i) t += PART[((size_t)(L * 64 + i) * 2 + r) * 256 + F.tid]; Tl[F.tid] = t; } __syncthreads();
        const float* up = A.in[5] + (size_t)L * ADA_R * MODW + col; float a = A.in[6][L * MODW + col];
#pragma unroll 8
        for (int j = 0; j < ADA_R; ++j) a += Tl[j] * up[(size_t)j * MODW];
        MOD[(size_t)(L * 2 + r) * MODW + col] = a; }
}
template <bool HAS_Y, bool HAS_H, int XS, int XD>
__device__ __forceinline__ void row_phase(Frame& F, int row_lo, int row_hi, int bid, int nb, const void* xs_l, const void* xs_c, void* xd_l, void* xd_c, const bf16* Y,
                                          const float* gate_l, const float* gate_c, const float* gy, bf16* HB, const float* gh,
                                          const float* shift_l, const float* shift_c, const float* scale_l, const float* scale_c) {
    const int gw = bid * NWAVES + F.wave, NGW = nb * NWAVES;
    LAS float* const LV = (LAS float*)F.lds;
    __syncthreads();
    for (int i = F.tid; i < 2 * 1024; i += NTHR) { const int r = i >> 10, c4 = (i & 1023) * 4;
        if (r == 0 ? (row_lo < SEQ) : (row_hi > SEQ)) {
            if (HAS_Y) { const f32x4 g = *(const GAS f32x4*)((r ? gate_c : gate_l) + c4), gg = *(const GAS f32x4*)(gy + c4); *(LAS f32x4*)(LV + (0 + r) * DM + c4) = g * gg; }
            if (HAS_H) { const f32x4 g = *(const GAS f32x4*)(gh + c4), s1 = *(const GAS f32x4*)((r ? scale_c : scale_l) + c4), s0 = *(const GAS f32x4*)((r ? shift_c : shift_l) + c4);
                *(LAS f32x4*)(LV + (2 + r) * DM + c4) = g * (s1 + 1.0f); *(LAS f32x4*)(LV + (4 + r) * DM + c4) = s0; } } }
    __syncthreads();
#define ROW_FENCE(j) do { if (((j) & 3) == 3) asm volatile("" ::: "memory"); } while (0)
    for (int row = row_lo + gw; row < row_hi; row += NGW) {
        int lane_ = F.lane; asm volatile("" : "+v"(lane_)); const int lane = lane_;
        const bool isc = row >= SEQ;
        const bf16* yr = Y + (size_t)row * DM;
        float rn = 0.f;
        v2u yk[16], xk[16];
        const bf16* xsb0 = (const bf16*)xs_l + (size_t)row * DM;
        if (HAS_Y) { float ss = 0.f;
#pragma unroll
            for (int j = 0; j < 16; ++j) { const v2u w = *(const GAS v2u*)(yr + 256 * j + 4 * lane); yk[j] = w; if (XS == 1) xk[j] = *(const GAS v2u*)(xsb0 + 256 * j + 4 * lane);
                const float a = bflo(w.x), b = bfhi(w.x), c = bflo(w.y), d = bfhi(w.y); ss += (a * a + b * b) + (c * c + d * d); ROW_FENCE(j); }
            rn = rsqrtf(wave_sum(ss) * (1.0f / DM) + EPS); }
        f32x4 xv[16]; float ssx = 0.f;
        const float* xsf = (const float*)(isc ? xs_c : xs_l) + (isc ? (size_t)(row - SEQ) * DM : (size_t)row * DM); const bf16* xsb = (const bf16*)xs_l + (size_t)row * DM;
        const LAS float* lv = LV + (isc ? DM : 0) + 4 * lane;
        bf16* xdb = (bf16*)xd_l + (size_t)row * DM; float* xdf = (float*)(isc ? xd_c : xd_l) + (isc ? (size_t)(row - SEQ) * DM : (size_t)row * DM);
#pragma unroll
        for (int j = 0; j < 16; ++j) {
            f32x4 x;
            if (XS == 0) x = *(const GAS f32x4*)(xsf + 256 * j + 4 * lane);
            else { const v2u w = HAS_Y ? xk[j] : *(const GAS v2u*)(xsb + 256 * j + 4 * lane); x = (f32x4){bflo(w.x), bfhi(w.x), bflo(w.y), bfhi(w.y)}; }
            if (HAS_Y) { const v2u w = yk[j]; const f32x4 yv = (f32x4){bflo(w.x), bfhi(w.x), bflo(w.y), bfhi(w.y)};
                const f32x4 v1 = *(const LAS f32x4*)(lv + 256 * j);
                x = x + (yv * rn) * v1; }
            if (XD == 1) { v2u o; o.x = pk2(x.x, x.y); o.y = pk2(x.z, x.w); *(GAS v2u*)(xdb + 256 * j + 4 * lane) = o; }
            else if (XD == 2) *(GAS f32x4*)(xdf + 256 * j + 4 * lane) = x;
            ssx += (x.x * x.x + x.y * x.y) + (x.z * x.z + x.w * x.w); xv[j] = x; ROW_FENCE(j);
        }
        if (HAS_H) {
            const float rh = rsqrtf(wave_sum(ssx) * (1.0f / DM) + EPS);
            bf16* hr = HB + (size_t)row * DM;
#pragma unroll
            for (int j = 0; j < 16; ++j) { const f32x4 v2 = *(const LAS f32x4*)(lv + 2 * DM + 256 * j), v3 = *(const LAS f32x4*)(lv + 4 * DM + 256 * j);
                const f32x4 h = (xv[j] * rh) * v2 + v3; v2u o; o.x = pk2(h.x, h.y); o.y = pk2(h.z, h.w);
                *(GAS v2u*)(hr + 256 * j + 4 * lane) = o; ROW_FENCE(j); }
        }
    }
#undef ROW_FENCE
}
__device__ __forceinline__ void sc_conv_phase(Frame& F, int row_lo, int row_hi, int bid, int nb, const bf16* P, const bf16* Bq, const float* wc, bf16* Z) {
    const int gw = bid * NWAVES + F.wave, NGW = nb * NWAVES, lane = F.lane; const int items = ((row_hi - row_lo) / 32) * 8;
    for (int it = gw; it < items; it += NGW) { const int r0 = row_lo + (it >> 3) * 32, c0 = (it & 7) * 512 + lane * 8;
        const int seg_lo = r0 < SEQ ? 0 : SEQ, seg_hi = r0 < SEQ ? SEQ : MT;
        float w0[8], w1[8], w2[8];
        { const f32x4 a = *(const f32x4*)(wc + c0), b = *(const f32x4*)(wc + c0 + 4); w0[0] = a.x; w0[1] = a.y; w0[2] = a.z; w0[3] = a.w; w0[4] = b.x; w0[5] = b.y; w0[6] = b.z; w0[7] = b.w; }
        { const f32x4 a = *(const f32x4*)(wc + DM + c0), b = *(const f32x4*)(wc + DM + c0 + 4); w1[0] = a.x; w1[1] = a.y; w1[2] = a.z; w1[3] = a.w; w1[4] = b.x; w1[5] = b.y; w1[6] = b.z; w1[7] = b.w; }
        { const f32x4 a = *(const f32x4*)(wc + 2 * DM + c0), b = *(const f32x4*)(wc + 2 * DM + c0 + 4); w2[0] = a.x; w2[1] = a.y; w2[2] = a.z; w2[3] = a.w; w2[4] = b.x; w2[5] = b.y; w2[6] = b.z; w2[7] = b.w; }
        float pv[8], cu[8], nx[8], bq[8], o[8];
        if (r0 == seg_lo) {
#pragma unroll
            for (int e = 0; e < 8; ++e) pv[e] = 0.f;
        } else unpack8(*(const GAS v4u*)(P + (size_t)(r0 - 1) * DM + c0), pv);
        unpack8(*(const GAS v4u*)(P + (size_t)r0 * DM + c0), cu);
        v4u pa[8], ba[8], pb[8], bb[8];
#define SC_LOAD(RS, PN, BV) do { _Pragma("unroll") for (int i = 0; i < 8; ++i) { const int r = (RS) + i; PN[i] = (v4u){0u, 0u, 0u, 0u}; \
            if (r + 1 < seg_hi) PN[i] = *(const GAS v4u*)(P + (size_t)(r + 1) * DM + c0); BV[i] = *(const GAS v4u*)(Bq + (size_t)r * DM + c0); } asm volatile("" ::: "memory"); } while (0)
#define SC_COMP(RS, PN, BV) do { _Pragma("unroll") for (int i = 0; i < 8; ++i) { unpack8(PN[i], nx); unpack8(BV[i], bq); \
            _Pragma("unroll") for (int e = 0; e < 8; ++e) { o[e] = bq[e] * (w0[e] * pv[e] + w1[e] * cu[e] + w2[e] * nx[e]); pv[e] = cu[e]; cu[e] = nx[e]; } \
            *(GAS v4u*)(Z + (size_t)((RS) + i) * DM + c0) = pack8f(o); } } while (0)
        SC_LOAD(r0, pa, ba);
        SC_LOAD(r0 + 8, pb, bb);  SC_COMP(r0, pa, ba);
        SC_LOAD(r0 + 16, pa, ba); SC_COMP(r0 + 8, pb, bb);
        SC_LOAD(r0 + 24, pb, bb); SC_COMP(r0 + 16, pa, ba);
        SC_COMP(r0 + 24, pb, bb);
#undef SC_LOAD
#undef SC_COMP
    }
}
__device__ __forceinline__ void mla_row_phase(Frame& F, const float* D, const float* qn, const float* kvn, bf16* CQN, bf16* CKVN, bf16* KR) {
    const int gw = blockIdx.x * NWAVES + F.wave, NGW = F.G * NWAVES, lane = F.lane;
    for (int row = gw; row < MT; row += NGW) { const float* d = D + (size_t)row * MDNP;
        f32x4 q[4]; float ss = 0.f;
#pragma unroll
        for (int j = 0; j < 4; ++j) { q[j] = *(const GAS f32x4*)(d + 256 * j + 4 * lane); ss += (q[j].x * q[j].x + q[j].y * q[j].y) + (q[j].z * q[j].z + q[j].w * q[j].w); }
        const float rq = rsqrtf(wave_sum(ss) * (1.0f / QR) + EPS);
#pragma unroll
        for (int j = 0; j < 4; ++j) { const f32x4 g = *(const f32x4*)(qn + 256 * j + 4 * lane); const f32x4 h = (q[j] * rq) * g; v2u o; o.x = pk2(h.x, h.y); o.y = pk2(h.z, h.w);
            *(GAS v2u*)(CQN + (size_t)row * QR + 256 * j + 4 * lane) = o; }
        f32x4 k[2]; ss = 0.f;
#pragma unroll
        for (int j = 0; j < 2; ++j) { k[j] = *(const GAS f32x4*)(d + QR + 256 * j + 4 * lane); ss += (k[j].x * k[j].x + k[j].y * k[j].y) + (k[j].z * k[j].z + k[j].w * k[j].w); }
        const float rk = rsqrtf(wave_sum(ss) * (1.0f / KVR) + EPS);
#pragma unroll
        for (int j = 0; j < 2; ++j) { const f32x4 g = *(const f32x4*)(kvn + 256 * j + 4 * lane); const f32x4 h = (k[j] * rk) * g; v2u o; o.x = pk2(h.x, h.y); o.y = pk2(h.z, h.w);
            *(GAS v2u*)(CKVN + (size_t)row * KVR + 256 * j + 4 * lane) = o; }
        const float v = *(const GAS float*)(d + QR + KVR + lane); const float pt = __shfl_xor(v, 16); float out = v;
        if (row < SEQ) { const int i = lane & 15; const float pos = (float)((lane < 32) ? (row >> 6) : (row & 63));
            const float ang = pos * exp2f(-(float)i * 0.83048202372184059f); const float cs = cosf(ang), sn = sinf(ang);
            out = (lane & 16) ? (v * cs + pt * sn) : (v * cs - pt * sn); }
        KR[(size_t)row * ROPE + lane] = (bf16)(pk2(out, 0.f) & 0xffffu);
    }
}

namespace att {
using bf16x8 = __attribute__((ext_vector_type(8))) short;
using s16x4  = __attribute__((ext_vector_type(4))) short;
using f32x16 = __attribute__((ext_vector_type(16))) float;
using u32x4  = __attribute__((ext_vector_type(4))) unsigned;
constexpr int NW = 8, QBLK = 32, KVBLK = 64;
constexpr float SCALE_DEF = 0.07216878364870322f, SCALE = SCALE_DEF;
constexpr float THR = 8.f;
#ifndef ATT_AUG
#define ATT_AUG 1
#endif
constexpr bool ATT_AUG_ON = (ATT_AUG != 0);
constexpr float QC = SCALE_DEF * 1.4426950408889634f;
#ifndef ATT_SDEPTH
#define ATT_SDEPTH 1
#endif
constexpr int SDEPTH = ATT_SDEPTH;
constexpr int LDQ = 6144, LDK = 8192, LDR = 64, LDO = 4096;
constexpr int SHM_V = KVBLK * 128 * 2, SHM_K = KVBLK * 128 * 2, SHM_R = KVBLK * 64 * 2;
#ifndef ATT_NBUF
#define ATT_NBUF 3
#endif
constexpr int NBUF = ATT_NBUF;
static_assert(NBUF == 2 || (NBUF == 3 && SDEPTH == 1), "3 buffers use the single staging slot");
constexpr int OFF_V = 0, OFF_K = NBUF * SHM_V, OFF_R = OFF_K + NBUF * SHM_K, OFF_WS = OFF_R + NBUF * SHM_R, OFF_QR = OFF_WS + NW * 64 * 4, LDS_NEED = OFF_QR + NW * 4096;
#define KSWZ(row, colB) ((row) * 256 + ((colB) ^ (((row) & 15) << 4)))
#define RSWZ(row, colB) ((row) * 128 + ((colB) ^ ((((row) >> 1) & 7) << 4)))
#define SBAR() __builtin_amdgcn_sched_barrier(0)
__device__ __forceinline__ int crow(int r, int hi) { return (r & 3) + 8 * (r >> 2) + 4 * hi; }
__device__ __forceinline__ unsigned cvtpk(float lo, float hi) { unsigned r; asm volatile("v_cvt_pk_bf16_f32 %0, %1, %2" : "=v"(r) : "v"(lo), "v"(hi)); return r; }
__device__ __forceinline__ bf16x8 ld8(const unsigned short* p) { return *reinterpret_cast<const bf16x8*>(p); }

__device__ __forceinline__ void partialSM(f32x16& p0, f32x16& p1, float& m_reg, float& mn, float& alpha) {
  constexpr float C = SCALE * 1.4426950408889634f;
  float pmax = p0[0]; for (int r = 1; r < 16; ++r) pmax = fmaxf(pmax, p0[r]); for (int r = 0; r < 16; ++r) pmax = fmaxf(pmax, p1[r]);
  { auto rr = __builtin_amdgcn_permlane32_swap(__float_as_uint(pmax), __float_as_uint(pmax), false, false);
    pmax = fmaxf(__uint_as_float(rr[0]), __uint_as_float(rr[1])); }
  if (__builtin_expect(__all(pmax - m_reg <= THR / SCALE), 1)) { mn = m_reg; alpha = 1.f; }
  else { mn = fmaxf(m_reg, pmax); alpha = __builtin_amdgcn_exp2f((m_reg - mn) * C); m_reg = mn; }
  float mnC = -mn * C;
  for (int r = 0; r < 16; ++r) p0[r] = fmaf(p0[r], C, mnC); for (int r = 0; r < 16; ++r) p1[r] = fmaf(p1[r], C, mnC);
  for (int r = 0; r < 16; ++r) p0[r] = __builtin_amdgcn_exp2f(p0[r]);
}
__device__ __forceinline__ void finishSM(f32x16& p0, f32x16& p1, float alpha, float& l_reg, bf16x8& pa0, bf16x8& pa1, bf16x8& pa2, bf16x8& pa3) {
  for (int r = 0; r < 16; ++r) p1[r] = __builtin_amdgcn_exp2f(p1[r]);
  float ps = 0; for (int r = 0; r < 16; ++r) ps += p0[r]; for (int r = 0; r < 16; ++r) ps += p1[r];
  { auto rr = __builtin_amdgcn_permlane32_swap(__float_as_uint(ps), __float_as_uint(ps), false, false);
    ps = __uint_as_float(rr[0]) + __uint_as_float(rr[1]); }
  l_reg = l_reg * alpha + ps;
#define PK4(P, BASE, OUT) do { unsigned a0 = cvtpk(P[BASE + 0], P[BASE + 1]), a1 = cvtpk(P[BASE + 2], P[BASE + 3]);   \
    unsigned b0 = cvtpk(P[BASE + 4], P[BASE + 5]), b1 = cvtpk(P[BASE + 6], P[BASE + 7]);                              \
    auto r0 = __builtin_amdgcn_permlane32_swap(a0, b0, false, false); auto r1 = __builtin_amdgcn_permlane32_swap(a1, b1, false, false); \
    u32x4 w = {r0[0], r1[0], r0[1], r1[1]}; OUT = *reinterpret_cast<bf16x8*>(&w); } while (0)
  PK4(p0, 0, pa0); PK4(p0, 8, pa1); PK4(p1, 0, pa2); PK4(p1, 8, pa3);
#undef PK4
}
__device__ __forceinline__ void qkt(f32x16& p0, f32x16& p1, const char* Ks, const char* Rs, const bf16x8* qr, const char* Qf, int r32, int hi) {
  p0 = f32x16{}; p1 = f32x16{};
#pragma unroll
  for (int d0 = 0; d0 < 8; ++d0) { int cb = (d0 * 16 + hi * 8) * 2;
    bf16x8 b0 = *reinterpret_cast<const bf16x8*>(Ks + KSWZ(r32, cb));
    bf16x8 b1 = *reinterpret_cast<const bf16x8*>(Ks + KSWZ(32 + r32, cb));
    p0 = __builtin_amdgcn_mfma_f32_32x32x16_bf16(b0, qr[d0], p0, 0, 0, 0);
    p1 = __builtin_amdgcn_mfma_f32_32x32x16_bf16(b1, qr[d0], p1, 0, 0, 0); }
#pragma unroll
  for (int d0 = 0; d0 < 4; ++d0) { int cb = (d0 * 16 + hi * 8) * 2;
    bf16x8 b0 = *reinterpret_cast<const bf16x8*>(Rs + RSWZ(r32, cb));
    bf16x8 b1 = *reinterpret_cast<const bf16x8*>(Rs + RSWZ(32 + r32, cb));
    bf16x8 qf = *reinterpret_cast<const bf16x8*>(Qf + d0 * 1024);
    p0 = __builtin_amdgcn_mfma_f32_32x32x16_bf16(b0, qf, p0, 0, 0, 0);
    p1 = __builtin_amdgcn_mfma_f32_32x32x16_bf16(b1, qf, p1, 0, 0, 0); }
}
template <int D0> __device__ __forceinline__ void kld_pp(bf16x8& a0, bf16x8& a1, bf16x8& qf, const char* Ks, const char* Rs, const char* Qf, int r32, int hi) {
  if constexpr (D0 < 8) { const int cb = (D0 * 16 + hi * 8) * 2; a0 = *reinterpret_cast<const bf16x8*>(Ks + KSWZ(r32, cb)); a1 = *reinterpret_cast<const bf16x8*>(Ks + KSWZ(32 + r32, cb)); }
  else { const int cb = ((D0 - 8) * 16 + hi * 8) * 2; a0 = *reinterpret_cast<const bf16x8*>(Rs + RSWZ(r32, cb)); a1 = *reinterpret_cast<const bf16x8*>(Rs + RSWZ(32 + r32, cb));
         qf = *reinterpret_cast<const bf16x8*>(Qf + (D0 - 8) * 1024); }
}
__device__ __forceinline__ void qkt_pp(f32x16& p0, f32x16& p1, const char* Ks, const char* Rs, const bf16x8* qr, const char* Qf, int r32, int hi) {
  p0 = f32x16{}; p1 = f32x16{};
  bf16x8 xa0, xa1, xq, ya0, ya1, yq, za0, za1, zq;
  kld_pp<0>(xa0, xa1, xq, Ks, Rs, Qf, r32, hi); kld_pp<1>(ya0, ya1, yq, Ks, Rs, Qf, r32, hi);
  __builtin_amdgcn_sched_group_barrier(0x100, 4, 0);
#define QK_STEP(D0, A0, A1, Q, NA0, NA1, NQ) do { if constexpr ((D0) + 2 < 12) kld_pp<(D0) + 2>(NA0, NA1, NQ, Ks, Rs, Qf, r32, hi); \
    { const bf16x8 bq_ = (D0) < 8 ? qr[(D0) < 8 ? (D0) : 0] : Q; p0 = __builtin_amdgcn_mfma_f32_32x32x16_bf16(A0, bq_, p0, 0, 0, 0); p1 = __builtin_amdgcn_mfma_f32_32x32x16_bf16(A1, bq_, p1, 0, 0, 0); } \
    if constexpr ((D0) + 2 < 8) __builtin_amdgcn_sched_group_barrier(0x100, 2, 0); else if constexpr ((D0) + 2 < 12) __builtin_amdgcn_sched_group_barrier(0x100, 3, 0); \
    __builtin_amdgcn_sched_group_barrier(0x8, 2, 0); } while (0)
  QK_STEP(0, xa0, xa1, xq, za0, za1, zq); QK_STEP(1, ya0, ya1, yq, xa0, xa1, xq); QK_STEP(2, za0, za1, zq, ya0, ya1, yq);
  QK_STEP(3, xa0, xa1, xq, za0, za1, zq); QK_STEP(4, ya0, ya1, yq, xa0, xa1, xq); QK_STEP(5, za0, za1, zq, ya0, ya1, yq);
  QK_STEP(6, xa0, xa1, xq, za0, za1, zq); QK_STEP(7, ya0, ya1, yq, xa0, xa1, xq); QK_STEP(8, za0, za1, zq, ya0, ya1, yq);
  QK_STEP(9, xa0, xa1, xq, za0, za1, zq); QK_STEP(10, ya0, ya1, yq, xa0, xa1, xq); QK_STEP(11, za0, za1, zq, ya0, ya1, yq);
#undef QK_STEP
}
template <int D0> __device__ __forceinline__ void kld_pr(bf16x8& a0, bf16x8& a1, const char* Ks, const char* Rs, int r32, int hi) {
  if constexpr (D0 < 8) { const int cb = (D0 * 16 + hi * 8) * 2; a0 = *reinterpret_cast<const bf16x8*>(Ks + KSWZ(r32, cb)); a1 = *reinterpret_cast<const bf16x8*>(Ks + KSWZ(32 + r32, cb)); }
  else { const int cb = ((D0 - 8) * 16 + hi * 8) * 2; a0 = *reinterpret_cast<const bf16x8*>(Rs + RSWZ(r32, cb)); a1 = *reinterpret_cast<const bf16x8*>(Rs + RSWZ(32 + r32, cb)); }
}
__device__ __forceinline__ void qkt_pr(f32x16& p0, f32x16& p1, const char* Ks, const char* Rs, const bf16x8* qr, int r32, int hi) {
  p0 = f32x16{}; p1 = f32x16{};
  bf16x8 xa0, xa1, ya0, ya1, za0, za1;
  kld_pr<0>(xa0, xa1, Ks, Rs, r32, hi); kld_pr<1>(ya0, ya1, Ks, Rs, r32, hi);
  __builtin_amdgcn_sched_group_barrier(0x100, 4, 0);
#define QK_STEP(D0, A0, A1, NA0, NA1) do { if constexpr ((D0) + 2 < 12) kld_pr<(D0) + 2>(NA0, NA1, Ks, Rs, r32, hi); \
    p0 = __builtin_amdgcn_mfma_f32_32x32x16_bf16(A0, qr[D0], p0, 0, 0, 0); p1 = __builtin_amdgcn_mfma_f32_32x32x16_bf16(A1, qr[D0], p1, 0, 0, 0); \
    if constexpr ((D0) + 2 < 12) __builtin_amdgcn_sched_group_barrier(0x100, 2, 0); \
    __builtin_amdgcn_sched_group_barrier(0x8, 2, 0); } while (0)
  QK_STEP(0, xa0, xa1, za0, za1); QK_STEP(1, ya0, ya1, xa0, xa1); QK_STEP(2, za0, za1, ya0, ya1);
  QK_STEP(3, xa0, xa1, za0, za1); QK_STEP(4, ya0, ya1, xa0, xa1); QK_STEP(5, za0, za1, ya0, ya1);
  QK_STEP(6, xa0, xa1, za0, za1); QK_STEP(7, ya0, ya1, xa0, xa1); QK_STEP(8, za0, za1, ya0, ya1);
  QK_STEP(9, xa0, xa1, za0, za1); QK_STEP(10, ya0, ya1, xa0, xa1); QK_STEP(11, za0, za1, ya0, ya1);
#undef QK_STEP
}
__device__ __forceinline__ void qkt_aug(f32x16& p0, f32x16& p1, const char* Ks, const char* Rs, const bf16x8* qr, bf16x8 kone, bf16x8 qx, int r32, int hi) {
  p0 = __builtin_amdgcn_mfma_f32_32x32x16_bf16(kone, qx, f32x16{}, 0, 0, 0); p1 = __builtin_amdgcn_mfma_f32_32x32x16_bf16(kone, qx, f32x16{}, 0, 0, 0);
  bf16x8 xa0, xa1, ya0, ya1, za0, za1;
  kld_pr<0>(xa0, xa1, Ks, Rs, r32, hi); kld_pr<1>(ya0, ya1, Ks, Rs, r32, hi);
  __builtin_amdgcn_sched_group_barrier(0x100, 4, 0);
#define QK_STEP(D0, A0, A1, NA0, NA1) do { if constexpr ((D0) + 2 < 12) kld_pr<(D0) + 2>(NA0, NA1, Ks, Rs, r32, hi); \
    p0 = __builtin_amdgcn_mfma_f32_32x32x16_bf16(A0, qr[D0], p0, 0, 0, 0); p1 = __builtin_amdgcn_mfma_f32_32x32x16_bf16(A1, qr[D0], p1, 0, 0, 0); \
    if constexpr ((D0) + 2 < 12) __builtin_amdgcn_sched_group_barrier(0x100, 2, 0); \
    __builtin_amdgcn_sched_group_barrier(0x8, 2, 0); } while (0)
  QK_STEP(0, xa0, xa1, za0, za1); QK_STEP(1, ya0, ya1, xa0, xa1); QK_STEP(2, za0, za1, ya0, ya1);
  QK_STEP(3, xa0, xa1, za0, za1); QK_STEP(4, ya0, ya1, xa0, xa1); QK_STEP(5, za0, za1, ya0, ya1);
  QK_STEP(6, xa0, xa1, za0, za1); QK_STEP(7, ya0, ya1, xa0, xa1); QK_STEP(8, za0, za1, ya0, ya1);
  QK_STEP(9, xa0, xa1, za0, za1); QK_STEP(10, ya0, ya1, xa0, xa1); QK_STEP(11, za0, za1, ya0, ya1);
#undef QK_STEP
}
__device__ __forceinline__ void partialSM_aug(f32x16& p0, f32x16& p1, float& mq, float& alpha, bf16x8& qx, int hi, bool first) {
  constexpr float THR2 = THR * 1.4426950408889634f;
  float pmax = p0[0]; for (int r = 1; r < 16; ++r) pmax = fmaxf(pmax, p0[r]); for (int r = 0; r < 16; ++r) pmax = fmaxf(pmax, p1[r]);
  { auto rr = __builtin_amdgcn_permlane32_swap(__float_as_uint(pmax), __float_as_uint(pmax), false, false);
    pmax = fmaxf(__uint_as_float(rr[0]), __uint_as_float(rr[1])); }
  if (__builtin_expect(!first && __all(pmax <= THR2), 1)) { alpha = 1.f; }
  else { const float d = first ? pmax : fmaxf(pmax, 0.f);
    const float mnew = __uint_as_float(cvtpk(mq + d, 0.f) << 16); const float dr = mnew - mq; alpha = first ? 1.f : __builtin_amdgcn_exp2f(-dr); mq = mnew;
    for (int r = 0; r < 16; ++r) { p0[r] -= dr; p1[r] -= dr; }
    qx[0] = (hi == 0) ? (short)(cvtpk(-mq, 0.f) & 0xffffu) : (short)0; }
  for (int r = 0; r < 16; ++r) p0[r] = __builtin_amdgcn_exp2f(p0[r]);
}
__device__ __forceinline__ int v_st(int k, int c) { const int kk = (k & ~0xC) | ((k & 4) << 1) | ((k & 8) >> 1); return ((kk >> 3) * 4 + (c >> 5)) * 512 + ((kk & 7) * 32 + (c & 31)) * 2; }
__device__ __forceinline__ int v_rd_base(int lane) { return ((lane & 3) << 3) | (((lane >> 2) & 3) << 6) | (((lane >> 4) & 1) << 5) | (((lane >> 5) & 1) << 8); }
constexpr int v_rd_off(int d0, int ks, int half) { return d0 * 512 + ks * 4096 + half * 2048; }
template <int OFF> __device__ __forceinline__ s16x4 tr_read(int vb) {
  s16x4 r; asm volatile("ds_read_b64_tr_b16 %0, %1 offset:%2" : "=&v"(r) : "v"(vb), "i"(OFF) : "memory"); return r;
}
template <int D0> __device__ __forceinline__ void pv_one(f32x16& od, int vb, bf16x8 pa0, bf16x8 pa1, bf16x8 pa2, bf16x8 pa3) {
  const s16x4 l0 = tr_read<v_rd_off(D0, 0, 0)>(vb), h0 = tr_read<v_rd_off(D0, 0, 1)>(vb), l1 = tr_read<v_rd_off(D0, 1, 0)>(vb), h1 = tr_read<v_rd_off(D0, 1, 1)>(vb);
  const s16x4 l2 = tr_read<v_rd_off(D0, 2, 0)>(vb), h2 = tr_read<v_rd_off(D0, 2, 1)>(vb), l3 = tr_read<v_rd_off(D0, 3, 0)>(vb), h3 = tr_read<v_rd_off(D0, 3, 1)>(vb);
  asm volatile("s_waitcnt lgkmcnt(0)" ::: "memory"); SBAR();
#define PK(L, H) (bf16x8){L[0], L[1], L[2], L[3], H[0], H[1], H[2], H[3]}
  od = __builtin_amdgcn_mfma_f32_32x32x16_bf16(pa0, PK(l0, h0), od, 0, 0, 0);
  od = __builtin_amdgcn_mfma_f32_32x32x16_bf16(pa1, PK(l1, h1), od, 0, 0, 0);
  od = __builtin_amdgcn_mfma_f32_32x32x16_bf16(pa2, PK(l2, h2), od, 0, 0, 0);
  od = __builtin_amdgcn_mfma_f32_32x32x16_bf16(pa3, PK(l3, h3), od, 0, 0, 0);
#undef PK
}
__device__ __forceinline__ void pv_d0(f32x16* o, int vb, bf16x8 pa0, bf16x8 pa1, bf16x8 pa2, bf16x8 pa3) {
  pv_one<0>(o[0], vb, pa0, pa1, pa2, pa3); pv_one<1>(o[1], vb, pa0, pa1, pa2, pa3); pv_one<2>(o[2], vb, pa0, pa1, pa2, pa3); pv_one<3>(o[3], vb, pa0, pa1, pa2, pa3);
}
__device__ __forceinline__ float bfv(short s) { return __uint_as_float(((unsigned)(unsigned short)s) << 16); }
__device__ __forceinline__ void attn_unit(const unsigned short* Qb, const unsigned short* Kn, const unsigned short* Vh, const unsigned short* Kr, unsigned short* Ob, int t0, int seq, char* lds) {
  int tid_ = threadIdx.x; asm volatile("" : "+v"(tid_));
  const int tid = tid_, wid = tid >> 6, lane = tid & 63, r32 = lane & 31, hi = lane >> 5;
  char* V_lds = lds + OFF_V; char* K_lds = lds + OFF_K; char* R_lds = lds + OFF_R;
  float* ws = (float*)(lds + OFF_WS) + wid * 64; float* li_l = ws; float* al_l = ws + 32;
  float m_reg = -1e30f, l_reg = 0; f32x16 o[4] = {}; bf16x8 qr[12];
  { const unsigned oq = (unsigned)((wid * QBLK + r32) * LDQ + hi * 8);
#pragma unroll
    for (int d0 = 0; d0 < 8; ++d0) { qr[d0] = ld8(Qb + (oq + d0 * 16));
      if constexpr (ATT_AUG_ON) { u32x4 w_;
#pragma unroll
        for (int e = 0; e < 4; ++e) w_[e] = cvtpk(bfv(qr[d0][2 * e]) * QC, bfv(qr[d0][2 * e + 1]) * QC);
        qr[d0] = *reinterpret_cast<bf16x8*>(&w_); } } }
  {
    const int row = tid >> 1, ax = tid & 1, t = t0 + row; const float pos = (float)(ax ? (t & 63) : (t >> 6));
    const unsigned oqp = (unsigned)(row * LDQ + 128 + 32 * ax);
    const bf16x8 xa0 = ld8(Qb + oqp), xa1 = ld8(Qb + (oqp + 8)), xb0 = ld8(Qb + (oqp + 16)), xb1 = ld8(Qb + (oqp + 24));
    unsigned oa[8], ob[8];
#pragma unroll
    for (int jj = 0; jj < 8; ++jj) { float r1[2], r2[2];
#pragma unroll
      for (int e = 0; e < 2; ++e) { const int i = 2 * jj + e; const float ang = pos * exp2f(-(float)i * 0.83048202372184059f); const float cs = __cosf(ang), sn = __sinf(ang);
        const float a = bfv(i < 8 ? xa0[i & 7] : xa1[i & 7]), b = bfv(i < 8 ? xb0[i & 7] : xb1[i & 7]); r1[e] = a * cs - b * sn; r2[e] = b * cs + a * sn; }
      if constexpr (ATT_AUG_ON) { r1[0] *= QC; r1[1] *= QC; r2[0] *= QC; r2[1] *= QC; }
      oa[jj] = cvtpk(r1[0], r1[1]); ob[jj] = cvtpk(r2[0], r2[1]); }
    char* qd = lds + OFF_QR + (row >> 5) * 4096 + (row & 31) * 16;
    *(u32x4*)(qd + (2 * ax) * 1024)           = (u32x4){oa[0], oa[1], oa[2], oa[3]};
    *(u32x4*)(qd + (2 * ax) * 1024 + 512)     = (u32x4){oa[4], oa[5], oa[6], oa[7]};
    *(u32x4*)(qd + (2 * ax + 1) * 1024)       = (u32x4){ob[0], ob[1], ob[2], ob[3]};
    *(u32x4*)(qd + (2 * ax + 1) * 1024 + 512) = (u32x4){ob[4], ob[5], ob[6], ob[7]}; }
  const char* Qf = lds + OFF_QR + wid * 4096 + lane * 16;
  const int sr = tid >> 4, sc = (tid & 15) * 8, vst0 = v_st(sr, sc), vst1 = v_st(32 + sr, sc);
  const int rr = tid >> 3, rc = (tid & 7) * 8;
  const int vb0 = (int)(uintptr_t)V_lds + v_rd_base(lane);
  struct { bf16x8 vs0, vs1, ks0, ks1, rs; } sr_[SDEPTH];
  unsigned okv0 = (unsigned)(sr * LDK + sc), okv1 = (unsigned)((32 + sr) * LDK + sc), okr = (unsigned)(rr * LDR + rc);
  asm volatile("" : "+v"(okv0), "+v"(okv1), "+v"(okr));
#define SLOAD(i, k0) do { const unsigned short* vt_ = Vh + (size_t)(k0) * LDK; const unsigned short* kt_ = Kn + (size_t)(k0) * LDK; const unsigned short* rt_ = Kr + (size_t)(k0) * LDR; \
    sr_[i].vs0 = ld8(vt_ + okv0); sr_[i].vs1 = ld8(vt_ + okv1); sr_[i].ks0 = ld8(kt_ + okv0); sr_[i].ks1 = ld8(kt_ + okv1); sr_[i].rs = ld8(rt_ + okr); } while (0)
#ifndef ATT_PF
#define ATT_PF 0
#endif
  unsigned opf; { const int t_ = tid < 320 ? tid : tid - 320; const unsigned nx = tid < 320 ? 0u : 64u;
    opf = (t_ < 128) ? (unsigned)((nx + (t_ >> 1)) * LDK + (t_ & 1) * 64) : (t_ < 256 && tid < 320) ? (unsigned)(((t_ - 128) >> 1) * LDK + (t_ & 1) * 64) : (tid < 320) ? (unsigned)((t_ - 256) * LDR) : (unsigned)((nx + ((t_ - 128) >> 1)) * LDK + (t_ & 1) * 64); }
  asm volatile("" : "+v"(opf));
  const int pfsel = __builtin_amdgcn_readfirstlane(tid < 128 ? 0 : (tid < 256 ? 1 : (tid < 320 ? 2 : (tid < 448 ? 0 : 1))));
  unsigned pf_ = 0u;
#define PFETCH(k0) do { if (ATT_PF > 0) { asm volatile("" :: "v"(pf_)); const int kc_ = (k0) < seq - 128 ? (k0) : seq - 128; const unsigned short* pb_ = (pfsel == 0) ? Kn + (size_t)kc_ * LDK : (pfsel == 1) ? Vh + (size_t)kc_ * LDK : Kr + (size_t)kc_ * LDR; \
    pf_ = *(const __attribute__((address_space(1))) unsigned*)(pb_ + opf); } } while (0)
#define SWRITE(b, i) do { *(bf16x8*)(V_lds + (b) * SHM_V + vst0) = sr_[i].vs0;          \
    *(bf16x8*)(V_lds + (b) * SHM_V + vst1) = sr_[i].vs1; int kc = sc * 2;               \
    *(bf16x8*)(K_lds + (b) * SHM_K + KSWZ(sr, kc)) = sr_[i].ks0;                       \
    *(bf16x8*)(K_lds + (b) * SHM_K + KSWZ(32 + sr, kc)) = sr_[i].ks1;                  \
    *(bf16x8*)(R_lds + (b) * SHM_R + RSWZ(rr, rc * 2)) = sr_[i].rs; } while (0)
#define SWAIT() do { if constexpr (SDEPTH == 2) asm volatile("s_waitcnt vmcnt(5)" ::: "memory"); else if (ATT_PF == 0) asm volatile("s_waitcnt vmcnt(0)" ::: "memory"); } while (0)
#define RESC(a) do { if (__any((a) < 1.f)) { if (hi == 0) al_l[r32] = (a); asm volatile("s_waitcnt lgkmcnt(0)" ::: "memory"); \
    for (int d = 0; d < 4; ++d) for (int r = 0; r < 16; ++r) o[d][r] *= al_l[crow(r, hi)]; } } while (0)
#ifndef ATT_PP
#define ATT_PP 1
#endif
  if constexpr (ATT_PP != 0 && NBUF == 3) {
  const int half = __builtin_amdgcn_readfirstlane(wid >> 2);
  f32x16 p0, p1; float mn, al; bf16x8 pa0, pa1, pa2, pa3; const int NT = seq / KVBLK;
#ifndef ATT_DMA
#define ATT_DMA 1
#endif
  const int widu = __builtin_amdgcn_readfirstlane(wid);
  unsigned dk0, dk1, dv0, dv1, dr0;
  { { const int row = 4 * (2 * widu) + (lane >> 4), ch = (lane & 15) ^ (row & 15); dk0 = (unsigned)(row * LDK + ch * 8); }
    { const int row = 4 * (2 * widu + 1) + (lane >> 4), ch = (lane & 15) ^ (row & 15); dk1 = (unsigned)(row * LDK + ch * 8); }
    { const int sub = 2 * (2 * widu) + (lane >> 5), idx = lane & 31, kk = (sub >> 2) * 8 + (idx >> 2), k = (kk & ~0xC) | ((kk & 4) << 1) | ((kk & 8) >> 1), c = (sub & 3) * 32 + (idx & 3) * 8; dv0 = (unsigned)(k * LDK + c); }
    { const int sub = 2 * (2 * widu + 1) + (lane >> 5), idx = lane & 31, kk = (sub >> 2) * 8 + (idx >> 2), k = (kk & ~0xC) | ((kk & 4) << 1) | ((kk & 8) >> 1), c = (sub & 3) * 32 + (idx & 3) * 8; dv1 = (unsigned)(k * LDK + c); }
    { const int row = 8 * widu + (lane >> 3), ch = (lane & 7) ^ ((row >> 1) & 7); dr0 = (unsigned)(row * LDR + ch * 8); } }
  asm volatile("" : "+v"(dk0), "+v"(dk1), "+v"(dv0), "+v"(dv1), "+v"(dr0));
#define GLDS16(gp, lp) __builtin_amdgcn_global_load_lds((const unsigned*)(gp), (__attribute__((address_space(3))) unsigned*)(lp), 16, 0, 0)
#define DMA_TILE(b, k0) do { const unsigned short* vt_ = Vh + (size_t)(k0) * LDK; const unsigned short* kt_ = Kn + (size_t)(k0) * LDK; const unsigned short* rt_ = Kr + (size_t)(k0) * LDR; \
    GLDS16(kt_ + dk0, K_lds + (b) * SHM_K + (2 * widu) * 1024); GLDS16(kt_ + dk1, K_lds + (b) * SHM_K + (2 * widu + 1) * 1024); \
    GLDS16(vt_ + dv0, V_lds + (b) * SHM_V + (2 * widu) * 1024); GLDS16(vt_ + dv1, V_lds + (b) * SHM_V + (2 * widu + 1) * 1024); \
    GLDS16(rt_ + dr0, R_lds + (b) * SHM_R + widu * 1024); } while (0)
#define DMA_WAIT() asm volatile("s_waitcnt vmcnt(0)" ::: "memory")
  if constexpr (ATT_DMA != 0) { DMA_TILE(0, 0); DMA_WAIT(); __syncthreads(); }
  else { SLOAD(0, 0); asm volatile("s_waitcnt vmcnt(0)" ::: "memory"); SWRITE(0, 0); SLOAD(0, KVBLK); __syncthreads(); }
#ifndef ATT_QREG
#define ATT_QREG 1
#endif
  if constexpr (ATT_QREG != 0) {
#pragma unroll
    for (int d = 0; d < 4; ++d) qr[8 + d] = *reinterpret_cast<const bf16x8*>(Qf + d * 1024); }
  float mq = 0.f; bf16x8 qx = (bf16x8){0, 0, 0, 0, 0, 0, 0, 0}; const bf16x8 kone = (bf16x8){(short)(hi == 0 ? 0x3F80 : 0), 0, 0, 0, 0, 0, 0, 0};
#define QKT_PP(P0, P1, KS, RS) do { if constexpr (ATT_AUG_ON && ATT_QREG != 0) qkt_aug(P0, P1, KS, RS, qr, kone, qx, r32, hi); else if constexpr (ATT_QREG != 0) qkt_pr(P0, P1, KS, RS, qr, r32, hi); else qkt_pp(P0, P1, KS, RS, qr, Qf, r32, hi); } while (0)
#define PSM_PP(P0, P1) do { if constexpr (ATT_AUG_ON && ATT_QREG != 0) partialSM_aug(P0, P1, mq, al, qx, hi, j == 0); else partialSM(P0, P1, m_reg, mn, al); } while (0)
  if (half == 0) {
    int bc = 0, bp = 2, bn = 1;
    for (int j = 0; j < NT; ++j) {
      if constexpr (ATT_DMA != 0) { if (j + 1 < NT) DMA_TILE(bn, (j + 1) * KVBLK); }
      SBAR(); if (j > 0) pv_d0(o, vb0 + bp * (int)SHM_V, pa0, pa1, pa2, pa3);
      QKT_PP(p0, p1, K_lds + bc * SHM_K, R_lds + bc * SHM_R); SBAR();
      if constexpr (ATT_DMA != 0) DMA_WAIT(); else { if (j + 1 < NT) { asm volatile("s_waitcnt vmcnt(0)" ::: "memory"); SWRITE(bn, 0); } }
      __syncthreads();
      if constexpr (ATT_DMA == 0) { if (j + 2 < NT) SLOAD(0, (j + 2) * KVBLK); }
      SBAR(); PSM_PP(p0, p1); finishSM(p0, p1, al, l_reg, pa0, pa1, pa2, pa3); RESC(al); SBAR();
      __syncthreads();
      { const int t_ = bp; bp = bc; bc = bn; bn = t_; }
    }
    SBAR(); pv_d0(o, vb0 + bp * (int)SHM_V, pa0, pa1, pa2, pa3);
    __syncthreads();
  } else {
    if constexpr (ATT_DMA != 0) { DMA_TILE(1, KVBLK); DMA_WAIT(); } else { asm volatile("s_waitcnt vmcnt(0)" ::: "memory"); SWRITE(1, 0); }
    __syncthreads();
    int bc = 0, bp = 2, bn = 1, bnn = 2;
    for (int j = 0; j < NT; ++j) {
      if constexpr (ATT_DMA == 0) SLOAD(0, (j + 2 < NT ? j + 2 : NT - 1) * KVBLK);
      SBAR(); if (j > 0) pv_d0(o, vb0 + bp * (int)SHM_V, pa0, pa1, pa2, pa3);
      QKT_PP(p0, p1, K_lds + bc * SHM_K, R_lds + bc * SHM_R); SBAR();
      __syncthreads();
      if constexpr (ATT_DMA != 0) { if (j + 2 < NT) DMA_TILE(bnn, (j + 2) * KVBLK); }
      SBAR(); PSM_PP(p0, p1); finishSM(p0, p1, al, l_reg, pa0, pa1, pa2, pa3); RESC(al); SBAR();
      if constexpr (ATT_DMA != 0) DMA_WAIT(); else { if (j + 2 < NT) { asm volatile("s_waitcnt vmcnt(0)" ::: "memory"); SWRITE(bnn, 0); } }
      __syncthreads();
      { bp = bc; bc = bn; bn = bnn; bnn = bp; }
    }
    SBAR(); pv_d0(o, vb0 + bp * (int)SHM_V, pa0, pa1, pa2, pa3);
  }
  } else {
  f32x16 pA0, pA1, pB0, pB1; float mnA, mnB, alA, alB; bf16x8 pa0, pa1, pa2, pa3; const int NT = seq / KVBLK;
#ifdef ATT_PRIO
  if (__builtin_amdgcn_readfirstlane(tid) >= 256) __builtin_amdgcn_s_setprio(1);
#endif
  constexpr int SE = 0, SO = SDEPTH - 1;
  SLOAD(SE, 0); asm volatile("s_waitcnt vmcnt(0)" ::: "memory"); SWRITE(0, SE); __syncthreads();
  qkt(pA0, pA1, K_lds, R_lds, qr, Qf, r32, hi); partialSM(pA0, pA1, m_reg, mnA, alA);
  SLOAD(SO, KVBLK); if constexpr (SDEPTH == 2) { if (2 < NT) SLOAD(SE, 2 * KVBLK); }
  SWAIT(); SWRITE(1, SO); __syncthreads();
  if constexpr (NBUF == 2) {
  for (int j = 1; j + 1 < NT; j += 2) {
    SBAR(); qkt(pB0, pB1, K_lds + SHM_K, R_lds + SHM_R, qr, Qf, r32, hi);
    finishSM(pA0, pA1, alA, l_reg, pa0, pa1, pa2, pa3); SBAR();
    SLOAD(SO, (j + SDEPTH) * KVBLK); PFETCH((j + SDEPTH + ATT_PF) * KVBLK); SBAR();
    pv_d0(o, vb0, pa0, pa1, pa2, pa3); partialSM(pB0, pB1, m_reg, mnB, alB);
    __syncthreads(); SWAIT(); SWRITE(0, SE);
    RESC(alB); __syncthreads();
    SBAR(); qkt(pA0, pA1, K_lds, R_lds, qr, Qf, r32, hi);
    finishSM(pB0, pB1, alB, l_reg, pa0, pa1, pa2, pa3); SBAR();
    if (SDEPTH == 1 || j + 3 < NT) SLOAD(SE, (j + 1 + SDEPTH) * KVBLK); PFETCH((j + 1 + SDEPTH + ATT_PF) * KVBLK); SBAR();
    pv_d0(o, vb0 + (int)SHM_V, pa0, pa1, pa2, pa3); partialSM(pA0, pA1, m_reg, mnA, alA);
    __syncthreads(); SWAIT(); SWRITE(1, SO);
    RESC(alA); __syncthreads();
  }
  SBAR(); qkt(pB0, pB1, K_lds + SHM_K, R_lds + SHM_R, qr, Qf, r32, hi);
  finishSM(pA0, pA1, alA, l_reg, pa0, pa1, pa2, pa3); SBAR();
  pv_d0(o, vb0, pa0, pa1, pa2, pa3); partialSM(pB0, pB1, m_reg, mnB, alB);
  __syncthreads(); RESC(alB);
  finishSM(pB0, pB1, alB, l_reg, pa0, pa1, pa2, pa3); SBAR();
  pv_d0(o, vb0 + (int)SHM_V, pa0, pa1, pa2, pa3);
  } else {
  int bp = 0, bc = 1, bn = 2;
  for (int j = 1; j + 1 < NT; j += 2) {
    SBAR(); qkt(pB0, pB1, K_lds + bc * SHM_K, R_lds + bc * SHM_R, qr, Qf, r32, hi);
    finishSM(pA0, pA1, alA, l_reg, pa0, pa1, pa2, pa3); SBAR();
    SLOAD(0, (j + 1) * KVBLK); SBAR();
    pv_d0(o, vb0 + bp * (int)SHM_V, pa0, pa1, pa2, pa3); partialSM(pB0, pB1, m_reg, mnB, alB);
    SWAIT(); SWRITE(bn, 0);
    RESC(alB); __syncthreads();
    { const int t_ = bp; bp = bc; bc = bn; bn = t_; }
    SBAR(); qkt(pA0, pA1, K_lds + bc * SHM_K, R_lds + bc * SHM_R, qr, Qf, r32, hi);
    finishSM(pB0, pB1, alB, l_reg, pa0, pa1, pa2, pa3); SBAR();
    SLOAD(0, (j + 2) * KVBLK); SBAR();
    pv_d0(o, vb0 + bp * (int)SHM_V, pa0, pa1, pa2, pa3); partialSM(pA0, pA1, m_reg, mnA, alA);
    SWAIT(); SWRITE(bn, 0);
    RESC(alA); __syncthreads();
    { const int t_ = bp; bp = bc; bc = bn; bn = t_; }
  }
  SBAR(); qkt(pB0, pB1, K_lds + bc * SHM_K, R_lds + bc * SHM_R, qr, Qf, r32, hi);
  finishSM(pA0, pA1, alA, l_reg, pa0, pa1, pa2, pa3); SBAR();
  pv_d0(o, vb0 + bp * (int)SHM_V, pa0, pa1, pa2, pa3); partialSM(pB0, pB1, m_reg, mnB, alB);
  __syncthreads(); RESC(alB);
  finishSM(pB0, pB1, alB, l_reg, pa0, pa1, pa2, pa3); SBAR();
  pv_d0(o, vb0 + bc * (int)SHM_V, pa0, pa1, pa2, pa3);
  }
  }
  asm volatile("" :: "v"(pf_));
#ifdef ATT_PRIO
  __builtin_amdgcn_s_setprio(0);
#endif
  if (hi == 0) li_l[r32] = l_reg; asm volatile("s_waitcnt lgkmcnt(0)" ::: "memory");
  float rli[16];
#pragma unroll
  for (int r = 0; r < 16; ++r) rli[r] = __builtin_amdgcn_rcpf(li_l[crow(r, hi)]);
#pragma unroll
  for (int r = 0; r < 16; ++r) { const unsigned oo = (unsigned)((wid * QBLK + crow(r, hi)) * LDO + r32);
#pragma unroll
    for (int d0 = 0; d0 < 4; ++d0) Ob[oo + d0 * 32] = (unsigned short)(cvtpk(o[d0][r] * rli[r], 0.f) & 0xffffu); }
#undef SLOAD
#undef PFETCH
#undef GLDS16
#undef QKT_PP
#undef PSM_PP
#undef DMA_TILE
#undef DMA_WAIT
#undef SWRITE
#undef SWAIT
#undef RESC
}
}

__device__ __forceinline__ void hy_h2_phase(Frame& F, const bf16* U, const float* cw, const float* cb, bf16* VVT) {
    const int gw = blockIdx.x * NWAVES + F.wave, NGW = F.G * NWAVES, lane = F.lane;
    LAS unsigned char* S = F.lds + F.wave * 16896;
    const int chunk = lane & 7, rsub = lane >> 3;
    constexpr int NTILE = (SEQ / 64) * (DM / 64);
    v4u R[2][9];
#define H2_LOAD(IT) do { const int t0_ = ((IT) >> 6) * 64, c0_ = ((IT) & 63) * 64; \
        _Pragma("unroll") for (int part = 0; part < 2; ++part) _Pragma("unroll") for (int i = 0; i < 9; ++i) { const int rr = rsub + 8 * i; const int t = t0_ - 1 + rr; v4u v = (v4u){0u, 0u, 0u, 0u}; \
            if (rr < 66 && t >= 0 && t < SEQ) v = *(const GAS v4u*)(U + (size_t)t * (3 * DM) + (part + 1) * DM + c0_ + chunk * 8); R[part][i] = v; } } while (0)
    if (gw < NTILE) H2_LOAD(gw);
    for (int it = gw; it < NTILE; it += NGW) { const int t0 = (it >> 6) * 64, c0 = (it & 63) * 64;
#pragma unroll
        for (int part = 0; part < 2; ++part)
#pragma unroll
            for (int i = 0; i < 9; ++i) { const int rr = rsub + 8 * i; if (rr < 66) *(LAS v4u*)(S + part * 8448 + rr * 128 + chunk * 16) = R[part][i]; }
        { const int itn = (it + NGW < NTILE) ? it + NGW : it; H2_LOAD(itn); }
        LDS_WAIT(); asm volatile("" ::: "memory");
        const int c1 = DM + c0 + lane, c2 = 2 * DM + c0 + lane;
        const float a0 = cw[c1], a1 = cw[3 * DM + c1], a2 = cw[6 * DM + c1], ab = cb[c1], b0 = cw[c2], b1 = cw[3 * DM + c2], b2 = cw[6 * DM + c2], bb = cb[c2];
        const LAS unsigned short* S1 = (const LAS unsigned short*)S + lane; const LAS unsigned short* S2 = (const LAS unsigned short*)(S + 8448) + lane;
        float p1 = bf1(S1[0]), q1 = bf1(S1[64]), p2 = bf1(S2[0]), q2 = bf1(S2[64]);
        unsigned ow[32];
#pragma unroll
        for (int t = 0; t < 64; t += 2) { float vv[2];
#pragma unroll
            for (int e = 0; e < 2; ++e) { const float n1 = bf1(S1[(t + e + 2) * 64]), n2 = bf1(S2[(t + e + 2) * 64]);
                vv[e] = (a0 * p1 + a1 * q1 + a2 * n1 + ab) * (b0 * p2 + b1 * q2 + b2 * n2 + bb); p1 = q1; q1 = n1; p2 = q2; q2 = n2; }
            ow[t >> 1] = pk2(vv[0], vv[1]); }
        GAS v4u* dst = (GAS v4u*)(VVT + (size_t)(c0 + lane) * SEQ + t0);
#pragma unroll
        for (int i = 0; i < 8; ++i) dst[i] = (v4u){ow[4 * i], ow[4 * i + 1], ow[4 * i + 2], ow[4 * i + 3]};
        LDS_WAIT(); asm volatile("" ::: "memory");
    }
}
#undef H2_LOAD
__device__ __forceinline__ void hy_h4_phase(Frame& F, const bf16* U, const float* cw, const float* cb, const bf16* YT, bf16* Aout) {
    const int gw = blockIdx.x * NWAVES + F.wave, NGW = F.G * NWAVES, lane = F.lane;
    LAS unsigned char* S = F.lds + F.wave * 17408;
    LAS unsigned char* Tt = S + 8448;
    const int chunk = lane & 7, rsub = lane >> 3;
    constexpr int NTILE = (SEQ / 64) * (DM / 64);
    v4u RX[9], RY[8];
#define H4_LOAD(IT) do { const int t0_ = ((IT) >> 6) * 64, c0_ = ((IT) & 63) * 64; \
        _Pragma("unroll") for (int i = 0; i < 9; ++i) { const int rr = rsub + 8 * i; const int t = t0_ - 1 + rr; v4u v = (v4u){0u, 0u, 0u, 0u}; \
            if (rr < 66 && t >= 0 && t < SEQ) v = *(const GAS v4u*)(U + (size_t)t * (3 * DM) + c0_ + chunk * 8); RX[i] = v; } \
        _Pragma("unroll") for (int i = 0; i < 8; ++i) { const int cr = rsub + 8 * i; RY[i] = *(const GAS v4u*)(YT + (size_t)(c0_ + cr) * SEQ + t0_ + chunk * 8); } } while (0)
    if (gw < NTILE) H4_LOAD(gw);
    for (int it = gw; it < NTILE; it += NGW) { const int t0 = (it >> 6) * 64, c0 = (it & 63) * 64;
#pragma unroll
        for (int i = 0; i < 9; ++i) { const int rr = rsub + 8 * i; if (rr < 66) *(LAS v4u*)(S + rr * 128 + chunk * 16) = RX[i]; }
#pragma unroll
        for (int i = 0; i < 8; ++i) { const int cr = rsub + 8 * i; const v4u v = RY[i];
            *(LAS v2u*)(Tt + cr * 136 + chunk * 16) = (v2u){v.x, v.y}; *(LAS v2u*)(Tt + cr * 136 + chunk * 16 + 8) = (v2u){v.z, v.w}; }
        { const int itn = (it + NGW < NTILE) ? it + NGW : it; H4_LOAD(itn); }
        LDS_WAIT(); asm volatile("" ::: "memory");
        const int c1 = c0 + lane; const float a0 = cw[c1], a1 = cw[3 * DM + c1], a2 = cw[6 * DM + c1], ab = cb[c1];
        const LAS unsigned short* S0 = (const LAS unsigned short*)S + lane; const LAS unsigned short* Ty = (const LAS unsigned short*)(Tt + lane * 136);
        float p = bf1(S0[0]), q = bf1(S0[64]);
        bf16* dst = Aout + (size_t)t0 * DM + c1;
#pragma unroll 8
        for (int t = 0; t < 64; ++t) { const float n = bf1(S0[(t + 2) * 64]); const float r = (a0 * p + a1 * q + a2 * n + ab) * bf1(Ty[t]); p = q; q = n;
            dst[(size_t)t * DM] = (bf16)(pk2(r, 0.f) & 0xffffu); }
        LDS_WAIT(); asm volatile("" ::: "memory");
    }
}
#undef H4_LOAD
namespace fftc {
constexpr int LOGN = 14, N = 1 << LOGN;
__device__ __forceinline__ int PA(int i) { return i + ((i >> 6) << 2); }
__device__ __forceinline__ int opq(int t) { asm volatile("" : "+v"(t)); return t; }
__device__ __forceinline__ f32x2 cmulc(f32x2 a, f32x2 b) { return (f32x2){a.x * b.x - a.y * b.y, a.x * b.y + a.y * b.x}; }
__device__ __forceinline__ f32x2 cmul(f32x2 a, f32x2 b) { f32x2 t, r;
    asm("v_pk_mul_f32 %0, %1, %2 op_sel_hi:[0,1]" : "=v"(t) : "v"(a), "v"(b));
    asm("v_pk_fma_f32 %0, %1, %2, %3 op_sel:[1,1,0] op_sel_hi:[1,0,1] neg_lo:[1,0,0]" : "=v"(r) : "v"(a), "v"(b), "v"(t));
    return r; }
__device__ __forceinline__ f32x2 cmadd(f32x2 a, f32x2 b, f32x2 c) { f32x2 t, r;
    asm("v_pk_fma_f32 %0, %1, %2, %3 op_sel_hi:[0,1,1]" : "=v"(t) : "v"(a), "v"(b), "v"(c));
    asm("v_pk_fma_f32 %0, %1, %2, %3 op_sel:[1,1,0] op_sel_hi:[1,0,1] neg_lo:[1,0,0]" : "=v"(r) : "v"(a), "v"(b), "v"(t));
    return r; }
__device__ __forceinline__ f32x2 cmul_n(f32x2 a, f32x2 b) { f32x2 t, r;
    asm("v_pk_mul_f32 %0, %1, %2 op_sel_hi:[0,1]" : "=v"(t) : "v"(a), "v"(b));
    asm("v_pk_fma_f32 %0, %1, %2, %3 op_sel:[1,1,0] op_sel_hi:[1,0,1] neg_lo:[1,0,0]\n\ts_nop 1" : "=v"(r) : "v"(a), "v"(b), "v"(t));
    return r; }
template <int CTRL> __device__ __forceinline__ f32x2 quadx(f32x2 v) {
    return (f32x2){__int_as_float(__builtin_amdgcn_update_dpp(0, __float_as_int(v.x), CTRL, 0xF, 0xF, true)), __int_as_float(__builtin_amdgcn_update_dpp(0, __float_as_int(v.y), CTRL, 0xF, 0xF, true))}; }
__device__ __forceinline__ f32x2 cis(float ang) { f32x2 w = (f32x2){__cosf(ang), __sinf(ang)}; asm volatile("s_nop 1" : "+v"(w)); return w; }
__device__ __forceinline__ constexpr float c8(int k) { return k == 0 ? 1.0f : k == 1 ? 0.92387953251128674f : k == 2 ? 0.70710678118654752f : k == 3 ? 0.38268343236508977f : k == 4 ? 0.0f : k == 5 ? -0.38268343236508977f : k == 6 ? -0.70710678118654752f : -0.92387953251128674f; }
__device__ __forceinline__ constexpr float s8(int k) { return k == 0 ? 0.0f : k == 1 ? 0.38268343236508977f : k == 2 ? 0.70710678118654752f : k == 3 ? 0.92387953251128674f : k == 4 ? 1.0f : k == 5 ? 0.92387953251128674f : k == 6 ? 0.70710678118654752f : 0.38268343236508977f; }
template <int NR, int HL, bool INV, bool DPPNEXT = false> __device__ __forceinline__ void bfly_stage(f32x2 (&v)[NR], const f32x2 bq) {
#pragma unroll
    for (int mu = 0; mu < HL; ++mu) {
        constexpr int KS = 8 / HL; const float cr = c8(mu * KS), ci = INV ? s8(mu * KS) : -s8(mu * KS);
        const f32x2 tw = (mu == 0) ? bq : cmulc(bq, (f32x2){cr, ci});
#pragma unroll
        for (int blk = 0; blk < NR; blk += 2 * HL) {
            if (!INV) { const f32x2 a = v[blk + mu], b = v[blk + mu + HL]; v[blk + mu] = a + b; v[blk + mu + HL] = DPPNEXT ? cmul_n(a - b, tw) : cmul(a - b, tw); }
            else { const f32x2 a = v[blk + mu], b = cmul(v[blk + mu + HL], tw); v[blk + mu] = a + b; v[blk + mu + HL] = a - b; }
        }
    }
}
template <int LOGH, int R, bool TAIL = false> __device__ __forceinline__ void dif_pass(LAS f32x2* X, int tid_) {
    constexpr int H = 1 << LOGH, S = H >> (R - 1), LOGS = LOGH - (R - 1), NR = 1 << R, NG = N >> R;
    const int tid = opq(tid_);
#pragma unroll 1
    for (int g = tid; g < NG; g += NTHR) {
        const int j = g & (S - 1), base = ((g >> LOGS) << (LOGH + 1)) + j;
        constexpr int PS = S + ((S >> 6) << 2); static_assert(S % 64 == 0 || NR * S <= 64, "padded stride");
        const int p0 = PA(base);
        f32x2 v[NR];
#pragma unroll
        for (int m = 0; m < NR; ++m) v[m] = X[p0 + PS * m];
        const float ang = -3.14159265358979323846f * (float)j * (1.0f / (float)((NR / 2) * S));
        const f32x2 bw = cis(ang);
        if constexpr (R == 4) { const f32x2 b4 = cmul(bw, bw), b2 = cmul(b4, b4), b1 = cmul(b2, b2);
            bfly_stage<NR, 8, false>(v, bw); bfly_stage<NR, 4, false>(v, b4); bfly_stage<NR, 2, false>(v, b2); bfly_stage<NR, 1, false, TAIL>(v, b1); }
        else { const f32x2 b1 = cmul(bw, bw); bfly_stage<NR, 2, false>(v, bw); bfly_stage<NR, 1, false>(v, b1); }
        if constexpr (TAIL) {
            static_assert(S == 4 && R == 4, "quad tail");
            const int q = tid & 3; const float s2 = (q & 2) ? -1.f : 1.f, s1 = (q & 1) ? -1.f : 1.f; const bool q3 = q == 3;
#pragma unroll
            for (int m = 0; m < NR; ++m) { const f32x2 xp = quadx<0x4E>(v[m]); f32x2 r = xp + v[m] * s2;
                r = q3 ? (f32x2){r.y, -r.x} : r;
                const f32x2 rp = quadx<0xB1>(r); v[m] = rp + r * s1; }
        }
#pragma unroll
        for (int m = 0; m < NR; ++m) X[p0 + PS * m] = v[m];
    }
}
template <int LOGH0, int R, bool HEAD = false> __device__ __forceinline__ void dit_pass(LAS f32x2* X, int tid_) {
    constexpr int S = 1 << LOGH0, NR = 1 << R, NG = N >> R;
    const int tid = opq(tid_);
#pragma unroll 1
    for (int g = tid; g < NG; g += NTHR) {
        const int j = g & (S - 1), base = ((g >> LOGH0) << (LOGH0 + R)) + j;
        constexpr int PS = S + ((S >> 6) << 2); static_assert(S % 64 == 0 || NR * S <= 64, "padded stride");
        const int p0 = PA(base);
        f32x2 v[NR];
#pragma unroll
        for (int m = 0; m < NR; ++m) v[m] = X[p0 + PS * m];
        if constexpr (HEAD) {
            static_assert(S == 4 && R == 4, "quad head");
            const int q = tid & 3; const float s2 = (q & 2) ? -1.f : 1.f, s1 = (q & 1) ? -1.f : 1.f; const bool q3 = q == 3;
#pragma unroll
            for (int m = 0; m < NR; ++m) { const f32x2 xp = quadx<0xB1>(v[m]); f32x2 r = xp + v[m] * s1;
                r = q3 ? (f32x2){-r.y, r.x} : r;
                const f32x2 rp = quadx<0x4E>(r); v[m] = rp + r * s2; }
        }
        const float ang = 3.14159265358979323846f * (float)j * (1.0f / (float)((NR / 2) * S));
        const f32x2 bw = cis(ang);
        if constexpr (R == 4) { const f32x2 b4 = cmul(bw, bw), b2 = cmul(b4, b4), b1 = cmul(b2, b2);
            bfly_stage<NR, 1, true>(v, b1); bfly_stage<NR, 2, true>(v, b2); bfly_stage<NR, 4, true>(v, b4); bfly_stage<NR, 8, true>(v, bw); }
        else { const f32x2 b1 = cmul(bw, bw); bfly_stage<NR, 1, true>(v, b1); bfly_stage<NR, 2, true>(v, bw); }
#pragma unroll
        for (int m = 0; m < NR; ++m) X[p0 + PS * m] = v[m];
    }
}
__device__ __forceinline__ void fwd(LAS f32x2* X, int tid) {
    dif_pass<13, 4>(X, tid); __syncthreads(); dif_pass<9, 4>(X, tid); __syncthreads(); dif_pass<5, 4, true>(X, tid); __syncthreads();
}
__device__ __forceinline__ void inv(LAS f32x2* X, int tid) {
    dit_pass<2, 4, true>(X, tid); __syncthreads(); dit_pass<6, 4>(X, tid); __syncthreads(); dit_pass<10, 4>(X, tid); __syncthreads();
}
__device__ __forceinline__ int brev14(int k) { return (int)(__brev((unsigned)k) >> 18); }
}
__device__ __forceinline__ void hy_fft_phase(Frame& F, const bf16* GT, const bf16* VVT, const float* skip, bf16* YT, float d0, float dstep, float tscale) {
    using namespace fftc;
    LAS f32x2* X = (LAS f32x2*)F.lds; const int tid0 = F.tid;
    v4u G[8]; unsigned short GE[4]; v4u V[4];
#define FFT_LOAD_G(cc) do { const int t_ = opq(tid0); const bf16* gf_ = GT + (size_t)(cc) * SEQ; const bf16* gb_ = GT + (size_t)(DM + (cc)) * SEQ; \
        _Pragma("unroll") for (int jj = 0; jj < 4; ++jj) { const int m = 4 * (t_ + NTHR * jj); G[jj] = *(const GAS v4u*)(gf_ + 2 * m); } \
        _Pragma("unroll") for (int jj = 4; jj < 8; ++jj) { const int m = 4 * (t_ + NTHR * jj), mp = N - m; G[jj] = *(const GAS v4u*)(gb_ + 2 * mp - 8); GE[jj - 4] = (2 * mp < N) ? *(const GAS bf16*)(gb_ + 2 * mp) : (unsigned short)0; } } while (0)
    if ((int)blockIdx.x < DM) FFT_LOAD_G(blockIdx.x);
    for (int c = blockIdx.x; c < DM; c += F.G) {
        const bf16* vr = VVT + (size_t)c * SEQ;
        int tid = opq(tid0);
        const float dlc = -(d0 + (float)c * dstep) * tscale, rst = __builtin_amdgcn_exp2f(dlc);
#pragma unroll
        for (int jj = 0; jj < 4; ++jj) { const int m = 4 * (tid + NTHR * jj); float f[8]; unpack8(G[jj], f); float dk = __builtin_amdgcn_exp2f(dlc * (float)(2 * m));
#pragma unroll
            for (int e = 0; e < 8; ++e) { f[e] *= dk; dk *= rst; }
#pragma unroll
            for (int e = 0; e < 4; ++e) X[PA(m + e)] = (f32x2){f[2 * e], f[2 * e + 1]}; }
#pragma unroll
        for (int jj = 4; jj < 8; ++jj) { const int m = 4 * (tid + NTHR * jj), mp = N - m; float f[8]; unpack8(G[jj], f); float e0 = bf1(GE[jj - 4]);
            float dk = __builtin_amdgcn_exp2f(dlc * (float)(2 * mp - 8));
#pragma unroll
            for (int e = 0; e < 8; ++e) { f[e] *= dk; dk *= rst; }
            e0 *= dk;
            X[PA(m)] = (f32x2){e0, f[7]}; X[PA(m + 1)] = (f32x2){f[6], f[5]}; X[PA(m + 2)] = (f32x2){f[4], f[3]}; X[PA(m + 3)] = (f32x2){f[2], f[1]}; }
        tid = opq(tid0);
#pragma unroll
        for (int jj = 0; jj < 4; ++jj) { const int m = 4 * (tid + NTHR * jj); V[jj] = *(const GAS v4u*)(vr + 2 * m); }
        __syncthreads();
        fwd(X, tid);
        tid = opq(tid0);
#define KMAP(t_, jj_) ((((t_) & 31) << 8) | (((t_) >> 5) << 4) | (jj_))
        f32x2 zg[16][2];
#pragma unroll
        for (int jj = 0; jj < 16; ++jj) { const int k = KMAP(tid, jj); zg[jj][0] = X[PA(brev14(k))]; zg[jj][1] = X[PA(brev14((N - k) & (N - 1)))]; }
        const f32x2 zgh = X[PA(1)];
        __syncthreads();
        tid = opq(tid0);
#pragma unroll
        for (int jj = 0; jj < 8; ++jj) { const int m = 4 * (tid + NTHR * jj);
            if (jj < 4) { float f[8]; unpack8(V[jj], f);
#pragma unroll
                for (int e = 0; e < 4; ++e) X[PA(m + e)] = (f32x2){f[2 * e], f[2 * e + 1]}; }
            else {
#pragma unroll
                for (int e = 0; e < 4; ++e) X[PA(m + e)] = (f32x2){0.f, 0.f}; } }
        if (c + F.G < DM) FFT_LOAD_G(c + F.G);
        __syncthreads();
        fwd(X, tid);
        tid = opq(tid0);
        constexpr float SC = 1.0f / (float)N;
#pragma unroll
        for (int jj = 0; jj < 16; ++jj) { const int k = KMAP(tid, jj), p = PA(brev14(k)), p2 = PA(brev14((N - k) & (N - 1)));
            const f32x2 a = X[p], b = X[p2], ga = zg[jj][0], gc = zg[jj][1];
            const f32x2 Ev = (f32x2){0.5f * (a.x + b.x), 0.5f * (a.y - b.y)}, Ov = (f32x2){0.5f * (a.y + b.y), 0.5f * (b.x - a.x)};
            const f32x2 Eg = (f32x2){0.5f * (ga.x + gc.x), 0.5f * (ga.y - gc.y)}, Og = (f32x2){0.5f * (ga.y + gc.y), 0.5f * (gc.x - ga.x)};
            const float ang = -6.283185307179586f * (float)k / (float)N; const f32x2 wk = cis(ang);
            f32x2 Pe = cmadd(Ev, Eg, cmul(wk, cmul(Ov, Og))), Po = cmadd(Ev, Og, cmul(Ov, Eg)); Pe = Pe * SC; Po = Po * SC;
            X[p] = (f32x2){Pe.x - Po.y, Pe.y + Po.x};
            if (k != 0) X[p2] = (f32x2){Pe.x + Po.y, Po.x - Pe.y}; }
        if (tid == 0) { const f32x2 a = X[PA(1)];
            const float Ev = a.x, Ov = a.y, Eg = zgh.x, Og = zgh.y; X[PA(1)] = (f32x2){(Ev * Eg - Ov * Og) * SC, (Ev * Og + Ov * Eg) * SC}; }
        __syncthreads();
        inv(X, tid);
        tid = opq(tid0);
        const float sk = skip[c];
#pragma unroll
        for (int jj = 0; jj < 4; ++jj) { const int m = 4 * (tid + NTHR * jj); float f[8], o[8]; unpack8(*(const GAS v4u*)(vr + 2 * m), f);
#pragma unroll
            for (int e = 0; e < 4; ++e) { const f32x2 q = X[PA(m + e)]; o[2 * e] = q.x + f[2 * e] * sk; o[2 * e + 1] = q.y + f[2 * e + 1] * sk; }
            *(GAS v4u*)(YT + (size_t)c * SEQ + 2 * m) = pack8f(o); }
        __syncthreads();
    }
#undef FFT_LOAD_G
#undef KMAP
}

#define GEMM_CALL(EPI, Aptr, Bptr, Mv, Nv, Kv, ...) do { pg8::Gemm g_{(const pg8::bf16_t*)(Aptr), (const pg8::bf16_t*)(Bptr), (Mv), (Nv), (Kv)}; pg8::StaticOrder S_; S_.init((Mv), (Nv), F.G, (int)blockIdx.x); \
    EPI E_{__VA_ARGS__}; pg8::gemm_phase<EPI, pg8::StaticOrder, PG8_ALIGN, PG8_SP2>(F.lds, g_, S_, E_); } while (0)

#ifndef DOWN_RB
#define DOWN_RB 2
#endif
#define GEMM_DOWN(Aptr, Bptr, ...) do { if (F.G == 256) { pg8::Gemm g_{(const pg8::bf16_t*)(Aptr), (const pg8::bf16_t*)(Bptr), SEQ, DM, FF, FFP}; pg8::BlockOrder<DOWN_RB, 32 / DOWN_RB> S_; S_.init((int)blockIdx.x); \
        pg8::EpiBf16<0> E_{__VA_ARGS__}; pg8::gemm_phase<pg8::EpiBf16<0>, pg8::BlockOrder<DOWN_RB, 32 / DOWN_RB>, PG8_ALIGN, PG8_SP2>(F.lds, g_, S_, E_); } \
    else { pg8::Gemm g_{(const pg8::bf16_t*)(Aptr), (const pg8::bf16_t*)(Bptr), SEQ, DM, FF, FFP}; pg8::StaticOrder S_; S_.init(SEQ, DM, F.G, (int)blockIdx.x); pg8::EpiBf16<0> E_{__VA_ARGS__}; pg8::gemm_phase<pg8::EpiBf16<0>, pg8::StaticOrder, PG8_ALIGN, PG8_SP2>(F.lds, g_, S_, E_); } } while (0)
#ifndef REP_P0
#define REP_P0 1
#endif
#ifndef REP_ATT
#define REP_ATT 1
#endif
#ifndef REP_GU
#define REP_GU 1
#endif
#ifndef REP_FFT
#define REP_FFT 1
#endif
#ifndef REP_DN
#define REP_DN 1
#endif
#ifndef REP_ROW
#define REP_ROW 1
#endif
#ifndef REP_SCIN
#define REP_SCIN 1
#endif
#ifndef REP_MISC
#define REP_MISC 1
#endif
#define GEMM_CALL_SUB(EPI, Aptr, Bptr, Mv, Nv, Kv, Gs, cs, ...) do { pg8::Gemm g_{(const pg8::bf16_t*)(Aptr), (const pg8::bf16_t*)(Bptr), (Mv), (Nv), (Kv)}; pg8::StaticOrder S_; S_.init((Mv), (Nv), (Gs), (cs)); \
    EPI E_{__VA_ARGS__}; pg8::gemm_phase<EPI, pg8::StaticOrder, PG8_ALIGN, PG8_SP2>(F.lds, g_, S_, E_); } while (0)
static_assert(att::LDS_NEED <= LDSCTL_OFF && 8 * 17408 <= LDSCTL_OFF && pg8::STAGE_BYTES <= LDSCTL_OFF, "phase LDS regions stay below the control words");
__global__ void __launch_bounds__(NTHR, 2) mega_fwd(Args args) {
    extern __shared__ __attribute__((aligned(16))) unsigned char lds[];
    Frame F;
    F.lds = (LAS unsigned char*)lds;
    F.MISC = (volatile LAS unsigned*)(F.lds + MISC_OFF);
    F.tid = threadIdx.x; F.lane = F.tid & 63; F.wave = __builtin_amdgcn_readfirstlane(F.tid >> 6);
    F.G = gridDim.x;
    unsigned char* ws = args.ws;
    F.ctl = (gu32*)(ws + WS_CTL);
    for (int u = F.tid; u < (LDS_BYTES - LDSCTL_OFF) / 4; u += NTHR) ((LAS unsigned*)(F.lds + LDSCTL_OFF))[u] = 0u;
    __syncthreads();
    const int lo = args.ph_lo, hi = args.ph_hi;
    XcdBarrier bar; bar.bar = (unsigned*)(F.ctl + CW_BAR); bar.x = 0; bar.st = nullptr;
    if (hi - lo > 1) bar = xcd_barrier_post((unsigned*)(F.ctl + CW_BAR), F.MISC + 8);
#ifndef MK_MASK
#define MK_MASK 0xFFFFFFFFFFFFFFFFull
#endif
#define IN(k) ((((MK_MASK) >> (k)) & 1ull) != 0ull && lo <= (k) && (k) < hi)
#define SEAM(k) do { if (IN(k) && IN((k) + 1)) xcd_barrier(bar); } while (0)

    float* const MOD = (float*)(ws + WS_MOD);
#define MODV(L, r, i) (MOD + ((size_t)((L) * 2 + (r)) * NMOD + (i)) * DM)
#define GAIN(L, i) (args.in[7] + ((size_t)(L) * 4 + (i)) * DM)
    bf16* const HB = (bf16*)(ws + WS_HB); bf16* const U = (bf16*)(ws + WS_U); bf16* const Z = (bf16*)(ws + WS_Z); bf16* const Y = (bf16*)(ws + WS_Y);
    float* const XC = (float*)(ws + WS_XC); float* const XL = args.out;
#ifndef XRES_BF16
#define XRES_BF16 1
#endif
    constexpr int RXS = XRES_BF16 ? 1 : 0, RXD = XRES_BF16 ? 1 : 2;
    void* const XRL = XRES_BF16 ? (void*)(ws + WS_XB) : (void*)XL;
    bf16* const Pb = U; bf16* const Bqb = U + (size_t)MT * DM;

    if (IN(0)) { for (int rep_ = 0; rep_ < REP_P0; ++rep_) { Frame Fp = fresh(F); p0_prologue(Fp, args); __syncthreads(); } } SEAM(0);
    if (IN(1)) { Frame Fp = fresh(F); p1_adaln(Fp, args); } SEAM(1);
    if (IN(2)) { Frame Fp = fresh(F); row_phase<false, true, 0, 0>(Fp, 0, MT, (int)blockIdx.x, F.G, args.in[0], args.in[2], nullptr, nullptr, nullptr, nullptr, nullptr, nullptr, HB, GAIN(0, 0), MODV(0, 0, 0), MODV(0, 1, 0), MODV(0, 0, 1), MODV(0, 1, 1)); } SEAM(2);

    const int gsi = F.G >= 96 ? 48 : F.G / 2, gso = F.G >= 32 ? 16 : F.G / 2;
    if (IN(3)) { GEMM_CALL(pg8::EpiScIn, HB, ws + WS_SCIN, SEQ, 3 * DM, DM, Pb, Bqb, DM); } SEAM(3);
    if (IN(4)) { if ((int)blockIdx.x < gsi) { GEMM_CALL_SUB(pg8::EpiScIn, HB + (size_t)SEQ * DM, ws + WS_SCIN, CTXL, 3 * DM, DM, gsi, (int)blockIdx.x, Pb + (size_t)SEQ * DM, Bqb + (size_t)SEQ * DM, DM); }
                 else { Frame Fp = fresh(F); sc_conv_phase(Fp, 0, SEQ, (int)blockIdx.x - gsi, F.G - gsi, Pb, Bqb, args.in[11], Z); } } SEAM(4);
    if (IN(5)) { { Frame Fp = fresh(F); sc_conv_phase(Fp, SEQ, MT, (int)blockIdx.x, F.G, Pb, Bqb, args.in[11], Z); }
                 GEMM_CALL(pg8::EpiBf16<0>, Z, ws + WS_SCOUT, SEQ, DM, DM, Y, DM, nullptr, 0, 0, 1.f); } SEAM(5);
    if (IN(6)) { if ((int)blockIdx.x < gso) { GEMM_CALL_SUB(pg8::EpiBf16<0>, Z + (size_t)SEQ * DM, ws + WS_SCOUT, CTXL, DM, DM, gso, (int)blockIdx.x, Y + (size_t)SEQ * DM, DM, nullptr, 0, 0, 1.f); }
                 else { Frame Fp = fresh(F); row_phase<true, true, 0, RXD>(Fp, 0, SEQ, (int)blockIdx.x - gso, F.G - gso, args.in[0], args.in[2], XRL, XC, Y, MODV(0, 0, 2), MODV(0, 1, 2), GAIN(0, 1), HB, GAIN(0, 2), MODV(0, 0, 3), MODV(0, 1, 3), MODV(0, 0, 4), MODV(0, 1, 4)); } } SEAM(6);
    if (IN(7)) { Frame Fp = fresh(F); row_phase<true, true, 0, 2>(Fp, SEQ, MT, (int)blockIdx.x, F.G, args.in[0], args.in[2], XL, XC, Y, MODV(0, 0, 2), MODV(0, 1, 2), GAIN(0, 1), HB, GAIN(0, 2), MODV(0, 0, 3), MODV(0, 1, 3), MODV(0, 0, 4), MODV(0, 1, 4)); } SEAM(7);
    if (IN(8)) { GEMM_CALL(pg8::EpiSwiglu, HB, ws + WS_WGU, MT, NGU, DM, U, FFP); } SEAM(8);
    if (IN(9)) { GEMM_DOWN(U, ws + WS_WD, Y, DM, nullptr, 0, 0, 1.f); } SEAM(9);
    if (IN(10)) { if ((int)blockIdx.x < gso) { { pg8::Gemm g_{(const pg8::bf16_t*)(U + (size_t)SEQ * FFP), (const pg8::bf16_t*)(ws + WS_WD), CTXL, DM, FF, FFP}; pg8::StaticOrder S_; S_.init(CTXL, DM, gso, (int)blockIdx.x); pg8::EpiBf16<0> E_{Y + (size_t)SEQ * DM, DM, nullptr, 0, 0, 1.f}; pg8::gemm_phase<pg8::EpiBf16<0>, pg8::StaticOrder, PG8_ALIGN, PG8_SP2>(F.lds, g_, S_, E_); } }
                  else { Frame Fp = fresh(F); row_phase<true, true, RXS, RXD>(Fp, 0, SEQ, (int)blockIdx.x - gso, F.G - gso, XRL, XC, XRL, XC, Y, MODV(0, 0, 5), MODV(0, 1, 5), GAIN(0, 3), HB, GAIN(1, 0), MODV(1, 0, 0), MODV(1, 1, 0), MODV(1, 0, 1), MODV(1, 1, 1)); } } SEAM(10);
    if (IN(11)) { Frame Fp = fresh(F); row_phase<true, true, 0, 2>(Fp, SEQ, MT, (int)blockIdx.x, F.G, XL, XC, XL, XC, Y, MODV(0, 0, 5), MODV(0, 1, 5), GAIN(0, 3), HB, GAIN(1, 0), MODV(1, 0, 0), MODV(1, 1, 0), MODV(1, 0, 1), MODV(1, 1, 1)); } SEAM(11);

    float* const Dd = (float*)(ws + WS_D); bf16* const CQN = (bf16*)(ws + WS_CQN); bf16* const CKVN = (bf16*)(ws + WS_CKVN); bf16* const KR = (bf16*)(ws + WS_KR);
    bf16* const Qb = (bf16*)(ws + WS_Q); bf16* const KVb = (bf16*)(ws + WS_KV);
    if (IN(12)) { GEMM_CALL(pg8::EpiF32, HB, ws + WS_MDOWN, MT, MDNP, DM, Dd, MDNP); } SEAM(12);
    if (IN(13)) { Frame Fp = fresh(F); mla_row_phase(Fp, Dd, args.in[14], args.in[15], CQN, CKVN, KR); } SEAM(13);
    if (IN(14)) { GEMM_CALL(pg8::EpiBf16<0>, CQN, ws + WS_MUQ, SEQ, QW, QR, Qb, QW, nullptr, 0, 0, 1.f);
                  GEMM_CALL(pg8::EpiBf16<0>, CKVN, ws + WS_MUKV, MT, KVW, KVR, KVb, KVW, nullptr, 0, 0, 1.f); } SEAM(14);
    if (IN(15)) for (int rep_ = 0; rep_ < REP_ATT; ++rep_) {
        const int c = blockIdx.x;
        for (int i = 0;; ++i) { int head, qb;
            if (F.G == 256) { if (i >= 8) break; head = i * 4 + ((c & 7) >> 1); qb = (c & 1) * 32 + (c >> 3); }
            else { const int u = i * F.G + c; if (u >= NH * (SEQ / 256)) break; head = u >> 6; qb = u & 63; }
            att::attn_unit(Qb + (size_t)qb * 256 * QW + head * (NOPE + ROPE), KVb + head * (NOPE + VD), KVb + head * (NOPE + VD) + NOPE, KR, Z + (size_t)qb * 256 * DM + head * VD, qb * 256, MT, (char*)lds);
            __syncthreads(); }
    } SEAM(15);
    if (IN(16)) { GEMM_CALL(pg8::EpiBf16<0>, Z, ws + WS_MOUT, SEQ, DM, DM, Y, DM, nullptr, 0, 0, 1.f); } SEAM(16);
    if (IN(17)) { Frame Fp = fresh(F); row_phase<true, true, RXS, RXD>(Fp, 0, SEQ, (int)blockIdx.x, F.G, XRL, XC, XRL, XC, Y, MODV(1, 0, 2), MODV(1, 1, 2), GAIN(1, 1), HB, GAIN(1, 2), MODV(1, 0, 3), MODV(1, 1, 3), MODV(1, 0, 4), MODV(1, 1, 4)); } SEAM(17);
    if (IN(17)) { for (int rep_ = 1; rep_ < REP_ROW; ++rep_) { Frame Fp = fresh(F); row_phase<true, true, 0, 2>(Fp, 0, SEQ, (int)blockIdx.x, F.G, XL, XC, (float*)(ws + WS_KV), XC, Y, MODV(1, 0, 2), MODV(1, 1, 2), GAIN(1, 1), (bf16*)(ws + WS_Q), GAIN(1, 2), MODV(1, 0, 3), MODV(1, 1, 3), MODV(1, 0, 4), MODV(1, 1, 4)); } }
#ifdef REP_BAR
    if (IN(17) && IN(18)) { for (int rep_ = 0; rep_ < REP_BAR; ++rep_) xcd_barrier(bar); }
#endif
    if (IN(18)) { for (int rep_ = 0; rep_ < REP_GU; ++rep_) { GEMM_CALL(pg8::EpiSwiglu, HB, ws + WS_WGU + SZ_WGU, SEQ, NGU, DM, U, FFP); } } SEAM(18);
    if (IN(19)) { for (int rep_ = 0; rep_ < REP_DN; ++rep_) { GEMM_DOWN(U, ws + WS_WD + SZ_WD, Y, DM, nullptr, 0, 0, 1.f); } } SEAM(19);
    if (IN(20)) { Frame Fp = fresh(F); row_phase<true, true, RXS, RXD>(Fp, 0, SEQ, (int)blockIdx.x, F.G, XRL, XC, XRL, XC, Y, MODV(1, 0, 5), MODV(1, 1, 5), GAIN(1, 3), HB, GAIN(2, 0), MODV(2, 0, 0), MODV(2, 1, 0), MODV(2, 0, 1), MODV(2, 1, 1)); } SEAM(20);

    bf16* const GT = (bf16*)(ws + WS_GT); bf16* const VVT = (bf16*)(ws + WS_VVT); bf16* const YT = (bf16*)(ws + WS_YT);
    if (IN(21)) { GEMM_CALL(pg8::EpiBf16<0>, HB, ws + WS_HYIN, SEQ, 3 * DM, DM, U, 3 * DM, nullptr, 0, 0, 1.f);
                  GEMM_CALL(pg8::EpiBf16<0>, ws + WS_W4T, ws + WS_HD3, 8192, SEQ, FHP, GT, SEQ, nullptr, 0, 0, 1.f); } SEAM(21);
    if (IN(22)) { for (int rep_ = 0; rep_ < REP_MISC; ++rep_) { Frame Fp = fresh(F); hy_h2_phase(Fp, U, args.in[20], args.in[21], VVT); } } SEAM(22);
    if (IN(23)) { for (int rep_ = 0; rep_ < REP_FFT; ++rep_) { Frame Fp = fresh(F); hy_fft_phase(Fp, GT, VVT, args.in[30], YT, 3.0701134573253945f, (15.350567286626972f - 3.0701134573253945f) / 4095.0f, 1.4426950408889634f / 16383.0f); } } SEAM(23);
    if (IN(24)) { for (int rep_ = 0; rep_ < REP_MISC; ++rep_) { Frame Fp = fresh(F); hy_h4_phase(Fp, U, args.in[20], args.in[21], YT, Z); } } SEAM(24);
    if (IN(25)) { GEMM_CALL(pg8::EpiBf16<0>, Z, ws + WS_HYOUT, SEQ, DM, DM, Y, DM, nullptr, 0, 0, 1.f); } SEAM(25);
    if (IN(26)) { Frame Fp = fresh(F); row_phase<true, true, RXS, RXD>(Fp, 0, SEQ, (int)blockIdx.x, F.G, XRL, XC, XRL, XC, Y, MODV(2, 0, 2), MODV(2, 1, 2), GAIN(2, 1), HB, GAIN(2, 2), MODV(2, 0, 3), MODV(2, 1, 3), MODV(2, 0, 4), MODV(2, 1, 4)); } SEAM(26);
    if (IN(27)) { GEMM_CALL(pg8::EpiSwiglu, HB, ws + WS_WGU + 2 * SZ_WGU, SEQ, NGU, DM, U, FFP); } SEAM(27);
    if (IN(28)) { GEMM_DOWN(U, ws + WS_WD + 2 * SZ_WD, Y, DM, nullptr, 0, 0, 1.f); } SEAM(28);
    if (IN(29)) { Frame Fp = fresh(F); row_phase<true, true, RXS, RXD>(Fp, 0, SEQ, (int)blockIdx.x, F.G, XRL, XC, XRL, XC, Y, MODV(2, 0, 5), MODV(2, 1, 5), GAIN(2, 3), HB, GAIN(3, 0), MODV(3, 0, 0), MODV(3, 1, 0), MODV(3, 0, 1), MODV(3, 1, 1)); } SEAM(29);

    if (IN(30)) { for (int rep_ = 0; rep_ < REP_SCIN; ++rep_) { GEMM_CALL(pg8::EpiScIn, HB, ws + WS_SCIN + SZ_W3, SEQ, 3 * DM, DM, Pb, Bqb, DM); } } SEAM(30);
    if (IN(31)) { for (int rep_ = 0; rep_ < REP_MISC; ++rep_) { Frame Fp = fresh(F); sc_conv_phase(Fp, 0, SEQ, (int)blockIdx.x, F.G, Pb, Bqb, args.in[11] + 3 * DM, Z); } } SEAM(31);
    if (IN(32)) { GEMM_CALL(pg8::EpiBf16<0>, Z, ws + WS_SCOUT + SZ_SQ, SEQ, DM, DM, Y, DM, nullptr, 0, 0, 1.f); } SEAM(32);
    if (IN(33)) { Frame Fp = fresh(F); row_phase<true, true, RXS, RXD>(Fp, 0, SEQ, (int)blockIdx.x, F.G, XRL, XC, XRL, XC, Y, MODV(3, 0, 2), MODV(3, 1, 2), GAIN(3, 1), HB, GAIN(3, 2), MODV(3, 0, 3), MODV(3, 1, 3), MODV(3, 0, 4), MODV(3, 1, 4)); } SEAM(33);
    if (IN(34)) { GEMM_CALL(pg8::EpiSwiglu, HB, ws + WS_WGU + 3 * SZ_WGU, SEQ, NGU, DM, U, FFP); } SEAM(34);
    if (IN(35)) { GEMM_DOWN(U, ws + WS_WD + 3 * SZ_WD, Y, DM, nullptr, 0, 0, 1.f); } SEAM(35);
    if (IN(36)) { Frame Fp = fresh(F); row_phase<true, false, RXS, 2>(Fp, 0, SEQ, (int)blockIdx.x, F.G, XRL, XC, XL, XC, Y, MODV(3, 0, 5), MODV(3, 1, 5), GAIN(3, 3), nullptr, nullptr, nullptr, nullptr, nullptr, nullptr); }
#undef IN
#undef SEAM
}

extern "C" void kernel_launch(void* const* d_in, const int* in_sizes, int n_in, void* d_out, int out_size, void* d_ws, size_t ws_size, hipStream_t stream) {
    static int grid = 0;
    if (grid == 0) {
        if (n_in != 32 || in_sizes[0] != SEQ * DM || out_size != SEQ * DM || ws_size < WS_END) {
            fprintf(stderr, "kernel_launch: shape mismatch: n_in %d in0 %d out %d ws %zu (need >= %zu); nothing launched\n", n_in, n_in > 0 ? in_sizes[0] : -1, out_size, ws_size, (size_t)WS_END); grid = -1; return; }
        int dev = 0, cus = 0, per_cu = 0;
        if (hipGetDevice(&dev) != hipSuccess || hipDeviceGetAttribute(&cus, hipDeviceAttributeMultiprocessorCount, dev) != hipSuccess) { fprintf(stderr, "kernel_launch: device query failed\n"); grid = -1; return; }
        if (hipFuncSetAttribute((const void*)mega_fwd, hipFuncAttributeMaxDynamicSharedMemorySize, LDS_BYTES) != hipSuccess) { fprintf(stderr, "kernel_launch: hipFuncSetAttribute failed\n"); grid = -1; return; }
        if (hipOccupancyMaxActiveBlocksPerMultiprocessor(&per_cu, (const void*)mega_fwd, NTHR, LDS_BYTES) != hipSuccess || per_cu < 1)
            fprintf(stderr, "kernel_launch: note: occupancy query reports %d workgroups per CU\n", per_cu);
        (void)hipGetLastError();
        grid = cus;
    }
    if (grid < 0) return;
    if (hipMemsetAsync((char*)d_ws + WS_CTL, 0, CTL_BYTES, stream) != hipSuccess) { fprintf(stderr, "kernel_launch: memset failed\n"); return; }
    Args a{};
    for (int i = 0; i < 32; ++i) a.in[i] = (const float*)d_in[i];
    a.out = (float*)d_out; a.ws = (unsigned char*)d_ws;
#if MK_MULTI
    for (int p = 0; p < MK_PH_END; ++p) { a.ph_lo = p; a.ph_hi = p + 1; hipLaunchKernelGGL(mega_fwd, dim3(grid), dim3(NTHR), LDS_BYTES, stream, a); }
#else
    a.ph_lo = 0; a.ph_hi = MK_PH_END;
    hipLaunchKernelGGL(mega_fwd, dim3(grid), dim3(NTHR), LDS_BYTES, stream, a);
#endif
    const hipError_t le = hipPeekAtLastError();
    if (le != hipSuccess) fprintf(stderr, "kernel_launch: launch failed: %s\n", hipGetErrorName(le));
}
```
